# Optimizing an MI355X kernel written in HIP

```python
import math
import jax, jax.numpy as jnp
from jax import lax
import numpy as np

D_MODEL = 2048
BATCH = 16
SEQ = 2048
DEPTH = 2
DEC_BATCH = 4
DEC_SEQ = 4096
PAST_LEN = 128

HEAD_DIM = 128
A_HEADS = D_MODEL // 256
A_KV_HEADS = A_HEADS // 4
A_WINDOW = 128
A_BLOCK = 128
B_HEADS = D_MODEL // 256
GRID_W = 64
NB_ROWS_MAX = 8
NB_COLS = 16
D_FF = 4 * D_MODEL
EPS = 1e-6
A_Q = A_HEADS * HEAD_DIM
A_KV = A_KV_HEADS * HEAD_DIM
B_W = B_HEADS * HEAD_DIM
IN_COLS = A_Q + 2 * A_KV + 3 * B_W + 2 * D_MODEL
NEG = -1e30

kernel_name = "hybrid_window_gqa_neighbourhood_encoder"


def _rms(x, g):
    xf = x.astype(jnp.float32)
    y = xf * lax.rsqrt(jnp.mean(xf * xf, axis=-1, keepdims=True) + EPS)
    return (y * g.astype(jnp.float32)).astype(x.dtype)


def _alibi_slopes(n_heads):
    return 2.0 ** (-8.0 * jnp.arange(1, n_heads + 1, dtype=jnp.float32) / n_heads)


def _window_gqa(q, k, v, sink):
    B, S, Hq, d = q.shape
    Hkv = k.shape[2]
    G = Hq // Hkv
    nb = S // A_BLOCK
    pad = ((0, 0), (A_BLOCK, A_BLOCK), (0, 0), (0, 0))
    kp = jnp.pad(k, pad).reshape(B, nb + 2, A_BLOCK, Hkv, d)
    vp = jnp.pad(v, pad).reshape(B, nb + 2, A_BLOCK, Hkv, d)
    kb = jnp.concatenate([kp[:, :-2], kp[:, 1:-1], kp[:, 2:]], axis=2)
    vb = jnp.concatenate([vp[:, :-2], vp[:, 1:-1], vp[:, 2:]], axis=2)
    qb = q.reshape(B, nb, A_BLOCK, Hkv, G, d)
    s = jnp.einsum('bnqhgd,bnshd->bnhgqs', qb, kb).astype(jnp.float32) * (d ** -0.5)
    i = jnp.arange(A_BLOCK)[:, None]
    j = jnp.arange(3 * A_BLOCK)[None, :]
    rel = A_BLOCK + i - j
    spos = jnp.arange(nb)[:, None] * A_BLOCK - A_BLOCK + jnp.arange(3 * A_BLOCK)[None, :]
    valid = (jnp.abs(rel) <= A_WINDOW)[None] & ((spos >= 0) & (spos < S))[:, None, :]
    slopes = _alibi_slopes(Hq).reshape(Hkv, G)
    alibi = -slopes[:, :, None, None] * jnp.abs(rel).astype(jnp.float32)[None, None]
    s = jnp.where(valid[None, :, None, None], s + alibi[None, None], NEG)
    sk = jnp.broadcast_to(sink.astype(jnp.float32).reshape(Hkv, G, 1, 1), s.shape[:-1] + (1,))
    p = jax.nn.softmax(jnp.concatenate([s, sk], axis=-1), axis=-1)[..., :-1]
    o = jnp.einsum('bnhgqs,bnshd->bnqhgd', p.astype(v.dtype), vb)
    return o.reshape(B, S, Hq * d)


def _neighbourhood_attn(q, k, v, rpb):
    B, S, H, d = q.shape
    rows = S // GRID_W
    kh = min(NB_ROWS_MAX, rows)
    r = jnp.arange(rows)
    r0 = jnp.clip(r - kh // 2, 0, rows - kh)
    row_idx = r0[:, None] + jnp.arange(kh)[None, :]
    c = jnp.arange(GRID_W)
    c0 = jnp.clip(c - NB_COLS // 2, 0, GRID_W - NB_COLS)
    col_ok = (c[None, :] >= c0[:, None]) & (c[None, :] < c0[:, None] + NB_COLS)
    qg = q.reshape(B, rows, GRID_W, H, d)
    kg = jnp.take(k.reshape(B, rows, GRID_W, H, d), row_idx, axis=1)
    vg = jnp.take(v.reshape(B, rows, GRID_W, H, d), row_idx, axis=1)
    s = jnp.einsum('brqhd,brjkhd->brhqjk', qg, kg).astype(jnp.float32) * (d ** -0.5)
    dr = row_idx - r[:, None] + (NB_ROWS_MAX - 1)
    dc = jnp.clip(c[None, :] - c[:, None], -(NB_COLS - 1), NB_COLS - 1) + (NB_COLS - 1)
    bias = rpb.astype(jnp.float32)[:, dr[:, None, :, None], dc[None, :, None, :]]
    s = s + jnp.transpose(bias, (1, 0, 2, 3, 4))[None]
    s = jnp.where(col_ok[None, None, None, :, None, :], s, NEG)
    p = jax.nn.softmax(s.reshape(B, rows, H, GRID_W, kh * GRID_W), axis=-1)
    p = p.reshape(B, rows, H, GRID_W, kh, GRID_W).astype(v.dtype)
    o = jnp.einsum('brhqjk,brjkhd->brqhd', p, vg)
    return o.reshape(B, S, H * d)


def _layer(x, c, w_ada, b_ada, ln1, ln2, w_in, qn_a, kn_a, qn_b, kn_b, sink_a, rpb_b,
           w_br_a, w_br_b, w_out, w_mlp1, w_mlp2):
    B, S, _ = x.shape
    mod = jax.nn.silu(c) @ w_ada + b_ada
    sh1, sc1, g1, sh2, sc2, g2 = jnp.split(mod[:, None, :], 6, axis=-1)
    h = _rms(x, ln1) * (1 + sc1) + sh1
    z = h @ w_in
    cuts = [A_Q, A_Q + A_KV, A_Q + 2 * A_KV, A_Q + 2 * A_KV + B_W,
            A_Q + 2 * A_KV + 2 * B_W, A_Q + 2 * A_KV + 3 * B_W,
            A_Q + 2 * A_KV + 3 * B_W + D_MODEL]
    qa, ka, va, qb, kb, vb, ga, gb = jnp.split(z, cuts, axis=-1)
    qa = _rms(qa.reshape(B, S, A_HEADS, HEAD_DIM), qn_a)
    ka = _rms(ka.reshape(B, S, A_KV_HEADS, HEAD_DIM), kn_a)
    va = va.reshape(B, S, A_KV_HEADS, HEAD_DIM)
    qb = _rms(qb.reshape(B, S, B_HEADS, HEAD_DIM), qn_b)
    kb = _rms(kb.reshape(B, S, B_HEADS, HEAD_DIM), kn_b)
    vb = vb.reshape(B, S, B_HEADS, HEAD_DIM)
    oa = _window_gqa(qa, ka, va, sink_a) @ w_br_a
    ob = _neighbourhood_attn(qb, kb, vb, rpb_b) @ w_br_b
    m = jax.nn.sigmoid(ga) * oa + jax.nn.sigmoid(gb) * ob
    x = x + g1 * (m @ w_out)
    h2 = _rms(x, ln2) * (1 + sc2) + sh2
    f = jnp.square(jax.nn.relu(h2 @ w_mlp1)) @ w_mlp2
    return x + g2 * f


def _trunk(x, c, w_ada, b_ada, ln1, ln2, w_in, qn_a, kn_a, qn_b, kn_b, sink_a, rpb_b,
           w_br_a, w_br_b, w_out, w_mlp1, w_mlp2):
    for l in range(DEPTH):
        x = _layer(x, c, w_ada[l], b_ada[l], ln1[l], ln2[l], w_in[l], qn_a[l], kn_a[l],
                   qn_b[l], kn_b[l], sink_a[l], rpb_b[l], w_br_a[l], w_br_b[l], w_out[l],
                   w_mlp1[l], w_mlp2[l])
    return x


def setup_inputs(seed: int = 0) -> dict:
    key = jax.random.key(seed)
    ks = jax.random.split(key, 24)
    f32 = jnp.float32

    def nrm(k, shape, scale):
        return jax.random.normal(k, shape, f32) * scale

    return {
        "x_prompt": nrm(ks[0], (BATCH, SEQ, D_MODEL), 1.0),
        "x_sample": nrm(ks[1], (DEC_BATCH, DEC_SEQ, D_MODEL), 1.0),
        "c_prompt": nrm(ks[2], (BATCH, D_MODEL), 1.0),
        "c_sample": nrm(ks[3], (DEC_BATCH, D_MODEL), 1.0),
        "w_ada": nrm(ks[4], (DEPTH, D_MODEL, 6 * D_MODEL), 0.5 * D_MODEL ** -0.5),
        "b_ada": nrm(ks[5], (DEPTH, 6 * D_MODEL), 0.02),
        "ln1": 1.0 + nrm(ks[6], (DEPTH, D_MODEL), 0.02),
        "ln2": 1.0 + nrm(ks[7], (DEPTH, D_MODEL), 0.02),
        "w_in": nrm(ks[8], (DEPTH, D_MODEL, IN_COLS), D_MODEL ** -0.5),
        "qn_a": 1.0 + nrm(ks[9], (DEPTH, HEAD_DIM), 0.02),
        "kn_a": 1.0 + nrm(ks[10], (DEPTH, HEAD_DIM), 0.02),
        "qn_b": 1.0 + nrm(ks[11], (DEPTH, HEAD_DIM), 0.02),
        "kn_b": 1.0 + nrm(ks[12], (DEPTH, HEAD_DIM), 0.02),
        "sink_a": nrm(ks[13], (DEPTH, A_HEADS), 0.5),
        "rpb_b": nrm(ks[14], (DEPTH, B_HEADS, 2 * NB_ROWS_MAX - 1, 2 * NB_COLS - 1), 0.1),
        "w_br_a": nrm(ks[15], (DEPTH, A_Q, D_MODEL), A_Q ** -0.5),
        "w_br_b": nrm(ks[16], (DEPTH, B_W, D_MODEL), B_W ** -0.5),
        "w_out": nrm(ks[17], (DEPTH, D_MODEL, D_MODEL), D_MODEL ** -0.5),
        "w_mlp1": nrm(ks[18], (DEPTH, D_MODEL, D_FF), D_MODEL ** -0.5),
        "w_mlp2": nrm(ks[19], (DEPTH, D_FF, D_MODEL), D_FF ** -0.5),
    }


def reference(x_prompt, x_sample, c_prompt, c_sample, w_ada, b_ada, ln1, ln2, w_in,
              qn_a, kn_a, qn_b, kn_b, sink_a, rpb_b, w_br_a, w_br_b, w_out, w_mlp1, w_mlp2):
    y_prompt = _trunk(x_prompt, c_prompt, w_ada, b_ada, ln1, ln2, w_in, qn_a, kn_a, qn_b, kn_b,
                      sink_a, rpb_b, w_br_a, w_br_b, w_out, w_mlp1, w_mlp2)
    y_sample = _trunk(x_sample, c_sample, w_ada, b_ada, ln1, ln2, w_in, qn_a, kn_a, qn_b, kn_b,
                      sink_a, rpb_b, w_br_a, w_br_b, w_out, w_mlp1, w_mlp2)
    return (y_prompt, y_sample)
```

```cpp
#include <hip/hip_runtime.h>
#include <cstdio>
#include <cstdint>
namespace pg8 {
#define PG8_LAS __attribute__((address_space(3)))
typedef unsigned short bf16_t;
typedef short bf16x8 __attribute__((ext_vector_type(8)));
typedef float f32x4 __attribute__((ext_vector_type(4)));
typedef unsigned u32x4 __attribute__((ext_vector_type(4)));
constexpr int BM = 256, BK = 64, HALF = 128, HTB = HALF * BK * 2  , STAGE_BYTES = 8 * HTB, NXCD = 8, WGM = 8;

__host__ __device__ __forceinline__ int lds_byte(int r, int c) { const int st = (r >> 4) * 2 + (c >> 5), rr = r & 15, cc = c & 31, ob = rr * 64 + cc * 2; return st * 1024 + (ob ^ (((ob >> 9) & 1) << 5)); }
__host__ __device__ __forceinline__ void stage_rc(int b, int& R, int& C) { const int st = b / 1024, sb = b % 1024, swz = sb ^ (((sb >> 9) & 1) << 5); R = (st >> 1) * 16 + swz / 64; C = (st & 1) * 32 + (swz % 64) / 2; }
__host__ __device__ __forceinline__ int perm32(int rho) { const int n = rho >> 4, i = rho & 15; return 8 * (i >> 2) + 4 * n + (i & 3); }

struct Unit { int pm, pn; };
struct Gemm { const bf16_t* A; const bf16_t* Bt; int M, N, K, lda, ldb; };

struct StaticOrder {
    int nM, nN, nwg, G, c;
    __host__ __device__ void init(int M, int N, int G_, int c_) { nM = M / BM; nN = N / BM; nwg = nM * nN; G = G_; c = c_; }
    __host__ __device__ bool next(int i, Unit& u) const {
        const long L = (long)i * G + c; if (L >= nwg) return false;
        int wgid = (int)L; { const int q = nwg / NXCD, r = nwg % NXCD, xcd = wgid % NXCD, off = wgid / NXCD; wgid = (xcd < r ? xcd * (q + 1) : r * (q + 1) + (xcd - r) * q) + off; }
        const int nig = WGM * nN, gid = wgid / nig, fm = gid * WGM, gsz = (nM - fm) < WGM ? (nM - fm) : WGM;
        u.pm = fm + ((wgid % nig) % gsz); u.pn = (wgid % nig) / gsz; return true;
    }
    __device__ __forceinline__ void a_ready(const Unit&) const {}
    __device__ __forceinline__ void done(const Unit&) const {}
};
__device__ __forceinline__ unsigned cvt_pk_bf16(float lo, float hi) { unsigned r; asm volatile("v_cvt_pk_bf16_f32 %0, %1, %2" : "=v"(r) : "v"(lo), "v"(hi)); return r; }
typedef float f32x2 __attribute__((ext_vector_type(2)));
template <class Epi, class Sched, bool ALIGN_EPI = false, bool SP2 = false>
__device__ __forceinline__ void gemm_phase(PG8_LAS unsigned char* lds, const Gemm g, const Sched& S, const Epi& E) {
    const int tid = threadIdx.x, wid = __builtin_amdgcn_readfirstlane(tid >> 6), lane = tid & 63, wr = wid >> 2, wc = wid & 3, fr = lane & 15, fq = lane >> 4;
    const int K = g.K, nt = K / BK;
    unsigned voffA[2], voffB[2];
#pragma unroll
    for (int i = 0; i < 2; ++i) { int R, C; stage_rc(tid * 16 + i * 8192, R, C); const int Rb = Epi::PERM ? ((R & ~31) + perm32(R & 31)) : R;
        voffA[i] = (unsigned)(R * g.lda + C) * 2u; voffB[i] = (unsigned)(Rb * g.ldb + C) * 2u; }
    const size_t kstep = (size_t)(BK * 2);
    const size_t hstepA = (size_t)HALF * g.lda * 2, hstepB = (size_t)HALF * g.ldb * 2;
    const size_t tstepA = 2 * hstepA, tstepB = 2 * hstepB;
    const unsigned ldsw = (unsigned)wid * 1024u;
    const int aoff = lds_byte(wr * 64 + fr, fq * 8), boff = lds_byte(wc * 32 + fr, fq * 8);
#define PG8_SA(b, h) (((b) * 2 + (h)) * HTB)
#define PG8_SB(b, h) ((4 + (b) * 2 + (h)) * HTB)
#define PG8_STAGE(bufoff, gbase, voff) do { _Pragma("unroll") for (int _i = 0; _i < 2; ++_i) \
        __builtin_amdgcn_global_load_lds((const unsigned*)((const char*)(gbase) + (voff)[_i]), (PG8_LAS unsigned*)(lds + (bufoff) + ldsw + _i * 8192), 16, 0, 0); } while (0)
#define PG8_LDA(dst, b, h) do { _Pragma("unroll") for (int m = 0; m < 4; ++m) _Pragma("unroll") for (int k = 0; k < 2; ++k) dst[m][k] = *(const PG8_LAS bf16x8*)(lds + PG8_SA(b, h) + aoff + m * 2048 + k * 1024); } while (0)
#define PG8_LDB(dst, b, h) do { _Pragma("unroll") for (int n = 0; n < 2; ++n) _Pragma("unroll") for (int k = 0; k < 2; ++k) dst[n][k] = *(const PG8_LAS bf16x8*)(lds + PG8_SB(b, h) + boff + n * 2048 + k * 1024); } while (0)
#define PG8_MMA(ai, bj, At, Bt) do { __builtin_amdgcn_s_setprio(1); _Pragma("unroll") for (int m = 0; m < 4; ++m) _Pragma("unroll") for (int n = 0; n < 2; ++n) _Pragma("unroll") for (int k = 0; k < 2; ++k) \
        acc[ai][bj][m][n] = __builtin_amdgcn_mfma_f32_16x16x32_bf16(Bt[n][k], At[m][k], acc[ai][bj][m][n], 0, 0, 0); __builtin_amdgcn_s_setprio(0); } while (0)
#define PG8_WAIT_V(n) asm volatile("s_waitcnt vmcnt(" #n ")" ::: "memory")
#define PG8_WAIT_L(n) asm volatile("s_waitcnt lgkmcnt(" #n ")" ::: "memory")
#define PG8_BAR __builtin_amdgcn_s_barrier()
#define PG8_SCHED __builtin_amdgcn_sched_barrier(0)
    Unit cur, nxt; int ui = 0;
    if (!S.next(0, cur)) return;
    f32x4 acc[2][2][4][2];
#pragma unroll
    for (int a = 0; a < 2; ++a)
#pragma unroll
        for (int b = 0; b < 2; ++b)
#pragma unroll
            for (int m = 0; m < 4; ++m)
#pragma unroll
                for (int n = 0; n < 2; ++n) acc[a][b][m][n] = (f32x4){0.f, 0.f, 0.f, 0.f};
    bf16x8 At[4][2], B0[2][2], B1[2][2];
    const char* cA = (const char*)g.A + (size_t)cur.pm * tstepA; const char* cB = (const char*)g.Bt + (size_t)cur.pn * tstepB;
    S.a_ready(cur);
    if constexpr (SP2) {
        PG8_STAGE(PG8_SB(0, 0), cB, voffB); PG8_STAGE(PG8_SB(0, 1), cB + hstepB, voffB); PG8_STAGE(PG8_SA(0, 0), cA, voffA); PG8_STAGE(PG8_SA(0, 1), cA + hstepA, voffA);
        if (wr == 1) PG8_BAR;
        PG8_WAIT_V(2); PG8_BAR;
        PG8_STAGE(PG8_SB(1, 0), cB + kstep, voffB); PG8_STAGE(PG8_SA(1, 0), cA + kstep, voffA); PG8_STAGE(PG8_SB(1, 1), cB + hstepB + kstep, voffB);
        PG8_WAIT_V(6); PG8_BAR;
    } else {
        PG8_STAGE(PG8_SB(0, 0), cB, voffB); PG8_STAGE(PG8_SA(0, 0), cA, voffA); PG8_STAGE(PG8_SB(0, 1), cB + hstepB, voffB); PG8_STAGE(PG8_SA(0, 1), cA + hstepA, voffA);
        if (wr == 1) PG8_BAR;
        PG8_WAIT_V(4); PG8_BAR;
        PG8_STAGE(PG8_SB(1, 0), cB + kstep, voffB); PG8_STAGE(PG8_SA(1, 0), cA + kstep, voffA); PG8_STAGE(PG8_SB(1, 1), cB + hstepB + kstep, voffB);
        PG8_WAIT_V(6); PG8_BAR;
    }
    for (;;) {
        const bool has_next = S.next(ui + 1, nxt);
        const char* nA = has_next ? (const char*)g.A + (size_t)nxt.pm * tstepA : cA; const char* nB = has_next ? (const char*)g.Bt + (size_t)nxt.pn * tstepB : cB;
        for (int t = 0; t < nt; t += 2) {
            const bool last = (t == nt - 2);
            const char* a1 = cA + (size_t)(t + 1) * kstep;
            const char* a2 = last ? nA : cA + (size_t)(t + 2) * kstep; const char* b2 = last ? nB : cB + (size_t)(t + 2) * kstep;
            const char* a3 = a2 + kstep; const char* b3 = b2 + kstep;
            if (last && has_next) S.a_ready(nxt);
            if constexpr (SP2) {
            PG8_LDB(B0, 0, 0); PG8_LDB(B1, 0, 1); PG8_SCHED; PG8_LDA(At, 0, 0); PG8_STAGE(PG8_SA(1, 1), a1 + hstepA, voffA);
            PG8_WAIT_V(8); PG8_WAIT_L(0); PG8_BAR; PG8_MMA(0, 0, At, B0); PG8_MMA(0, 1, At, B1); PG8_BAR; PG8_SCHED;
            PG8_LDA(At, 0, 1); PG8_STAGE(PG8_SB(0, 0), b2, voffB); PG8_STAGE(PG8_SB(0, 1), b2 + hstepB, voffB); PG8_STAGE(PG8_SA(0, 0), a2, voffA);
            PG8_WAIT_V(8); PG8_WAIT_L(0); PG8_BAR; PG8_MMA(1, 0, At, B0); PG8_MMA(1, 1, At, B1); PG8_BAR; PG8_SCHED;
            PG8_LDB(B0, 1, 0); PG8_LDB(B1, 1, 1); PG8_SCHED; PG8_LDA(At, 1, 0); PG8_STAGE(PG8_SA(0, 1), a2 + hstepA, voffA);
            PG8_WAIT_V(8); PG8_WAIT_L(0); PG8_BAR; PG8_MMA(0, 0, At, B0); PG8_MMA(0, 1, At, B1); PG8_BAR; PG8_SCHED;
            PG8_LDA(At, 1, 1); PG8_STAGE(PG8_SB(1, 0), b3, voffB); PG8_STAGE(PG8_SB(1, 1), b3 + hstepB, voffB); PG8_STAGE(PG8_SA(1, 0), a3, voffA);
            PG8_WAIT_V(8); PG8_WAIT_L(0); PG8_BAR; PG8_MMA(1, 0, At, B0); PG8_MMA(1, 1, At, B1); PG8_BAR; PG8_SCHED;
            } else {
            PG8_LDB(B0, 0, 0); PG8_SCHED; PG8_LDA(At, 0, 0); PG8_STAGE(PG8_SA(1, 1), a1 + hstepA, voffA);
            PG8_WAIT_L(8); PG8_BAR; PG8_WAIT_L(0); PG8_MMA(0, 0, At, B0); PG8_BAR; PG8_SCHED;
            PG8_LDB(B1, 0, 1); PG8_STAGE(PG8_SB(0, 0), b2, voffB);
            PG8_BAR; PG8_WAIT_L(0); PG8_MMA(0, 1, At, B1); PG8_BAR;
            PG8_LDA(At, 0, 1); PG8_STAGE(PG8_SA(0, 0), a2, voffA);
            PG8_BAR; PG8_WAIT_L(0); PG8_MMA(1, 0, At, B0); PG8_BAR; PG8_SCHED;
            PG8_STAGE(PG8_SB(0, 1), b2 + hstepB, voffB);
            PG8_WAIT_V(6); PG8_BAR; PG8_MMA(1, 1, At, B1); PG8_BAR;
            PG8_LDB(B0, 1, 0); PG8_SCHED; PG8_LDA(At, 1, 0); PG8_STAGE(PG8_SA(0, 1), a2 + hstepA, voffA);
            PG8_WAIT_L(8); PG8_BAR; PG8_WAIT_L(0); PG8_MMA(0, 0, At, B0); PG8_BAR; PG8_SCHED;
            PG8_LDB(B1, 1, 1); PG8_STAGE(PG8_SB(1, 0), b3, voffB);
            PG8_BAR; PG8_WAIT_L(0); PG8_MMA(0, 1, At, B1); PG8_BAR;
            PG8_LDA(At, 1, 1); PG8_STAGE(PG8_SA(1, 0), a3, voffA);
            PG8_BAR; PG8_WAIT_L(0); PG8_MMA(1, 0, At, B0); PG8_BAR; PG8_SCHED;
            PG8_STAGE(PG8_SB(1, 1), b3 + hstepB, voffB);
            PG8_WAIT_V(6); PG8_BAR; PG8_MMA(1, 1, At, B1); PG8_BAR;
            }
        }
        if constexpr (ALIGN_EPI) { if (wr == 0) PG8_BAR; }
        if constexpr (!Epi::AFTER_DRAIN) { E(acc, cur, wr, wc, fr, fq); S.done(cur); }
        if (!has_next) break;
#pragma unroll
        for (int a = 0; a < 2; ++a)
#pragma unroll
            for (int b = 0; b < 2; ++b)
#pragma unroll
                for (int m = 0; m < 4; ++m)
#pragma unroll
                    for (int n = 0; n < 2; ++n) acc[a][b][m][n] = (f32x4){0.f, 0.f, 0.f, 0.f};
        cur = nxt; cA = nA; cB = nB; ++ui;
        if constexpr (ALIGN_EPI) { if (wr == 1) PG8_BAR; }
    }
    PG8_WAIT_V(0);
    if constexpr (!ALIGN_EPI) { if (wr == 0) PG8_BAR; }
    PG8_BAR;
    if constexpr (Epi::AFTER_DRAIN) { E.fused(acc, cur, wr, wc, fr, fq, lds, wid, lane); S.done(cur); }
#undef PG8_SA
#undef PG8_SB
#undef PG8_STAGE
#undef PG8_LDA
#undef PG8_LDB
#undef PG8_MMA
#undef PG8_WAIT_V
#undef PG8_WAIT_L
#undef PG8_BAR
#undef PG8_SCHED
}
}

namespace pg8 {
__device__ __forceinline__ float bf_lo(unsigned w) { return __uint_as_float(w << 16); }
__device__ __forceinline__ float bf_hi(unsigned w) { return __uint_as_float(w & 0xffff0000u); }
__device__ __forceinline__ float sigmoidf_fast(float g) { return __builtin_amdgcn_rcpf(1.0f + __builtin_amdgcn_exp2f(-1.4426950408889634f * g)); }

template <int ACT  > struct EpiStore {
    static constexpr bool PERM = true, AFTER_DRAIN = false;
    bf16_t* O; int ldc;
    __device__ __forceinline__ void operator()(const f32x4 (&acc)[2][2][4][2], const Unit& u, int wr, int wc, int fr, int fq) const {
        const int row0 = u.pm * BM + wr * 64 + fr, col0 = u.pn * BM + wc * 32 + 8 * fq;
#pragma unroll
        for (int ai = 0; ai < 2; ++ai)
#pragma unroll
            for (int m = 0; m < 4; ++m) { bf16_t* rowp = O + (size_t)(row0 + ai * HALF + m * 16) * ldc + col0;
#pragma unroll
                for (int bj = 0; bj < 2; ++bj) { f32x4 v0 = acc[ai][bj][m][0], v1 = acc[ai][bj][m][1];
                    if (ACT == 1) { const f32x4 z = (f32x4){0.f, 0.f, 0.f, 0.f}; v0 = __builtin_elementwise_max(v0, z); v1 = __builtin_elementwise_max(v1, z); v0 = v0 * v0; v1 = v1 * v1; }
                    u32x4 w; w.x = cvt_pk_bf16(v0[0], v0[1]); w.y = cvt_pk_bf16(v0[2], v0[3]); w.z = cvt_pk_bf16(v1[0], v1[1]); w.w = cvt_pk_bf16(v1[2], v1[3]);
                    *(u32x4*)(rowp + bj * HALF) = w; } }
    }
};
template <int MODE> struct EpiGate {
    static constexpr bool PERM = true, AFTER_DRAIN = false;
    const bf16_t* G; int ldg; const bf16_t* P; bf16_t* O; int ldo;
    __device__ __forceinline__ void operator()(const f32x4 (&acc)[2][2][4][2], const Unit& u, int wr, int wc, int fr, int fq) const {
        const int row0 = u.pm * BM + wr * 64 + fr, col0 = u.pn * BM + wc * 32 + 8 * fq;
#pragma unroll
        for (int ai = 0; ai < 2; ++ai)
#pragma unroll
            for (int m = 0; m < 4; ++m) { const size_t row = (size_t)(row0 + ai * HALF + m * 16);
#pragma unroll
                for (int bj = 0; bj < 2; ++bj) { const int col = col0 + bj * HALF;
                    const u32x4 gw = *(const u32x4*)(G + row * ldg + col);
                    f32x4 v0 = acc[ai][bj][m][0], v1 = acc[ai][bj][m][1];
                    v0[0] *= sigmoidf_fast(bf_lo(gw.x)); v0[1] *= sigmoidf_fast(bf_hi(gw.x)); v0[2] *= sigmoidf_fast(bf_lo(gw.y)); v0[3] *= sigmoidf_fast(bf_hi(gw.y));
                    v1[0] *= sigmoidf_fast(bf_lo(gw.z)); v1[1] *= sigmoidf_fast(bf_hi(gw.z)); v1[2] *= sigmoidf_fast(bf_lo(gw.w)); v1[3] *= sigmoidf_fast(bf_hi(gw.w));
                    if (MODE == 1) { const u32x4 pw = *(const u32x4*)(P + row * ldo + col);
                        v0[0] += bf_lo(pw.x); v0[1] += bf_hi(pw.x); v0[2] += bf_lo(pw.y); v0[3] += bf_hi(pw.y);
                        v1[0] += bf_lo(pw.z); v1[1] += bf_hi(pw.z); v1[2] += bf_lo(pw.w); v1[3] += bf_hi(pw.w); }
                    u32x4 w; w.x = cvt_pk_bf16(v0[0], v0[1]); w.y = cvt_pk_bf16(v0[2], v0[3]); w.z = cvt_pk_bf16(v1[0], v1[1]); w.w = cvt_pk_bf16(v1[2], v1[3]);
                    *(u32x4*)(O + row * ldo + col) = w; } }
    }
};
struct EpiRes {
    static constexpr bool PERM = false, AFTER_DRAIN = false;
    const float* xp; const float* xs; float* out; const float* modg; int row_off;
    __device__ __forceinline__ void operator()(const f32x4 (&acc)[2][2][4][2], const Unit& u, int wr, int wc, int fr, int fq) const {
        const int rowg = row_off + u.pm * BM;
        const int b = rowg < 32768 ? (rowg >> 11) : 16 + ((rowg - 32768) >> 12);
        const float* gvec = modg + (size_t)b * (6 * 2048);
        const float* base = xp ? (rowg < 32768 ? xp + (size_t)rowg * 2048 : xs + (size_t)(rowg - 32768) * 2048) : out + (size_t)rowg * 2048;
        float* op = out + (size_t)rowg * 2048;
        const int r0 = wr * 64 + fr, col0 = u.pn * BM + wc * 32 + 4 * fq;
        f32x4 gv[2][2];
#pragma unroll
        for (int bj = 0; bj < 2; ++bj)
#pragma unroll
            for (int n = 0; n < 2; ++n) gv[bj][n] = *(const f32x4*)(gvec + col0 + bj * HALF + n * 16);
#pragma unroll
        for (int ai = 0; ai < 2; ++ai)
#pragma unroll
            for (int m = 0; m < 4; ++m) { const size_t off = (size_t)(r0 + ai * HALF + m * 16) * 2048 + col0;
#pragma unroll
                for (int bj = 0; bj < 2; ++bj)
#pragma unroll
                    for (int n = 0; n < 2; ++n) { const f32x4 bs = *(const f32x4*)(base + off + bj * HALF + n * 16);
                        *(f32x4*)(op + off + bj * HALF + n * 16) = bs + gv[bj][n] * acc[ai][bj][m][n]; } }
    }
};
}

#ifndef MK_MULTI
#define MK_MULTI 0
#endif
#ifndef PG8_SP2
#define PG8_SP2 true
#endif
#ifndef PG8_ALIGN
#define PG8_ALIGN true
#endif

constexpr int NWAVES = 8;
constexpr int D = 2048, TTOK = 49152, TP = 32768, NSEQ = 20, INC = 8704, DFF = 8192, HD = 128;
constexpr int TC = 24576, NCH = 2, NLAYER = 2;
constexpr float RMS_EPS = 1e-6f, ATT_SCALE = 0.08838834764831845f, LOG2E = 1.4426950408889634f;
constexpr int ZC_QA = 0, ZC_KA = 1024, ZC_VA = 1280, ZC_QB = 1536, ZC_KB = 2560, ZC_VB = 3584, ZC_GA = 4608, ZC_GB = 6656;
static_assert(TTOK == NCH * TC && TC % 256 == 0 && TP % 256 == 0, "chunks");
enum { I_XP = 0, I_XS, I_CP, I_CS, I_WADA, I_BADA, I_LN1, I_LN2, I_WIN, I_QNA, I_KNA, I_QNB, I_KNB, I_SINK, I_RPB, I_WBRA, I_WBRB, I_WOUT, I_W1, I_W2, N_IN };

constexpr size_t MiB = 1u << 20;
constexpr size_t WS_CTL = 0, CTL_ZERO_BYTES = 1 * MiB;
constexpr size_t WS_MOD = 1 * MiB;
constexpr size_t WS_TBLA = 3 * MiB, WS_TBLB = 4 * MiB;
constexpr size_t WS_W = 8 * MiB, W_LAYER = 114 * MiB;
constexpr size_t WO_IN = 0, WO_BR = 34 * MiB, WO_OUT = 42 * MiB, WO_1 = 50 * MiB, WO_2 = 82 * MiB;
constexpr size_t WS_H = WS_W + 2 * W_LAYER;
constexpr size_t WS_Z = WS_H + 96 * MiB;
constexpr size_t WS_O = WS_Z + 408 * MiB;
constexpr size_t WS_MB = WS_O + 96 * MiB;
constexpr size_t WS_END = WS_MB + 96 * MiB;
static_assert((size_t)INC * 2048 * 2 == 34 * MiB && (size_t)TC * INC * 2 == 408 * MiB && (size_t)TC * D * 2 == 96 * MiB, "sizes");
constexpr int CW_TMO = 0, CW_BAR = 4096;

constexpr int RING_OFF = 0, RING_BYTES = 131072;
constexpr int LDSCTL_OFF = RING_BYTES, MISC_OFF = LDSCTL_OFF + 320;
constexpr int LDS_BYTES = 147456;
static_assert(MISC_OFF + 128 <= LDS_BYTES, "LDS map");

#define GAS __attribute__((address_space(1)))
#define LAS __attribute__((address_space(3)))
typedef unsigned short bf16;
typedef unsigned v4u __attribute__((ext_vector_type(4)));
typedef unsigned v2u __attribute__((ext_vector_type(2)));
typedef float f32x4 __attribute__((ext_vector_type(4)));
typedef GAS unsigned gu32;
#define RLX_AGENT __ATOMIC_RELAXED, __HIP_MEMORY_SCOPE_AGENT
#define LDS_WAIT() asm volatile("s_waitcnt lgkmcnt(0)" ::: "memory")
#define VM_WAIT() asm volatile("s_waitcnt vmcnt(0)" ::: "memory")
__device__ __forceinline__ unsigned f2bf(float f) { unsigned u = __builtin_bit_cast(unsigned, f); return (u + 0x7fffu + ((u >> 16) & 1u)) >> 16; }
__device__ __forceinline__ unsigned pk2(float lo, float hi) { return f2bf(lo) | (f2bf(hi) << 16); }
__device__ __forceinline__ float bflo(unsigned w) { return __uint_as_float(w << 16); }
__device__ __forceinline__ float bfhi(unsigned w) { return __uint_as_float(w & 0xffff0000u); }
__device__ __forceinline__ float wave_sum(float v) {
#pragma unroll
    for (int o = 1; o < 64; o <<= 1) v += __shfl_xor(v, o);
    return v;
}
__device__ __forceinline__ int seq_of(int row) { return row < TP ? (row >> 11) : 16 + ((row - TP) >> 12); }

#define XB_TMO      128
#define XB_XCNT(j)  (256  + 64 * (j))
#define XB_XSUB(j)  (1280 + 64 * (j))
#define XB_XGEN(j)  (2304 + 64 * (j))
#define XB_TOP      3328
#define XB_TOPGEN   3392
#define XCD_BAR_WORDS 3456
#define XB_SPIN_CAP (1u << 18)

__device__ __forceinline__ unsigned xb_ld(unsigned* p)              { return __hip_atomic_load(p, __ATOMIC_RELAXED, __HIP_MEMORY_SCOPE_AGENT); }
__device__ __forceinline__ unsigned xb_add(unsigned* p, unsigned v) { return __hip_atomic_fetch_add(p, v, __ATOMIC_RELAXED, __HIP_MEMORY_SCOPE_AGENT); }
__device__ __forceinline__ unsigned xb_xcc_id() { return (unsigned)__builtin_amdgcn_s_getreg((3 << 11) | 20) & 0xFu; }
#define XB_SPIN(cond, bar) do { unsigned _sp = 0; while (cond) { __builtin_amdgcn_s_sleep(1); \
    if ((++_sp & 255u) == 0u) { if (xb_ld(&(bar)[XB_TMO])) break; if (_sp > XB_SPIN_CAP) { atomicAdd(&(bar)[XB_TMO], 1u); break; } } } } while (0)

struct XcdBarrier {
    unsigned* bar; unsigned x;
    volatile LAS unsigned* st;
};

__device__ __forceinline__ XcdBarrier xcd_barrier_post(unsigned* bar, volatile LAS unsigned* st) {
    XcdBarrier b; b.bar = bar; b.x = xb_xcc_id(); b.st = st;
    if (threadIdx.x == 0) (void)xb_add(&bar[XB_XCNT(b.x)], 1u);
    return b;
}
__device__ __forceinline__ void xcd_barrier_complete(unsigned* bar, unsigned x, unsigned& nloc, unsigned& nx) {
    const unsigned G = gridDim.x * gridDim.y * gridDim.z;
    unsigned sum, cnt, mine, sp = 0u;
    for (;;) {
        sum = 0u; cnt = 0u; mine = 0u;
#pragma unroll
        for (unsigned j = 0; j < 16; ++j) { const unsigned c = xb_ld(&bar[XB_XCNT(j)]); sum += c; cnt += (c > 0u) ? 1u : 0u; mine = (j == x) ? c : mine; }
        if (sum == G) break;
        __builtin_amdgcn_s_sleep(1);
        if ((++sp & 255u) == 0u) { if (xb_ld(&bar[XB_TMO])) break; if (sp > XB_SPIN_CAP) { atomicAdd(&bar[XB_TMO], 1u); break; } }
    }
    nloc = mine > 0u ? mine : 1u; nx = cnt > 0u ? cnt : 1u;
}

__device__ __forceinline__ void xcd_barrier(const XcdBarrier& b) {
    asm volatile("s_waitcnt vmcnt(0)" ::: "memory");
    __syncthreads();
    if (threadIdx.x == 0) {
        unsigned* bar = b.bar;
        __builtin_amdgcn_s_waitcnt(0);
        unsigned nloc = b.st[0], nx = b.st[1];
        if (nloc == 0u) { xcd_barrier_complete(bar, b.x, nloc, nx); b.st[0] = nloc; b.st[1] = nx; }
        const unsigned old = xb_add(&bar[XB_XSUB(b.x)], 1u);
        const unsigned gen = old / nloc;
        if (old + 1u == (gen + 1u) * nloc) {
            __builtin_amdgcn_fence(__ATOMIC_RELEASE, "agent");
            asm volatile("s_waitcnt vmcnt(0)" ::: "memory");
            const unsigned og = xb_add(&bar[XB_TOP], 1u);
            const unsigned tg = og / nx;
            if (og + 1u == (tg + 1u) * nx) xb_add(&bar[XB_TOPGEN], 1u);
            else XB_SPIN(xb_ld(&bar[XB_TOPGEN]) == tg, bar);
            __builtin_amdgcn_fence(__ATOMIC_ACQUIRE, "agent");
            xb_add(&bar[XB_XGEN(b.x)], 1u);
            asm volatile("s_waitcnt vmcnt(0)" ::: "memory");
        } else {
            XB_SPIN(xb_ld(&bar[XB_XGEN(b.x)]) == gen, bar);
            __builtin_amdgcn_fence(__ATOMIC_ACQUIRE, "agent");
            asm volatile("s_waitcnt vmcnt(0)" ::: "memory");
        }
    }
    __syncthreads();
}


struct Frame {
    LAS unsigned char* lds;
    int tid, lane, wave, G, gw, ngw;
    const float* in[N_IN];
    float* out; unsigned char* ws;
    float* mod;
};

__device__ __forceinline__ void transpose_item(const float* W, int N, bf16* WT, int ldT, int koff, LAS float* scr, int item, int lane) {
    const int nblk = N / 32, kb = item / nblk, nb = item - kb * nblk, k0 = 64 * kb, n0 = 32 * nb;
#pragma unroll 8
    for (int i = 0; i < 32; ++i) { const int kk = 2 * i + (lane >> 5); scr[kk * 33 + (lane & 31)] = W[(size_t)(k0 + kk) * N + n0 + (lane & 31)]; }
    LDS_WAIT(); asm volatile("" ::: "memory");
    const int c = lane & 7;
#pragma unroll
    for (int j = 0; j < 4; ++j) { const int n = (lane >> 3) + 8 * j; const LAS float* s = scr + (8 * c) * 33 + n;
        v4u o; o.x = pk2(s[0 * 33], s[1 * 33]); o.y = pk2(s[2 * 33], s[3 * 33]); o.z = pk2(s[4 * 33], s[5 * 33]); o.w = pk2(s[6 * 33], s[7 * 33]);
        *(GAS v4u*)(WT + (size_t)(n0 + n) * ldT + koff + k0 + 8 * c) = o; }
    LDS_WAIT(); asm volatile("" ::: "memory");
}

__device__ __forceinline__ void p0_weights(Frame& F) {
    LAS float* scr = (LAS float*)(F.lds + RING_OFF + F.wave * 16384);
    constexpr int I_IN = (D / 64) * (INC / 32), I_BR = (1024 / 64) * (D / 32), I_OUT = (D / 64) * (D / 32), I_1 = (D / 64) * (DFF / 32), I_2 = (DFF / 64) * (D / 32);
    constexpr int PER_LAYER = I_IN + 2 * I_BR + I_OUT + I_1 + I_2;
    for (int it = F.gw; it < NLAYER * PER_LAYER; it += F.ngw) {
        const int l = it / PER_LAYER; int r = it - l * PER_LAYER;
        unsigned char* wl = F.ws + WS_W + (size_t)l * W_LAYER;
        if (r < I_IN) { transpose_item(F.in[I_WIN] + (size_t)l * D * INC, INC, (bf16*)(wl + WO_IN), D, 0, scr, r, F.lane); continue; } r -= I_IN;
        if (r < I_BR) { transpose_item(F.in[I_WBRA] + (size_t)l * 1024 * D, D, (bf16*)(wl + WO_BR), 2048, 0, scr, r, F.lane); continue; } r -= I_BR;
        if (r < I_BR) { transpose_item(F.in[I_WBRB] + (size_t)l * 1024 * D, D, (bf16*)(wl + WO_BR), 2048, 1024, scr, r, F.lane); continue; } r -= I_BR;
        if (r < I_OUT) { transpose_item(F.in[I_WOUT] + (size_t)l * D * D, D, (bf16*)(wl + WO_OUT), D, 0, scr, r, F.lane); continue; } r -= I_OUT;
        if (r < I_1) { transpose_item(F.in[I_W1] + (size_t)l * D * DFF, DFF, (bf16*)(wl + WO_1), D, 0, scr, r, F.lane); continue; } r -= I_1;
        transpose_item(F.in[I_W2] + (size_t)l * DFF * D, D, (bf16*)(wl + WO_2), DFF, 0, scr, r, F.lane);
    }
}

__device__ __forceinline__ void p0_mod(Frame& F) {
    LAS float* scr = (LAS float*)(F.lds + RING_OFF + F.wave * 8192);
    LAS float* red = (LAS float*)(F.lds + RING_OFF + 65536);
    const float* cp = F.in[I_CP]; const float* cs = F.in[I_CS];
    for (int task = blockIdx.x; task < NLAYER * 192; task += F.G) {
        const int l = task / 192, n0 = (task - l * 192) * 64;
        const float* W = F.in[I_WADA] + (size_t)l * D * 12288 + n0 + F.lane;
        float acc[NSEQ];
#pragma unroll
        for (int b = 0; b < NSEQ; ++b) acc[b] = 0.f;
        for (int kc = 0; kc < 4; ++kc) {
            const int k0 = F.wave * 256 + kc * 64;
#pragma unroll
            for (int b = 0; b < NSEQ; ++b) { const float cv = (b < 16) ? cp[b * D + k0 + F.lane] : cs[(b - 16) * D + k0 + F.lane];
                scr[F.lane * NSEQ + b] = cv / (1.0f + __expf(-cv)); }
            LDS_WAIT(); asm volatile("" ::: "memory");
#pragma unroll 4
            for (int kk = 0; kk < 64; ++kk) { const float w = W[(size_t)(k0 + kk) * 12288];
#pragma unroll
                for (int b = 0; b < NSEQ; ++b) acc[b] = fmaf(scr[kk * NSEQ + b], w, acc[b]); }
            LDS_WAIT(); asm volatile("" ::: "memory");
        }
#pragma unroll
        for (int b = 0; b < NSEQ; ++b) red[(F.wave * NSEQ + b) * 64 + F.lane] = acc[b];
        __syncthreads();
        for (int idx = F.tid; idx < NSEQ * 64; idx += NWAVES * 64) { const int b = idx >> 6, ln = idx & 63; float s = 0.f;
#pragma unroll
            for (int w = 0; w < NWAVES; ++w) s += red[(w * NSEQ + b) * 64 + ln];
            F.mod[((size_t)l * NSEQ + b) * 12288 + n0 + ln] = s + F.in[I_BADA][l * 12288 + n0 + ln]; }
        __syncthreads();
    }
}

__device__ __forceinline__ void norm_phase(Frame& F, int l, int which, int c0, bool from_inputs) {
    bf16* H = (bf16*)(F.ws + WS_H);
    const float* lnw = F.in[which ? I_LN2 : I_LN1] + l * D;
    for (int tl = F.gw; tl < TC; tl += F.ngw) {
        const int row = c0 + tl, b = seq_of(row);
        const float* xrow = from_inputs ? (row < TP ? F.in[I_XP] + (size_t)row * D : F.in[I_XS] + (size_t)(row - TP) * D) : F.out + (size_t)row * D;
        const float* sh = F.mod + (((size_t)l * NSEQ + b) * 6 + which * 3) * D; const float* sc = sh + D;
        const GAS f32x4* xr = (const GAS f32x4*)xrow + F.lane;
        f32x4 v[8]; float ss = 0.f;
#pragma unroll
        for (int j = 0; j < 8; ++j) { v[j] = xr[64 * j]; ss += (v[j].x * v[j].x + v[j].y * v[j].y) + (v[j].z * v[j].z + v[j].w * v[j].w); }
        const float rstd = rsqrtf(wave_sum(ss) * (1.f / D) + RMS_EPS);
        GAS v2u* o8 = (GAS v2u*)(H + (size_t)tl * D) + F.lane;
#pragma unroll
        for (int j = 0; j < 8; ++j) { const int col = 4 * F.lane + 256 * j;
            const f32x4 g = *(const f32x4*)(lnw + col), s1 = *(const f32x4*)(sc + col), s0 = *(const f32x4*)(sh + col);
            const f32x4 y = (v[j] * rstd) * g * (s1 + 1.0f) + s0;
            v2u w; w.x = pk2(y.x, y.y); w.y = pk2(y.z, y.w); o8[64 * j] = w; }
    }
}

__device__ __forceinline__ void attn_simple_A(Frame& F, int l, int c0) {
    const bf16* Z = (const bf16*)(F.ws + WS_Z); bf16* O = (bf16*)(F.ws + WS_O);
    const float* qn = F.in[I_QNA] + l * HD; const float* kn = F.in[I_KNA] + l * HD; const float* sink = F.in[I_SINK] + l * 8;
    const float g0 = qn[2 * F.lane] * kn[2 * F.lane] * ATT_SCALE, g1 = qn[2 * F.lane + 1] * kn[2 * F.lane + 1] * ATT_SCALE;
    for (int item = F.gw; item < TC * 8; item += F.ngw) {
        const int tl = item >> 3, h = item & 7, kvh = h >> 2, row = c0 + tl;
        const int S = row < TP ? 2048 : 4096, pos = row < TP ? (row & 2047) : ((row - TP) & 4095);
        const bf16* zr = Z + (size_t)tl * INC;
        const unsigned qw = *(const unsigned*)(zr + ZC_QA + h * HD + 2 * F.lane);
        float q0 = bflo(qw), q1 = bfhi(qw);
        const float rq = rsqrtf(wave_sum(q0 * q0 + q1 * q1) * (1.f / HD) + RMS_EPS);
        q0 *= rq * g0; q1 *= rq * g1;
        float m = sink[h], lsum = 1.f, o0 = 0.f, o1 = 0.f;
        const float slope = exp2f(-(float)(h + 1));
        const int slo = pos - 128 < 0 ? 0 : pos - 128, shi = pos + 128 > S - 1 ? S - 1 : pos + 128;
        for (int s = slo; s <= shi; ++s) {
            const bf16* kr = zr + (ptrdiff_t)(s - pos) * INC;
            const unsigned kw = *(const unsigned*)(kr + ZC_KA + kvh * HD + 2 * F.lane), vw = *(const unsigned*)(kr + ZC_VA + kvh * HD + 2 * F.lane);
            const float k0 = bflo(kw), k1 = bfhi(kw);
            float dot = q0 * k0 + q1 * k1, kss = k0 * k0 + k1 * k1;
#pragma unroll
            for (int o = 1; o < 64; o <<= 1) { dot += __shfl_xor(dot, o); kss += __shfl_xor(kss, o); }
            const float sc = dot * rsqrtf(kss * (1.f / HD) + RMS_EPS) - slope * fabsf((float)(pos - s));
            const float mn = fmaxf(m, sc), al = __expf(m - mn), p = __expf(sc - mn);
            lsum = lsum * al + p; o0 = o0 * al + p * bflo(vw); o1 = o1 * al + p * bfhi(vw); m = mn;
        }
        const float inv = 1.f / lsum;
        *(unsigned*)(O + (size_t)tl * D + h * HD + 2 * F.lane) = pk2(o0 * inv, o1 * inv);
    }
}
__device__ __forceinline__ void attn_simple_B(Frame& F, int l, int c0) {
    const bf16* Z = (const bf16*)(F.ws + WS_Z); bf16* O = (bf16*)(F.ws + WS_O);
    const float* qn = F.in[I_QNB] + l * HD; const float* kn = F.in[I_KNB] + l * HD; const float* rpb = F.in[I_RPB] + (size_t)l * 8 * 15 * 31;
    const float g0 = qn[2 * F.lane] * kn[2 * F.lane] * ATT_SCALE, g1 = qn[2 * F.lane + 1] * kn[2 * F.lane + 1] * ATT_SCALE;
    for (int item = F.gw; item < TC * 8; item += F.ngw) {
        const int tl = item >> 3, h = item & 7, row = c0 + tl;
        const int S = row < TP ? 2048 : 4096, pos = row < TP ? (row & 2047) : ((row - TP) & 4095), rows = S >> 6;
        const int r = pos >> 6, c = pos & 63;
        const int r0 = r - 4 < 0 ? 0 : (r - 4 > rows - 8 ? rows - 8 : r - 4), cc0 = c - 8 < 0 ? 0 : (c - 8 > 48 ? 48 : c - 8);
        const bf16* zr = Z + (size_t)tl * INC;
        const unsigned qw = *(const unsigned*)(zr + ZC_QB + h * HD + 2 * F.lane);
        float q0 = bflo(qw), q1 = bfhi(qw);
        const float rq = rsqrtf(wave_sum(q0 * q0 + q1 * q1) * (1.f / HD) + RMS_EPS);
        q0 *= rq * g0; q1 *= rq * g1;
        float m = -1e30f, lsum = 0.f, o0 = 0.f, o1 = 0.f;
        for (int j = 0; j < 8; ++j) { const int kr_ = r0 + j, dr = kr_ - r + 7;
            for (int kk = 0; kk < 16; ++kk) { const int kc = cc0 + kk; int dcv = kc - c; dcv = dcv < -15 ? -15 : (dcv > 15 ? 15 : dcv);
                const float bias = rpb[(h * 15 + dr) * 31 + dcv + 15];
                const bf16* kp = zr + (ptrdiff_t)(kr_ * 64 + kc - pos) * INC;
                const unsigned kw = *(const unsigned*)(kp + ZC_KB + h * HD + 2 * F.lane), vw = *(const unsigned*)(kp + ZC_VB + h * HD + 2 * F.lane);
                const float k0 = bflo(kw), k1 = bfhi(kw);
                float dot = q0 * k0 + q1 * k1, kss = k0 * k0 + k1 * k1;
#pragma unroll
                for (int o = 1; o < 64; o <<= 1) { dot += __shfl_xor(dot, o); kss += __shfl_xor(kss, o); }
                const float sc = dot * rsqrtf(kss * (1.f / HD) + RMS_EPS) + bias;
                const float mn = fmaxf(m, sc), al = __expf(m - mn), p = __expf(sc - mn);
                lsum = lsum * al + p; o0 = o0 * al + p * bflo(vw); o1 = o1 * al + p * bfhi(vw); m = mn; } }
        const float inv = 1.f / lsum;
        *(unsigned*)(O + (size_t)tl * D + 1024 + h * HD + 2 * F.lane) = pk2(o0 * inv, o1 * inv);
    }
}

#ifndef SITE_MASK
#define SITE_MASK 0xffff
#endif
#define SITE(k) ((SITE_MASK >> (k)) & 1)
constexpr int PH_PER = 9, N_PHASES = 1 + 2 * 2 * PH_PER;
template <int l, int c> __device__ __forceinline__ void layer_chunk(Frame& F, const XcdBarrier& bar, const int lo, const int hi) {
#define RUN(ph) ((ph) >= lo && (ph) < hi)
#define SEAM(ph) do { if ((ph) + 1 < hi) xcd_barrier(bar); } while (0)
        unsigned char* wl = F.ws + WS_W + (size_t)l * W_LAYER;
        const pg8::bf16_t* WinT = (const pg8::bf16_t*)(wl + WO_IN); const pg8::bf16_t* WbrT = (const pg8::bf16_t*)(wl + WO_BR); const pg8::bf16_t* WoutT = (const pg8::bf16_t*)(wl + WO_OUT);
        const pg8::bf16_t* W1T = (const pg8::bf16_t*)(wl + WO_1); const pg8::bf16_t* W2T = (const pg8::bf16_t*)(wl + WO_2);
        pg8::bf16_t* Hb = (pg8::bf16_t*)(F.ws + WS_H); pg8::bf16_t* Zb = (pg8::bf16_t*)(F.ws + WS_Z); pg8::bf16_t* Ob = (pg8::bf16_t*)(F.ws + WS_O); pg8::bf16_t* Mb = (pg8::bf16_t*)(F.ws + WS_MB);
        {
            const int c0 = c * TC, pb = 1 + (l * NCH + c) * PH_PER;
            if (SITE(1) && RUN(pb + 0)) { norm_phase(F, l, 0, c0, l == 0); SEAM(pb + 0); }
            if (SITE(2) && RUN(pb + 1)) { pg8::Gemm g{Hb, WinT, TC, INC, D, D, D}; pg8::StaticOrder S; S.init(TC, INC, F.G, (int)blockIdx.x);
                pg8::EpiStore<0> E{Zb, INC};
                pg8::gemm_phase<pg8::EpiStore<0>, pg8::StaticOrder, PG8_ALIGN, PG8_SP2>(F.lds + RING_OFF, g, S, E); SEAM(pb + 1); }
            if (SITE(3) && RUN(pb + 2)) { attn_simple_A(F, l, c0); attn_simple_B(F, l, c0); SEAM(pb + 2); }
            if (SITE(4) && RUN(pb + 3)) { pg8::Gemm g{Ob, WbrT, TC, D, 1024, D, D}; pg8::StaticOrder S; S.init(TC, D, F.G, (int)blockIdx.x);
                pg8::EpiGate<0> E{Zb + ZC_GA, INC, nullptr, Hb, D};
                pg8::gemm_phase<pg8::EpiGate<0>, pg8::StaticOrder, PG8_ALIGN, PG8_SP2>(F.lds + RING_OFF, g, S, E); SEAM(pb + 3); }
            if (SITE(5) && RUN(pb + 4)) { pg8::Gemm g{Ob + 1024, WbrT + 1024, TC, D, 1024, D, D}; pg8::StaticOrder S; S.init(TC, D, F.G, (int)blockIdx.x);
                pg8::EpiGate<1> E{Zb + ZC_GB, INC, Hb, Mb, D};
                pg8::gemm_phase<pg8::EpiGate<1>, pg8::StaticOrder, PG8_ALIGN, PG8_SP2>(F.lds + RING_OFF, g, S, E); SEAM(pb + 4); }
            if (SITE(6) && RUN(pb + 5)) { pg8::Gemm g{Mb, WoutT, TC, D, D, D, D}; pg8::StaticOrder S; S.init(TC, D, F.G, (int)blockIdx.x);
                pg8::EpiRes E{l == 0 ? F.in[I_XP] : nullptr, F.in[I_XS], F.out, F.mod + ((size_t)l * NSEQ * 6 + 2) * D, c0};
                pg8::gemm_phase<pg8::EpiRes, pg8::StaticOrder, PG8_ALIGN, PG8_SP2>(F.lds + RING_OFF, g, S, E); SEAM(pb + 5); }
            if (SITE(7) && RUN(pb + 6)) { norm_phase(F, l, 1, c0, false); SEAM(pb + 6); }
            if (SITE(8) && RUN(pb + 7)) { pg8::Gemm g{Hb, W1T, TC, DFF, D, D, D}; pg8::StaticOrder S; S.init(TC, DFF, F.G, (int)blockIdx.x);
                pg8::EpiStore<1> E{Zb, DFF};
                pg8::gemm_phase<pg8::EpiStore<1>, pg8::StaticOrder, PG8_ALIGN, PG8_SP2>(F.lds + RING_OFF, g, S, E); SEAM(pb + 7); }
            if (SITE(9) && RUN(pb + 8)) { pg8::Gemm g{Zb, W2T, TC, D, DFF, DFF, DFF}; pg8::StaticOrder S; S.init(TC, D, F.G, (int)blockIdx.x);
                pg8::EpiRes E{nullptr, F.in[I_XS], F.out, F.mod + ((size_t)l * NSEQ * 6 + 5) * D, c0};
                pg8::gemm_phase<pg8::EpiRes, pg8::StaticOrder, PG8_ALIGN, PG8_SP2>(F.lds + RING_OFF, g, S, E); SEAM(pb + 8); }
        }
#undef RUN
#undef SEAM
}

struct Args { const float* in[N_IN]; float* out; unsigned char* ws; int ph_lo, ph_hi; };
__global__ void __launch_bounds__(NWAVES * 64, 2) enc_fwd(Args a) {
    extern __shared__ __attribute__((aligned(16))) unsigned char lds_raw[];
    Frame F;
    F.lds = (LAS unsigned char*)lds_raw;
    F.tid = threadIdx.x; F.lane = F.tid & 63; F.wave = __builtin_amdgcn_readfirstlane(F.tid >> 6);
    F.G = gridDim.x; F.gw = blockIdx.x * NWAVES + F.wave; F.ngw = F.G * NWAVES;
#pragma unroll
    for (int i = 0; i < N_IN; ++i) F.in[i] = a.in[i];
    F.out = a.out; F.ws = a.ws; F.mod = (float*)(a.ws + WS_MOD);
    gu32* ctl = (gu32*)(a.ws + WS_CTL);
    for (int u = F.tid; u < (LDS_BYTES - LDSCTL_OFF) / 4; u += NWAVES * 64) ((LAS unsigned*)(F.lds + LDSCTL_OFF))[u] = 0u;
    __syncthreads();
    volatile LAS unsigned* MISC = (volatile LAS unsigned*)(F.lds + MISC_OFF);
    XcdBarrier bar = xcd_barrier_post((unsigned*)(ctl + CW_BAR), MISC + 8);
    const int lo = a.ph_lo, hi = a.ph_hi;
#define RUN(ph) ((ph) >= lo && (ph) < hi)
#define SEAM(ph) do { if ((ph) + 1 < hi) xcd_barrier(bar); } while (0)

    if (SITE(0) && RUN(0)) { p0_mod(F); p0_weights(F); SEAM(0); }

    layer_chunk<0, 0>(F, bar, lo, hi); layer_chunk<0, 1>(F, bar, lo, hi); layer_chunk<1, 0>(F, bar, lo, hi); layer_chunk<1, 1>(F, bar, lo, hi);
    if (hi == N_PHASES && blockIdx.x == 0 && F.tid == 0) { if (__hip_atomic_load(ctl + CW_BAR + XB_TMO, RLX_AGENT) != 0u) F.out[0] = __builtin_nanf(""); }
#undef RUN
#undef SEAM
}

extern "C" void kernel_launch(void* const* d_in, const int* in_sizes, int n_in, void* d_out, int out_size, void* d_ws, size_t ws_size, hipStream_t stream) {
    static int grid = 0;
    if (grid == 0) {
        if (n_in != N_IN || out_size != TTOK * D || ws_size < WS_END) { fprintf(stderr, "kernel_launch: shape/workspace mismatch (n_in %d, out %d, ws %zu, need %zu); nothing launched\n", n_in, out_size, ws_size, (size_t)WS_END); grid = -1; return; }
        int dev = 0, cus = 0;
        if (hipGetDevice(&dev) != hipSuccess || hipDeviceGetAttribute(&cus, hipDeviceAttributeMultiprocessorCount, dev) != hipSuccess) { grid = -1; return; }
        if (hipFuncSetAttribute((const void*)enc_fwd, hipFuncAttributeMaxDynamicSharedMemorySize, LDS_BYTES) != hipSuccess) { fprintf(stderr, "kernel_launch: hipFuncSetAttribute failed\n"); grid = -1; return; }
        int per_cu = 0;
        if (hipOccupancyMaxActiveBlocksPerMultiprocessor(&per_cu, (const void*)enc_fwd, NWAVES * 64, LDS_BYTES) != hipSuccess || per_cu < 1) { fprintf(stderr, "kernel_launch: occupancy query says %d blocks per CU\n", per_cu); }
        (void)hipGetLastError();
        grid = cus;
    }
    if (grid < 0) return;
    if (hipMemsetAsync((char*)d_ws + WS_CTL, 0, CTL_ZERO_BYTES, stream) != hipSuccess) return;
    Args a{};
    for (int i = 0; i < N_IN; ++i) a.in[i] = (const float*)d_in[i];
    a.out = (float*)d_out; a.ws = (unsigned char*)d_ws;
#if MK_MULTI
    for (int ph = 0; ph < N_PHASES; ++ph) { a.ph_lo = ph; a.ph_hi = ph + 1; hipLaunchKernelGGL(enc_fwd, dim3(grid), dim3(NWAVES * 64), LDS_BYTES, stream, a); }
#else
    a.ph_lo = 0; a.ph_hi = N_PHASES;
    hipLaunchKernelGGL(enc_fwd, dim3(grid), dim3(NWAVES * 64), LDS_BYTES, stream, a);
#endif
    const hipError_t le = hipPeekAtLastError();
    if (le != hipSuccess) fprintf(stderr, "kernel_launch: launch failed: %s\n", hipGetErrorName(le));
}
```

```cpp
#include <hip/hip_runtime.h>
#include <cstdio>
#include <cstdint>
namespace pg8 {
#define PG8_LAS __attribute__((address_space(3)))
typedef unsigned short bf16_t;
typedef short bf16x8 __attribute__((ext_vector_type(8)));
typedef float f32x4 __attribute__((ext_vector_type(4)));
typedef unsigned u32x4 __attribute__((ext_vector_type(4)));
constexpr int BM = 256, BK = 64, HALF = 128, HTB = HALF * BK * 2  , STAGE_BYTES = 8 * HTB, NXCD = 8, WGM = 8;

__host__ __device__ __forceinline__ int lds_byte(int r, int c) { const int st = (r >> 4) * 2 + (c >> 5), rr = r & 15, cc = c & 31, ob = rr * 64 + cc * 2; return st * 1024 + (ob ^ (((ob >> 9) & 1) << 5)); }
__host__ __device__ __forceinline__ void stage_rc(int b, int& R, int& C) { const int st = b / 1024, sb = b % 1024, swz = sb ^ (((sb >> 9) & 1) << 5); R = (st >> 1) * 16 + swz / 64; C = (st & 1) * 32 + (swz % 64) / 2; }
__host__ __device__ __forceinline__ int perm32(int rho) { const int n = rho >> 4, i = rho & 15; return 8 * (i >> 2) + 4 * n + (i & 3); }

struct Unit { int pm, pn; };
struct Gemm { const bf16_t* A; const bf16_t* Bt; int M, N, K, lda, ldb; };

struct StaticOrder {
    int nM, nN, nwg, G, c;
    __host__ __device__ void init(int M, int N, int G_, int c_) { nM = M / BM; nN = N / BM; nwg = nM * nN; G = G_; c = c_; }
    __host__ __device__ bool next(int i, Unit& u) const {
        const long L = (long)i * G + c; if (L >= nwg) return false;
        int wgid = (int)L; { const int q = nwg / NXCD, r = nwg % NXCD, xcd = wgid % NXCD, off = wgid / NXCD; wgid = (xcd < r ? xcd * (q + 1) : r * (q + 1) + (xcd - r) * q) + off; }
        const int nig = WGM * nN, gid = wgid / nig, fm = gid * WGM, gsz = (nM - fm) < WGM ? (nM - fm) : WGM;
        u.pm = fm + ((wgid % nig) % gsz); u.pn = (wgid % nig) / gsz; return true;
    }
    __device__ __forceinline__ void a_ready(const Unit&) const {}
    __device__ __forceinline__ void done(const Unit&) const {}
};
__device__ __forceinline__ unsigned cvt_pk_bf16(float lo, float hi) { unsigned r; asm volatile("v_cvt_pk_bf16_f32 %0, %1, %2" : "=v"(r) : "v"(lo), "v"(hi)); return r; }
typedef float f32x2 __attribute__((ext_vector_type(2)));
template <class Epi, class Sched, bool ALIGN_EPI = false, bool SP2 = false>
__device__ __forceinline__ void gemm_phase(PG8_LAS unsigned char* lds, const Gemm g, const Sched& S, const Epi& E) {
    const int tid = threadIdx.x, wid = __builtin_amdgcn_readfirstlane(tid >> 6), lane = tid & 63, wr = wid >> 2, wc = wid & 3, fr = lane & 15, fq = lane >> 4;
    const int K = g.K, nt = K / BK;
    unsigned voffA[2], voffB[2];
#pragma unroll
    for (int i = 0; i < 2; ++i) { int R, C; stage_rc(tid * 16 + i * 8192, R, C); const int Rb = Epi::PERM ? ((R & ~31) + perm32(R & 31)) : R;
        voffA[i] = (unsigned)(R * g.lda + C) * 2u; voffB[i] = (unsigned)(Rb * g.ldb + C) * 2u; }
    const size_t kstep = (size_t)(BK * 2);
    const size_t hstepA = (size_t)HALF * g.lda * 2, hstepB = (size_t)HALF * g.ldb * 2;
    const size_t tstepA = 2 * hstepA, tstepB = 2 * hstepB;
    const unsigned ldsw = (unsigned)wid * 1024u;
    const int aoff = lds_byte(wr * 64 + fr, fq * 8), boff = lds_byte(wc * 32 + fr, fq * 8);
#define PG8_SA(b, h) (((b) * 2 + (h)) * HTB)
#define PG8_SB(b, h) ((4 + (b) * 2 + (h)) * HTB)
#define PG8_STAGE(bufoff, gbase, voff) do { _Pragma("unroll") for (int _i = 0; _i < 2; ++_i) \
        __builtin_amdgcn_global_load_lds((const unsigned*)((const char*)(gbase) + (voff)[_i]), (PG8_LAS unsigned*)(lds + (bufoff) + ldsw + _i * 8192), 16, 0, 0); } while (0)
#define PG8_LDA(dst, b, h) do { _Pragma("unroll") for (int m = 0; m < 4; ++m) _Pragma("unroll") for (int k = 0; k < 2; ++k) dst[m][k] = *(const PG8_LAS bf16x8*)(lds + PG8_SA(b, h) + aoff + m * 2048 + k * 1024); } while (0)
#define PG8_LDB(dst, b, h) do { _Pragma("unroll") for (int n = 0; n < 2; ++n) _Pragma("unroll") for (int k = 0; k < 2; ++k) dst[n][k] = *(const PG8_LAS bf16x8*)(lds + PG8_SB(b, h) + boff + n * 2048 + k * 1024); } while (0)
#define PG8_MMA(ai, bj, At, Bt) do { __builtin_amdgcn_s_setprio(1); _Pragma("unroll") for (int m = 0; m < 4; ++m) _Pragma("unroll") for (int n = 0; n < 2; ++n) _Pragma("unroll") for (int k = 0; k < 2; ++k) \
        acc[ai][bj][m][n] = __builtin_amdgcn_mfma_f32_16x16x32_bf16(Bt[n][k], At[m][k], acc[ai][bj][m][n], 0, 0, 0); __builtin_amdgcn_s_setprio(0); } while (0)
#define PG8_WAIT_V(n) asm volatile("s_waitcnt vmcnt(" #n ")" ::: "memory")
#define PG8_WAIT_L(n) asm volatile("s_waitcnt lgkmcnt(" #n ")" ::: "memory")
#define PG8_BAR __builtin_amdgcn_s_barrier()
#define PG8_SCHED __builtin_amdgcn_sched_barrier(0)
    Unit cur, nxt; int ui = 0;
    if (!S.next(0, cur)) return;
    f32x4 acc[2][2][4][2];
#pragma unroll
    for (int a = 0; a < 2; ++a)
#pragma unroll
        for (int b = 0; b < 2; ++b)
#pragma unroll
            for (int m = 0; m < 4; ++m)
#pragma unroll
                for (int n = 0; n < 2; ++n) acc[a][b][m][n] = (f32x4){0.f, 0.f, 0.f, 0.f};
    bf16x8 At[4][2], B0[2][2], B1[2][2];
    const char* cA = (const char*)g.A + (size_t)cur.pm * tstepA; const char* cB = (const char*)g.Bt + (size_t)cur.pn * tstepB;
    S.a_ready(cur);
    if constexpr (SP2) {
        PG8_STAGE(PG8_SB(0, 0), cB, voffB); PG8_STAGE(PG8_SB(0, 1), cB + hstepB, voffB); PG8_STAGE(PG8_SA(0, 0), cA, voffA); PG8_STAGE(PG8_SA(0, 1), cA + hstepA, voffA);
        if (wr == 1) PG8_BAR;
        PG8_WAIT_V(2); PG8_BAR;
        PG8_STAGE(PG8_SB(1, 0), cB + kstep, voffB); PG8_STAGE(PG8_SA(1, 0), cA + kstep, voffA); PG8_STAGE(PG8_SB(1, 1), cB + hstepB + kstep, voffB);
        PG8_WAIT_V(6); PG8_BAR;
    } else {
        PG8_STAGE(PG8_SB(0, 0), cB, voffB); PG8_STAGE(PG8_SA(0, 0), cA, voffA); PG8_STAGE(PG8_SB(0, 1), cB + hstepB, voffB); PG8_STAGE(PG8_SA(0, 1), cA + hstepA, voffA);
        if (wr == 1) PG8_BAR;
        PG8_WAIT_V(4); PG8_BAR;
        PG8_STAGE(PG8_SB(1, 0), cB + kstep, voffB); PG8_STAGE(PG8_SA(1, 0), cA + kstep, voffA); PG8_STAGE(PG8_SB(1, 1), cB + hstepB + kstep, voffB);
        PG8_WAIT_V(6); PG8_BAR;
    }
    for (;;) {
        const bool has_next = S.next(ui + 1, nxt);
        const char* nA = has_next ? (const char*)g.A + (size_t)nxt.pm * tstepA : cA; const char* nB = has_next ? (const char*)g.Bt + (size_t)nxt.pn * tstepB : cB;
        for (int t = 0; t < nt; t += 2) {
            const bool last = (t == nt - 2);
            const char* a1 = cA + (size_t)(t + 1) * kstep;
            const char* a2 = last ? nA : cA + (size_t)(t + 2) * kstep; const char* b2 = last ? nB : cB + (size_t)(t + 2) * kstep;
            const char* a3 = a2 + kstep; const char* b3 = b2 + kstep;
            if (last && has_next) S.a_ready(nxt);
            if constexpr (SP2) {
            PG8_LDB(B0, 0, 0); PG8_LDB(B1, 0, 1); PG8_SCHED; PG8_LDA(At, 0, 0); PG8_STAGE(PG8_SA(1, 1), a1 + hstepA, voffA);
            PG8_WAIT_V(8); PG8_WAIT_L(0); PG8_BAR; PG8_MMA(0, 0, At, B0); PG8_MMA(0, 1, At, B1); PG8_BAR; PG8_SCHED;
            PG8_LDA(At, 0, 1); PG8_STAGE(PG8_SB(0, 0), b2, voffB); PG8_STAGE(PG8_SB(0, 1), b2 + hstepB, voffB); PG8_STAGE(PG8_SA(0, 0), a2, voffA);
            PG8_WAIT_V(8); PG8_WAIT_L(0); PG8_BAR; PG8_MMA(1, 0, At, B0); PG8_MMA(1, 1, At, B1); PG8_BAR; PG8_SCHED;
            PG8_LDB(B0, 1, 0); PG8_LDB(B1, 1, 1); PG8_SCHED; PG8_LDA(At, 1, 0); PG8_STAGE(PG8_SA(0, 1), a2 + hstepA, voffA);
            PG8_WAIT_V(8); PG8_WAIT_L(0); PG8_BAR; PG8_MMA(0, 0, At, B0); PG8_MMA(0, 1, At, B1); PG8_BAR; PG8_SCHED;
            PG8_LDA(At, 1, 1); PG8_STAGE(PG8_SB(1, 0), b3, voffB); PG8_STAGE(PG8_SB(1, 1), b3 + hstepB, voffB); PG8_STAGE(PG8_SA(1, 0), a3, voffA);
            PG8_WAIT_V(8); PG8_WAIT_L(0); PG8_BAR; PG8_MMA(1, 0, At, B0); PG8_MMA(1, 1, At, B1); PG8_BAR; PG8_SCHED;
            } else {
            PG8_LDB(B0, 0, 0); PG8_SCHED; PG8_LDA(At, 0, 0); PG8_STAGE(PG8_SA(1, 1), a1 + hstepA, voffA);
            PG8_WAIT_L(8); PG8_BAR; PG8_WAIT_L(0); PG8_MMA(0, 0, At, B0); PG8_BAR; PG8_SCHED;
            PG8_LDB(B1, 0, 1); PG8_STAGE(PG8_SB(0, 0), b2, voffB);
            PG8_BAR; PG8_WAIT_L(0); PG8_MMA(0, 1, At, B1); PG8_BAR;
            PG8_LDA(At, 0, 1); PG8_STAGE(PG8_SA(0, 0), a2, voffA);
            PG8_BAR; PG8_WAIT_L(0); PG8_MMA(1, 0, At, B0); PG8_BAR; PG8_SCHED;
            PG8_STAGE(PG8_SB(0, 1), b2 + hstepB, voffB);
            PG8_WAIT_V(6); PG8_BAR; PG8_MMA(1, 1, At, B1); PG8_BAR;
            PG8_LDB(B0, 1, 0); PG8_SCHED; PG8_LDA(At, 1, 0); PG8_STAGE(PG8_SA(0, 1), a2 + hstepA, voffA);
            PG8_WAIT_L(8); PG8_BAR; PG8_WAIT_L(0); PG8_MMA(0, 0, At, B0); PG8_BAR; PG8_SCHED;
            PG8_LDB(B1, 1, 1); PG8_STAGE(PG8_SB(1, 0), b3, voffB);
            PG8_BAR; PG8_WAIT_L(0); PG8_MMA(0, 1, At, B1); PG8_BAR;
            PG8_LDA(At, 1, 1); PG8_STAGE(PG8_SA(1, 0), a3, voffA);
            PG8_BAR; PG8_WAIT_L(0); PG8_MMA(1, 0, At, B0); PG8_BAR; PG8_SCHED;
            PG8_STAGE(PG8_SB(1, 1), b3 + hstepB, voffB);
            PG8_WAIT_V(6); PG8_BAR; PG8_MMA(1, 1, At, B1); PG8_BAR;
            }
        }
        if constexpr (ALIGN_EPI) { if (wr == 0) PG8_BAR; }
        if constexpr (!Epi::AFTER_DRAIN) { E(acc, cur, wr, wc, fr, fq); S.done(cur); }
        if (!has_next) break;
#pragma unroll
        for (int a = 0; a < 2; ++a)
#pragma unroll
            for (int b = 0; b < 2; ++b)
#pragma unroll
                for (int m = 0; m < 4; ++m)
#pragma unroll
                    for (int n = 0; n < 2; ++n) acc[a][b][m][n] = (f32x4){0.f, 0.f, 0.f, 0.f};
        cur = nxt; cA = nA; cB = nB; ++ui;
        if constexpr (ALIGN_EPI) { if (wr == 1) PG8_BAR; }
    }
    PG8_WAIT_V(0);
    if constexpr (!ALIGN_EPI) { if (wr == 0) PG8_BAR; }
    PG8_BAR;
    if constexpr (Epi::AFTER_DRAIN) { E.fused(acc, cur, wr, wc, fr, fq, lds, wid, lane); S.done(cur); }
#undef PG8_SA
#undef PG8_SB
#undef PG8_STAGE
#undef PG8_LDA
#undef PG8_LDB
#undef PG8_MMA
#undef PG8_WAIT_V
#undef PG8_WAIT_L
#undef PG8_BAR
#undef PG8_SCHED
}
}

namespace pg8 {
__device__ __forceinline__ float bf_lo(unsigned w) { return __uint_as_float(w << 16); }
__device__ __forceinline__ float bf_hi(unsigned w) { return __uint_as_float(w & 0xffff0000u); }
__device__ __forceinline__ float sigmoidf_fast(float g) { return __builtin_amdgcn_rcpf(1.0f + __builtin_amdgcn_exp2f(-1.4426950408889634f * g)); }

template <int ACT  > struct EpiStore {
    static constexpr bool PERM = true, AFTER_DRAIN = false;
    bf16_t* O; int ldc;
    __device__ __forceinline__ void operator()(const f32x4 (&acc)[2][2][4][2], const Unit& u, int wr, int wc, int fr, int fq) const {
        const int row0 = u.pm * BM + wr * 64 + fr, col0 = u.pn * BM + wc * 32 + 8 * fq;
#pragma unroll
        for (int ai = 0; ai < 2; ++ai)
#pragma unroll
            for (int m = 0; m < 4; ++m) { bf16_t* rowp = O + (size_t)(row0 + ai * HALF + m * 16) * ldc + col0;
#pragma unroll
                for (int bj = 0; bj < 2; ++bj) { f32x4 v0 = acc[ai][bj][m][0], v1 = acc[ai][bj][m][1];
                    if (ACT == 1) { const f32x4 z = (f32x4){0.f, 0.f, 0.f, 0.f}; v0 = __builtin_elementwise_max(v0, z); v1 = __builtin_elementwise_max(v1, z); v0 = v0 * v0; v1 = v1 * v1; }
                    u32x4 w; w.x = cvt_pk_bf16(v0[0], v0[1]); w.y = cvt_pk_bf16(v0[2], v0[3]); w.z = cvt_pk_bf16(v1[0], v1[1]); w.w = cvt_pk_bf16(v1[2], v1[3]);
                    *(u32x4*)(rowp + bj * HALF) = w; } }
    }
};
template <int MODE> struct EpiGate {
    static constexpr bool PERM = true, AFTER_DRAIN = false;
    const bf16_t* G; int ldg; const bf16_t* P; bf16_t* O; int ldo;
    __device__ __forceinline__ void operator()(const f32x4 (&acc)[2][2][4][2], const Unit& u, int wr, int wc, int fr, int fq) const {
        const int row0 = u.pm * BM + wr * 64 + fr, col0 = u.pn * BM + wc * 32 + 8 * fq;
#pragma unroll
        for (int ai = 0; ai < 2; ++ai)
#pragma unroll
            for (int m = 0; m < 4; ++m) { const size_t row = (size_t)(row0 + ai * HALF + m * 16);
#pragma unroll
                for (int bj = 0; bj < 2; ++bj) { const int col = col0 + bj * HALF;
                    const u32x4 gw = *(const u32x4*)(G + row * ldg + col);
                    f32x4 v0 = acc[ai][bj][m][0], v1 = acc[ai][bj][m][1];
                    v0[0] *= sigmoidf_fast(bf_lo(gw.x)); v0[1] *= sigmoidf_fast(bf_hi(gw.x)); v0[2] *= sigmoidf_fast(bf_lo(gw.y)); v0[3] *= sigmoidf_fast(bf_hi(gw.y));
                    v1[0] *= sigmoidf_fast(bf_lo(gw.z)); v1[1] *= sigmoidf_fast(bf_hi(gw.z)); v1[2] *= sigmoidf_fast(bf_lo(gw.w)); v1[3] *= sigmoidf_fast(bf_hi(gw.w));
                    if (MODE == 1) { const u32x4 pw = *(const u32x4*)(P + row * ldo + col);
                        v0[0] += bf_lo(pw.x); v0[1] += bf_hi(pw.x); v0[2] += bf_lo(pw.y); v0[3] += bf_hi(pw.y);
                        v1[0] += bf_lo(pw.z); v1[1] += bf_hi(pw.z); v1[2] += bf_lo(pw.w); v1[3] += bf_hi(pw.w); }
                    u32x4 w; w.x = cvt_pk_bf16(v0[0], v0[1]); w.y = cvt_pk_bf16(v0[2], v0[3]); w.z = cvt_pk_bf16(v1[0], v1[1]); w.w = cvt_pk_bf16(v1[2], v1[3]);
                    *(u32x4*)(O + row * ldo + col) = w; } }
    }
};
struct EpiRes {
    static constexpr bool PERM = false, AFTER_DRAIN = false;
    const float* xp; const float* xs; float* out; const float* modg; int row_off;
    __device__ __forceinline__ void operator()(const f32x4 (&acc)[2][2][4][2], const Unit& u, int wr, int wc, int fr, int fq) const {
        const int rowg = row_off + u.pm * BM;
        const int b = rowg < 32768 ? (rowg >> 11) : 16 + ((rowg - 32768) >> 12);
        const float* gvec = modg + (size_t)b * (6 * 2048);
        const float* base = xp ? (rowg < 32768 ? xp + (size_t)rowg * 2048 : xs + (size_t)(rowg - 32768) * 2048) : out + (size_t)rowg * 2048;
        float* op = out + (size_t)rowg * 2048;
        const int r0 = wr * 64 + fr, col0 = u.pn * BM + wc * 32 + 4 * fq;
        f32x4 gv[2][2];
#pragma unroll
        for (int bj = 0; bj < 2; ++bj)
#pragma unroll
            for (int n = 0; n < 2; ++n) gv[bj][n] = *(const f32x4*)(gvec + col0 + bj * HALF + n * 16);
#pragma unroll
        for (int ai = 0; ai < 2; ++ai)
#pragma unroll
            for (int m = 0; m < 4; ++m) { const size_t off = (size_t)(r0 + ai * HALF + m * 16) * 2048 + col0;
#pragma unroll
                for (int bj = 0; bj < 2; ++bj)
#pragma unroll
                    for (int n = 0; n < 2; ++n) { const f32x4 bs = *(const f32x4*)(base + off + bj * HALF + n * 16);
                        *(f32x4*)(op + off + bj * HALF + n * 16) = bs + gv[bj][n] * acc[ai][bj][m][n]; } }
    }
};
}

#ifndef MK_MULTI
#define MK_MULTI 0
#endif
#ifndef PG8_SP2
#define PG8_SP2 true
#endif
#ifndef PG8_ALIGN
#define PG8_ALIGN true
#endif

constexpr int NWAVES = 8;
constexpr int D = 2048, TTOK = 49152, TP = 32768, NSEQ = 20, INC = 8704, DFF = 8192, HD = 128;
constexpr int TC = 24576, NCH = 2, NLAYER = 2;
constexpr float RMS_EPS = 1e-6f, ATT_SCALE = 0.08838834764831845f, LOG2E = 1.4426950408889634f;
constexpr int ZC_QA = 0, ZC_KA = 1024, ZC_VA = 1280, ZC_QB = 1536, ZC_KB = 2560, ZC_VB = 3584, ZC_GA = 4608, ZC_GB = 6656;
static_assert(TTOK == NCH * TC && TC % 256 == 0 && TP % 256 == 0, "chunks");
enum { I_XP = 0, I_XS, I_CP, I_CS, I_WADA, I_BADA, I_LN1, I_LN2, I_WIN, I_QNA, I_KNA, I_QNB, I_KNB, I_SINK, I_RPB, I_WBRA, I_WBRB, I_WOUT, I_W1, I_W2, N_IN };

constexpr size_t MiB = 1u << 20;
constexpr size_t WS_CTL = 0, CTL_ZERO_BYTES = 1 * MiB;
constexpr size_t WS_MOD = 1 * MiB;
constexpr size_t WS_TBLA = 3 * MiB, WS_TBLB = 4 * MiB;
constexpr size_t WS_W = 8 * MiB, W_LAYER = 114 * MiB;
constexpr size_t WO_IN = 0, WO_BR = 34 * MiB, WO_OUT = 42 * MiB, WO_1 = 50 * MiB, WO_2 = 82 * MiB;
constexpr size_t WS_H = WS_W + 2 * W_LAYER;
constexpr size_t WS_Z = WS_H + 96 * MiB;
constexpr size_t WS_O = WS_Z + 408 * MiB;
constexpr size_t WS_MB = WS_O + 96 * MiB;
constexpr size_t WS_END = WS_MB + 96 * MiB;
static_assert((size_t)INC * 2048 * 2 == 34 * MiB && (size_t)TC * INC * 2 == 408 * MiB && (size_t)TC * D * 2 == 96 * MiB, "sizes");
constexpr int CW_TMO = 0, CW_BAR = 4096;

constexpr int RING_OFF = 0, RING_BYTES = 133120;
constexpr int LDSCTL_OFF = RING_BYTES, MISC_OFF = LDSCTL_OFF + 320;
constexpr int LDS_BYTES = 147456;
static_assert(MISC_OFF + 128 <= LDS_BYTES, "LDS map");

#define GAS __attribute__((address_space(1)))
#define LAS __attribute__((address_space(3)))
typedef unsigned short bf16;
typedef unsigned v4u __attribute__((ext_vector_type(4)));
typedef unsigned v2u __attribute__((ext_vector_type(2)));
typedef float f32x4 __attribute__((ext_vector_type(4)));
typedef GAS unsigned gu32;
#define RLX_AGENT __ATOMIC_RELAXED, __HIP_MEMORY_SCOPE_AGENT
#define LDS_WAIT() asm volatile("s_waitcnt lgkmcnt(0)" ::: "memory")
#define VM_WAIT() asm volatile("s_waitcnt vmcnt(0)" ::: "memory")
__device__ __forceinline__ unsigned f2bf(float f) { unsigned u = __builtin_bit_cast(unsigned, f); return (u + 0x7fffu + ((u >> 16) & 1u)) >> 16; }
__device__ __forceinline__ unsigned pk2(float lo, float hi) { return f2bf(lo) | (f2bf(hi) << 16); }
__device__ __forceinline__ float bflo(unsigned w) { return __uint_as_float(w << 16); }
__device__ __forceinline__ float bfhi(unsigned w) { return __uint_as_float(w & 0xffff0000u); }
__device__ __forceinline__ float wave_sum(float v) {
#pragma unroll
    for (int o = 1; o < 64; o <<= 1) v += __shfl_xor(v, o);
    return v;
}
__device__ __forceinline__ int seq_of(int row) { return row < TP ? (row >> 11) : 16 + ((row - TP) >> 12); }

#define XB_TMO      128
#define XB_XCNT(j)  (256  + 64 * (j))
#define XB_XSUB(j)  (1280 + 64 * (j))
#define XB_XGEN(j)  (2304 + 64 * (j))
#define XB_TOP      3328
#define XB_TOPGEN   3392
#define XCD_BAR_WORDS 3456
#define XB_SPIN_CAP (1u << 18)

__device__ __forceinline__ unsigned xb_ld(unsigned* p)              { return __hip_atomic_load(p, __ATOMIC_RELAXED, __HIP_MEMORY_SCOPE_AGENT); }
__device__ __forceinline__ unsigned xb_add(unsigned* p, unsigned v) { return __hip_atomic_fetch_add(p, v, __ATOMIC_RELAXED, __HIP_MEMORY_SCOPE_AGENT); }
__device__ __forceinline__ unsigned xb_xcc_id() { return (unsigned)__builtin_amdgcn_s_getreg((3 << 11) | 20) & 0xFu; }
#define XB_SPIN(cond, bar) do { unsigned _sp = 0; while (cond) { __builtin_amdgcn_s_sleep(1); \
    if ((++_sp & 255u) == 0u) { if (xb_ld(&(bar)[XB_TMO])) break; if (_sp > XB_SPIN_CAP) { atomicAdd(&(bar)[XB_TMO], 1u); break; } } } } while (0)

struct XcdBarrier {
    unsigned* bar; unsigned x;
    volatile LAS unsigned* st;
};

__device__ __forceinline__ XcdBarrier xcd_barrier_post(unsigned* bar, volatile LAS unsigned* st) {
    XcdBarrier b; b.bar = bar; b.x = xb_xcc_id(); b.st = st;
    if (threadIdx.x == 0) (void)xb_add(&bar[XB_XCNT(b.x)], 1u);
    return b;
}
__device__ __forceinline__ void xcd_barrier_complete(unsigned* bar, unsigned x, unsigned& nloc, unsigned& nx) {
    const unsigned G = gridDim.x * gridDim.y * gridDim.z;
    unsigned sum, cnt, mine, sp = 0u;
    for (;;) {
        sum = 0u; cnt = 0u; mine = 0u;
#pragma unroll
        for (unsigned j = 0; j < 16; ++j) { const unsigned c = xb_ld(&bar[XB_XCNT(j)]); sum += c; cnt += (c > 0u) ? 1u : 0u; mine = (j == x) ? c : mine; }
        if (sum == G) break;
        __builtin_amdgcn_s_sleep(1);
        if ((++sp & 255u) == 0u) { if (xb_ld(&bar[XB_TMO])) break; if (sp > XB_SPIN_CAP) { atomicAdd(&bar[XB_TMO], 1u); break; } }
    }
    nloc = mine > 0u ? mine : 1u; nx = cnt > 0u ? cnt : 1u;
}

__device__ __forceinline__ void xcd_barrier(const XcdBarrier& b) {
    asm volatile("s_waitcnt vmcnt(0)" ::: "memory");
    __syncthreads();
    if (threadIdx.x == 0) {
        unsigned* bar = b.bar;
        __builtin_amdgcn_s_waitcnt(0);
        unsigned nloc = b.st[0], nx = b.st[1];
        if (nloc == 0u) { xcd_barrier_complete(bar, b.x, nloc, nx); b.st[0] = nloc; b.st[1] = nx; }
        const unsigned old = xb_add(&bar[XB_XSUB(b.x)], 1u);
        const unsigned gen = old / nloc;
        if (old + 1u == (gen + 1u) * nloc) {
            __builtin_amdgcn_fence(__ATOMIC_RELEASE, "agent");
            asm volatile("s_waitcnt vmcnt(0)" ::: "memory");
            const unsigned og = xb_add(&bar[XB_TOP], 1u);
            const unsigned tg = og / nx;
            if (og + 1u == (tg + 1u) * nx) xb_add(&bar[XB_TOPGEN], 1u);
            else XB_SPIN(xb_ld(&bar[XB_TOPGEN]) == tg, bar);
            __builtin_amdgcn_fence(__ATOMIC_ACQUIRE, "agent");
            xb_add(&bar[XB_XGEN(b.x)], 1u);
            asm volatile("s_waitcnt vmcnt(0)" ::: "memory");
        } else {
            XB_SPIN(xb_ld(&bar[XB_XGEN(b.x)]) == gen, bar);
            __builtin_amdgcn_fence(__ATOMIC_ACQUIRE, "agent");
            asm volatile("s_waitcnt vmcnt(0)" ::: "memory");
        }
    }
    __syncthreads();
}


struct Frame {
    LAS unsigned char* lds;
    int tid, lane, wave, G, gw, ngw;
    const float* in[N_IN];
    float* out; unsigned char* ws;
    float* mod;
};

__device__ __forceinline__ void transpose_item(const float* W, int N, bf16* WT, int ldT, int koff, LAS float* scr, int item, int lane) {
    const int nblk = N / 32, kb = item / nblk, nb = item - kb * nblk, k0 = 64 * kb, n0 = 32 * nb;
#pragma unroll 8
    for (int i = 0; i < 32; ++i) { const int kk = 2 * i + (lane >> 5); scr[kk * 33 + (lane & 31)] = W[(size_t)(k0 + kk) * N + n0 + (lane & 31)]; }
    LDS_WAIT(); asm volatile("" ::: "memory");
    const int c = lane & 7;
#pragma unroll
    for (int j = 0; j < 4; ++j) { const int n = (lane >> 3) + 8 * j; const LAS float* s = scr + (8 * c) * 33 + n;
        v4u o; o.x = pk2(s[0 * 33], s[1 * 33]); o.y = pk2(s[2 * 33], s[3 * 33]); o.z = pk2(s[4 * 33], s[5 * 33]); o.w = pk2(s[6 * 33], s[7 * 33]);
        *(GAS v4u*)(WT + (size_t)(n0 + n) * ldT + koff + k0 + 8 * c) = o; }
    LDS_WAIT(); asm volatile("" ::: "memory");
}

__device__ __forceinline__ void p0_weights(Frame& F) {
    LAS float* scr = (LAS float*)(F.lds + RING_OFF + F.wave * 16384);
    constexpr int I_IN = (D / 64) * (INC / 32), I_BR = (1024 / 64) * (D / 32), I_OUT = (D / 64) * (D / 32), I_1 = (D / 64) * (DFF / 32), I_2 = (DFF / 64) * (D / 32);
    constexpr int PER_LAYER = I_IN + 2 * I_BR + I_OUT + I_1 + I_2;
    for (int it = F.gw; it < NLAYER * PER_LAYER; it += F.ngw) {
        const int l = it / PER_LAYER; int r = it - l * PER_LAYER;
        unsigned char* wl = F.ws + WS_W + (size_t)l * W_LAYER;
        if (r < I_IN) { transpose_item(F.in[I_WIN] + (size_t)l * D * INC, INC, (bf16*)(wl + WO_IN), D, 0, scr, r, F.lane); continue; } r -= I_IN;
        if (r < I_BR) { transpose_item(F.in[I_WBRA] + (size_t)l * 1024 * D, D, (bf16*)(wl + WO_BR), 2048, 0, scr, r, F.lane); continue; } r -= I_BR;
        if (r < I_BR) { transpose_item(F.in[I_WBRB] + (size_t)l * 1024 * D, D, (bf16*)(wl + WO_BR), 2048, 1024, scr, r, F.lane); continue; } r -= I_BR;
        if (r < I_OUT) { transpose_item(F.in[I_WOUT] + (size_t)l * D * D, D, (bf16*)(wl + WO_OUT), D, 0, scr, r, F.lane); continue; } r -= I_OUT;
        if (r < I_1) { transpose_item(F.in[I_W1] + (size_t)l * D * DFF, DFF, (bf16*)(wl + WO_1), D, 0, scr, r, F.lane); continue; } r -= I_1;
        transpose_item(F.in[I_W2] + (size_t)l * DFF * D, D, (bf16*)(wl + WO_2), DFF, 0, scr, r, F.lane);
    }
}

__device__ __forceinline__ void p0_mod(Frame& F) {
    LAS float* scr = (LAS float*)(F.lds + RING_OFF + F.wave * 8192);
    LAS float* red = (LAS float*)(F.lds + RING_OFF + 65536);
    const float* cp = F.in[I_CP]; const float* cs = F.in[I_CS];
    for (int task = blockIdx.x; task < NLAYER * 192; task += F.G) {
        const int l = task / 192, n0 = (task - l * 192) * 64;
        const float* W = F.in[I_WADA] + (size_t)l * D * 12288 + n0 + F.lane;
        float acc[NSEQ];
#pragma unroll
        for (int b = 0; b < NSEQ; ++b) acc[b] = 0.f;
        for (int kc = 0; kc < 4; ++kc) {
            const int k0 = F.wave * 256 + kc * 64;
#pragma unroll
            for (int b = 0; b < NSEQ; ++b) { const float cv = (b < 16) ? cp[b * D + k0 + F.lane] : cs[(b - 16) * D + k0 + F.lane];
                scr[F.lane * NSEQ + b] = cv / (1.0f + __expf(-cv)); }
            LDS_WAIT(); asm volatile("" ::: "memory");
#pragma unroll 4
            for (int kk = 0; kk < 64; ++kk) { const float w = W[(size_t)(k0 + kk) * 12288];
#pragma unroll
                for (int b = 0; b < NSEQ; ++b) acc[b] = fmaf(scr[kk * NSEQ + b], w, acc[b]); }
            LDS_WAIT(); asm volatile("" ::: "memory");
        }
#pragma unroll
        for (int b = 0; b < NSEQ; ++b) red[(F.wave * NSEQ + b) * 64 + F.lane] = acc[b];
        __syncthreads();
        for (int idx = F.tid; idx < NSEQ * 64; idx += NWAVES * 64) { const int b = idx >> 6, ln = idx & 63; float s = 0.f;
#pragma unroll
            for (int w = 0; w < NWAVES; ++w) s += red[(w * NSEQ + b) * 64 + ln];
            F.mod[((size_t)l * NSEQ + b) * 12288 + n0 + ln] = s + F.in[I_BADA][l * 12288 + n0 + ln]; }
        __syncthreads();
    }
}

__device__ __forceinline__ void norm_phase(Frame& F, int l, int which, int c0, bool from_inputs) {
    bf16* H = (bf16*)(F.ws + WS_H);
    const float* lnw = F.in[which ? I_LN2 : I_LN1] + l * D;
    for (int tl = F.gw; tl < TC; tl += F.ngw) {
        const int row = c0 + tl, b = seq_of(row);
        const float* xrow = from_inputs ? (row < TP ? F.in[I_XP] + (size_t)row * D : F.in[I_XS] + (size_t)(row - TP) * D) : F.out + (size_t)row * D;
        const float* sh = F.mod + (((size_t)l * NSEQ + b) * 6 + which * 3) * D; const float* sc = sh + D;
        const GAS f32x4* xr = (const GAS f32x4*)xrow + F.lane;
        f32x4 v[8]; float ss = 0.f;
#pragma unroll
        for (int j = 0; j < 8; ++j) { v[j] = xr[64 * j]; ss += (v[j].x * v[j].x + v[j].y * v[j].y) + (v[j].z * v[j].z + v[j].w * v[j].w); }
        const float rstd = rsqrtf(wave_sum(ss) * (1.f / D) + RMS_EPS);
        GAS v2u* o8 = (GAS v2u*)(H + (size_t)tl * D) + F.lane;
#pragma unroll
        for (int j = 0; j < 8; ++j) { const int col = 4 * F.lane + 256 * j;
            const f32x4 g = *(const f32x4*)(lnw + col), s1 = *(const f32x4*)(sc + col), s0 = *(const f32x4*)(sh + col);
            const f32x4 y = (v[j] * rstd) * g * (s1 + 1.0f) + s0;
            v2u w; w.x = pk2(y.x, y.y); w.y = pk2(y.z, y.w); o8[64 * j] = w; }
    }
}

__device__ __forceinline__ void attn_simple_A(Frame& F, int l, int c0) {
    const bf16* Z = (const bf16*)(F.ws + WS_Z); bf16* O = (bf16*)(F.ws + WS_O);
    const float* qn = F.in[I_QNA] + l * HD; const float* kn = F.in[I_KNA] + l * HD; const float* sink = F.in[I_SINK] + l * 8;
    const float g0 = qn[2 * F.lane] * kn[2 * F.lane] * ATT_SCALE, g1 = qn[2 * F.lane + 1] * kn[2 * F.lane + 1] * ATT_SCALE;
    for (int item = F.gw; item < TC * 8; item += F.ngw) {
        const int tl = item >> 3, h = item & 7, kvh = h >> 2, row = c0 + tl;
        const int S = row < TP ? 2048 : 4096, pos = row < TP ? (row & 2047) : ((row - TP) & 4095);
        const bf16* zr = Z + (size_t)tl * INC;
        const unsigned qw = *(const unsigned*)(zr + ZC_QA + h * HD + 2 * F.lane);
        float q0 = bflo(qw), q1 = bfhi(qw);
        const float rq = rsqrtf(wave_sum(q0 * q0 + q1 * q1) * (1.f / HD) + RMS_EPS);
        q0 *= rq * g0; q1 *= rq * g1;
        float m = sink[h], lsum = 1.f, o0 = 0.f, o1 = 0.f;
        const float slope = exp2f(-(float)(h + 1));
        const int slo = pos - 128 < 0 ? 0 : pos - 128, shi = pos + 128 > S - 1 ? S - 1 : pos + 128;
        for (int s = slo; s <= shi; ++s) {
            const bf16* kr = zr + (ptrdiff_t)(s - pos) * INC;
            const unsigned kw = *(const unsigned*)(kr + ZC_KA + kvh * HD + 2 * F.lane), vw = *(const unsigned*)(kr + ZC_VA + kvh * HD + 2 * F.lane);
            const float k0 = bflo(kw), k1 = bfhi(kw);
            float dot = q0 * k0 + q1 * k1, kss = k0 * k0 + k1 * k1;
#pragma unroll
            for (int o = 1; o < 64; o <<= 1) { dot += __shfl_xor(dot, o); kss += __shfl_xor(kss, o); }
            const float sc = dot * rsqrtf(kss * (1.f / HD) + RMS_EPS) - slope * fabsf((float)(pos - s));
            const float mn = fmaxf(m, sc), al = __expf(m - mn), p = __expf(sc - mn);
            lsum = lsum * al + p; o0 = o0 * al + p * bflo(vw); o1 = o1 * al + p * bfhi(vw); m = mn;
        }
        const float inv = 1.f / lsum;
        *(unsigned*)(O + (size_t)tl * D + h * HD + 2 * F.lane) = pk2(o0 * inv, o1 * inv);
    }
}
__device__ __forceinline__ void attn_simple_B(Frame& F, int l, int c0) {
    const bf16* Z = (const bf16*)(F.ws + WS_Z); bf16* O = (bf16*)(F.ws + WS_O);
    const float* qn = F.in[I_QNB] + l * HD; const float* kn = F.in[I_KNB] + l * HD; const float* rpb = F.in[I_RPB] + (size_t)l * 8 * 15 * 31;
    const float g0 = qn[2 * F.lane] * kn[2 * F.lane] * ATT_SCALE, g1 = qn[2 * F.lane + 1] * kn[2 * F.lane + 1] * ATT_SCALE;
    for (int item = F.gw; item < TC * 8; item += F.ngw) {
        const int tl = item >> 3, h = item & 7, row = c0 + tl;
        const int S = row < TP ? 2048 : 4096, pos = row < TP ? (row & 2047) : ((row - TP) & 4095), rows = S >> 6;
        const int r = pos >> 6, c = pos & 63;
        const int r0 = r - 4 < 0 ? 0 : (r - 4 > rows - 8 ? rows - 8 : r - 4), cc0 = c - 8 < 0 ? 0 : (c - 8 > 48 ? 48 : c - 8);
        const bf16* zr = Z + (size_t)tl * INC;
        const unsigned qw = *(const unsigned*)(zr + ZC_QB + h * HD + 2 * F.lane);
        float q0 = bflo(qw), q1 = bfhi(qw);
        const float rq = rsqrtf(wave_sum(q0 * q0 + q1 * q1) * (1.f / HD) + RMS_EPS);
        q0 *= rq * g0; q1 *= rq * g1;
        float m = -1e30f, lsum = 0.f, o0 = 0.f, o1 = 0.f;
        for (int j = 0; j < 8; ++j) { const int kr_ = r0 + j, dr = kr_ - r + 7;
            for (int kk = 0; kk < 16; ++kk) { const int kc = cc0 + kk; int dcv = kc - c; dcv = dcv < -15 ? -15 : (dcv > 15 ? 15 : dcv);
                const float bias = rpb[(h * 15 + dr) * 31 + dcv + 15];
                const bf16* kp = zr + (ptrdiff_t)(kr_ * 64 + kc - pos) * INC;
                const unsigned kw = *(const unsigned*)(kp + ZC_KB + h * HD + 2 * F.lane), vw = *(const unsigned*)(kp + ZC_VB + h * HD + 2 * F.lane);
                const float k0 = bflo(kw), k1 = bfhi(kw);
                float dot = q0 * k0 + q1 * k1, kss = k0 * k0 + k1 * k1;
#pragma unroll
                for (int o = 1; o < 64; o <<= 1) { dot += __shfl_xor(dot, o); kss += __shfl_xor(kss, o); }
                const float sc = dot * rsqrtf(kss * (1.f / HD) + RMS_EPS) + bias;
                const float mn = fmaxf(m, sc), al = __expf(m - mn), p = __expf(sc - mn);
                lsum = lsum * al + p; o0 = o0 * al + p * bflo(vw); o1 = o1 * al + p * bfhi(vw); m = mn; } }
        const float inv = 1.f / lsum;
        *(unsigned*)(O + (size_t)tl * D + 1024 + h * HD + 2 * F.lane) = pk2(o0 * inv, o1 * inv);
    }
}


namespace att {
typedef short bf16x8 __attribute__((ext_vector_type(8)));
typedef short s16x4 __attribute__((ext_vector_type(4)));
typedef float f32x16 __attribute__((ext_vector_type(16)));
typedef float f32x4 __attribute__((ext_vector_type(4)));
typedef unsigned u32x4 __attribute__((ext_vector_type(4)));
constexpr int SHM_V = 64 * 128 * 2, SHM_K = 64 * 128 * 2;
constexpr int OFF_V = 0, OFF_K = 2 * SHM_V, OFF_WS = 2 * SHM_V + 2 * SHM_K, ATT_LDS = OFF_WS + 8 * 64 * 4;
constexpr float THR_L2 = 11.5f;
#define ATT_KSWZ(row, colB) ((row) * 256 + ((colB) ^ (((row) & 7) << 4)))
#define ATT_SBAR() __builtin_amdgcn_sched_barrier(0)
__device__ __forceinline__ int crow(int r, int hi) { return (r & 3) + 8 * (r >> 2) + 4 * hi; }
__device__ __forceinline__ unsigned cvtpk(float lo, float hi) { unsigned r; asm volatile("v_cvt_pk_bf16_f32 %0, %1, %2" : "=v"(r) : "v"(lo), "v"(hi)); return r; }
__device__ __forceinline__ void qkt(f32x16& p0, f32x16& p1, const LAS unsigned char* Ks, const bf16x8 (&qr)[8], int r32, int hi) {
#pragma unroll
    for (int d0 = 0; d0 < 8; ++d0) { const int cb = (d0 * 16 + hi * 8) * 2;
        const bf16x8 b0 = *(const LAS bf16x8*)(Ks + ATT_KSWZ(r32, cb));
        const bf16x8 b1 = *(const LAS bf16x8*)(Ks + ATT_KSWZ(32 + r32, cb));
        p0 = __builtin_amdgcn_mfma_f32_32x32x16_bf16(b0, qr[d0], p0, 0, 0, 0);
        p1 = __builtin_amdgcn_mfma_f32_32x32x16_bf16(b1, qr[d0], p1, 0, 0, 0); }
}
__device__ __forceinline__ int v_st(int k, int c) { const int kk = (k & ~0xC) | ((k & 4) << 1) | ((k & 8) >> 1); return ((kk >> 3) * 4 + (c >> 5)) * 512 + ((kk & 7) * 32 + (c & 31)) * 2; }
__device__ __forceinline__ int v_rd_base(int lane) { return ((lane & 3) << 3) | (((lane >> 2) & 3) << 6) | (((lane >> 4) & 1) << 5) | (((lane >> 5) & 1) << 8); }
constexpr int v_rd_off(int d0, int ks, int half) { return d0 * 512 + ks * 4096 + half * 2048; }
template <int OFF> __device__ __forceinline__ s16x4 tr_read(int vb) { s16x4 r; asm volatile("ds_read_b64_tr_b16 %0, %1 offset:%2" : "=&v"(r) : "v"(vb), "i"(OFF) : "memory"); return r; }
template <int D0> __device__ __forceinline__ void pv_one(f32x16& od, int vb, bf16x8 pa0, bf16x8 pa1, bf16x8 pa2, bf16x8 pa3) {
    const s16x4 l0 = tr_read<v_rd_off(D0, 0, 0)>(vb), h0 = tr_read<v_rd_off(D0, 0, 1)>(vb), l1 = tr_read<v_rd_off(D0, 1, 0)>(vb), h1 = tr_read<v_rd_off(D0, 1, 1)>(vb);
    const s16x4 l2 = tr_read<v_rd_off(D0, 2, 0)>(vb), h2 = tr_read<v_rd_off(D0, 2, 1)>(vb), l3 = tr_read<v_rd_off(D0, 3, 0)>(vb), h3 = tr_read<v_rd_off(D0, 3, 1)>(vb);
    asm volatile("s_waitcnt lgkmcnt(0)" ::: "memory"); ATT_SBAR();
#define ATT_PK(L, H) (bf16x8){L[0], L[1], L[2], L[3], H[0], H[1], H[2], H[3]}
    od = __builtin_amdgcn_mfma_f32_32x32x16_bf16(pa0, ATT_PK(l0, h0), od, 0, 0, 0);
    od = __builtin_amdgcn_mfma_f32_32x32x16_bf16(pa1, ATT_PK(l1, h1), od, 0, 0, 0);
    od = __builtin_amdgcn_mfma_f32_32x32x16_bf16(pa2, ATT_PK(l2, h2), od, 0, 0, 0);
    od = __builtin_amdgcn_mfma_f32_32x32x16_bf16(pa3, ATT_PK(l3, h3), od, 0, 0, 0);
#undef ATT_PK
}
__device__ __forceinline__ void pv_d0(f32x16 (&o)[4], int vb, bf16x8 pa0, bf16x8 pa1, bf16x8 pa2, bf16x8 pa3) {
    pv_one<0>(o[0], vb, pa0, pa1, pa2, pa3); pv_one<1>(o[1], vb, pa0, pa1, pa2, pa3); pv_one<2>(o[2], vb, pa0, pa1, pa2, pa3); pv_one<3>(o[3], vb, pa0, pa1, pa2, pa3);
}
__device__ __forceinline__ float swap_max(float v) { auto rr = __builtin_amdgcn_permlane32_swap(__float_as_uint(v), __float_as_uint(v), false, false); return fmaxf(__uint_as_float(rr[0]), __uint_as_float(rr[1])); }
__device__ __forceinline__ float swap_add(float v) { auto rr = __builtin_amdgcn_permlane32_swap(__float_as_uint(v), __float_as_uint(v), false, false); return __uint_as_float(rr[0]) + __uint_as_float(rr[1]); }
__device__ __forceinline__ bf16x8 knorm8(bf16x8 raw, const float (&g)[8]) {
    const u32x4 w = __builtin_bit_cast(u32x4, raw);
    float f[8] = {__uint_as_float(w.x << 16), __uint_as_float(w.x & 0xffff0000u), __uint_as_float(w.y << 16), __uint_as_float(w.y & 0xffff0000u),
                  __uint_as_float(w.z << 16), __uint_as_float(w.z & 0xffff0000u), __uint_as_float(w.w << 16), __uint_as_float(w.w & 0xffff0000u)};
    float ss = 0.f;
#pragma unroll
    for (int i = 0; i < 8; ++i) ss = fmaf(f[i], f[i], ss);
    ss += __shfl_xor(ss, 1); ss += __shfl_xor(ss, 2); ss += __shfl_xor(ss, 4); ss += __shfl_xor(ss, 8);
    const float rs = rsqrtf(ss * (1.f / 128.f) + 1e-6f);
    u32x4 o; o.x = cvtpk(f[0] * rs * g[0], f[1] * rs * g[1]); o.y = cvtpk(f[2] * rs * g[2], f[3] * rs * g[3]); o.z = cvtpk(f[4] * rs * g[4], f[5] * rs * g[5]); o.w = cvtpk(f[6] * rs * g[6], f[7] * rs * g[7]);
    return __builtin_bit_cast(bf16x8, o);
}

constexpr int OFF_T = 2 * SHM_V + 2 * SHM_K, OFF_WS2 = OFF_T + 8 * 8192, ATT_LDS2 = OFF_WS2 + 8 * 256;
__device__ __forceinline__ void glds16(const void* g, LAS unsigned char* l) { __builtin_amdgcn_global_load_lds((const unsigned*)g, (LAS unsigned*)l, 16, 0, 0); }
template <int LDZ, int LDO, class TblFn>
__device__ __forceinline__ void attn_unit(const bf16* __restrict__ Zq, const bf16* __restrict__ Zk, const bf16* __restrict__ Zv, bf16* __restrict__ Ob, const int NT,
                                          const TblFn& tbl, const float sink_l2, LAS unsigned char* lds, const int tid) {
    const int wid = __builtin_amdgcn_readfirstlane(tid >> 6), lane = tid & 63, r32 = lane & 31, hi = lane >> 5;
    LAS unsigned char* V_lds = lds + OFF_V; LAS unsigned char* K_lds = lds + OFF_K; LAS unsigned char* T_lds = lds + OFF_T + wid * 8192;
    LAS float* wsf = (LAS float*)(lds + OFF_WS2) + wid * 64; LAS float* li_l = wsf; LAS float* al_l = wsf + 32;
    const LAS float* li_h = li_l + 4 * hi; const LAS float* al_h = al_l + 4 * hi;
    constexpr float C = 0.08838834764831845f * 1.4426950408889634f;
    float m_reg = -1e30f, l_reg = 0.f; f32x16 o[4] = {}; bf16x8 qr[8];
    { const bf16* Qw = Zq + (size_t)(wid * 32 + r32) * LDZ + hi * 8;
#pragma unroll
      for (int d0 = 0; d0 < 8; ++d0) qr[d0] = *(const bf16x8*)(Qw + d0 * 16); }
    unsigned kof[2], vof[2];
#pragma unroll
    for (int i = 0; i < 2; ++i) { const int p = (wid * 2 + i) * 64 + lane;
        { const int row = p >> 4, ch = (p & 15) ^ (row & 7); kof[i] = (unsigned)(row * LDZ + ch * 8); }
        { const int sub = p >> 5, g = p & 31, kk = (sub >> 2) * 8 + (g >> 2), c = (sub & 3) * 32 + (g & 3) * 8, k = (kk & ~0xC) | ((kk & 4) << 1) | ((kk & 8) >> 1);
          vof[i] = (unsigned)(k * LDZ + c); } }
    const int vb0 = (int)(unsigned)(uintptr_t)V_lds + v_rd_base(lane);
#define ATT_STAGE(t, b) do { const bf16* _k = Zk + (size_t)(t) * 64 * LDZ; const bf16* _v = Zv + (size_t)(t) * 64 * LDZ; \
        glds16(_k + kof[0], K_lds + (b) * SHM_K + (wid * 2) * 1024); glds16(_k + kof[1], K_lds + (b) * SHM_K + (wid * 2 + 1) * 1024); \
        glds16(_v + vof[0], V_lds + (b) * SHM_V + (wid * 2) * 1024); glds16(_v + vof[1], V_lds + (b) * SHM_V + (wid * 2 + 1) * 1024); } while (0)
#define ATT_TSTAGE(tp_) do { _Pragma("unroll") for (int i = 0; i < 8; ++i) glds16((tp_) + (i * 64 + lane) * 4, T_lds + i * 1024); } while (0)
    const float* tp = tbl(0);
    ATT_STAGE(0, 0); if (tp != nullptr) ATT_TSTAGE(tp);
    asm volatile("s_waitcnt vmcnt(0)" ::: "memory"); __syncthreads();
    for (int j = 0; j < NT; ++j) {
        const int b = j & 1;
        if (j + 1 < NT) ATT_STAGE(j + 1, b ^ 1);
        const float* tpn = (j + 1 < NT) ? tbl(j + 1) : nullptr;
        if (tp != nullptr) {
            f32x16 p0, p1;
#pragma unroll
            for (int i = 0; i < 4; ++i) { const f32x4 a = *(const LAS f32x4*)(T_lds + (i * 64 + lane) * 16), c4 = *(const LAS f32x4*)(T_lds + ((4 + i) * 64 + lane) * 16);
                p0[4 * i + 0] = a.x; p0[4 * i + 1] = a.y; p0[4 * i + 2] = a.z; p0[4 * i + 3] = a.w; p1[4 * i + 0] = c4.x; p1[4 * i + 1] = c4.y; p1[4 * i + 2] = c4.z; p1[4 * i + 3] = c4.w; }
            asm volatile("s_waitcnt lgkmcnt(0)" ::: "memory");
            if (tpn != nullptr) ATT_TSTAGE(tpn);
            qkt(p0, p1, K_lds + b * SHM_K, qr, r32, hi);
            float pmax = p0[0];
#pragma unroll
            for (int r = 1; r < 16; ++r) pmax = fmaxf(pmax, p0[r]);
#pragma unroll
            for (int r = 0; r < 16; ++r) pmax = fmaxf(pmax, p1[r]);
            pmax = swap_max(pmax) * C;
            if (!__all(pmax - m_reg <= THR_L2)) {
                const float mn = fmaxf(m_reg, pmax), alpha = __builtin_amdgcn_exp2f(m_reg - mn); m_reg = mn; l_reg *= alpha;
                if (hi == 0) al_l[r32] = alpha;
                asm volatile("s_waitcnt lgkmcnt(0)" ::: "memory");
#pragma unroll
                for (int d = 0; d < 4; ++d)
#pragma unroll
                    for (int r = 0; r < 16; ++r) o[d][r] *= al_h[(r & 3) + 8 * (r >> 2)];
            }
            float ps = 0.f; const float nm = -m_reg;
#pragma unroll
            for (int r = 0; r < 16; ++r) { p0[r] = __builtin_amdgcn_exp2f(fmaf(p0[r], C, nm)); p1[r] = __builtin_amdgcn_exp2f(fmaf(p1[r], C, nm)); ps += p0[r] + p1[r]; }
            l_reg += swap_add(ps);
            bf16x8 pa0, pa1, pa2, pa3;
#define ATT_PK4(P, BASE, OUT) do { const unsigned a0 = cvtpk(P[BASE + 0], P[BASE + 1]), a1 = cvtpk(P[BASE + 2], P[BASE + 3]); \
            const unsigned b0 = cvtpk(P[BASE + 4], P[BASE + 5]), b1 = cvtpk(P[BASE + 6], P[BASE + 7]); \
            auto r0 = __builtin_amdgcn_permlane32_swap(a0, b0, false, false); auto r1 = __builtin_amdgcn_permlane32_swap(a1, b1, false, false); \
            u32x4 w = {r0[0], r1[0], r0[1], r1[1]}; OUT = __builtin_bit_cast(bf16x8, w); } while (0)
            ATT_PK4(p0, 0, pa0); ATT_PK4(p0, 8, pa1); ATT_PK4(p1, 0, pa2); ATT_PK4(p1, 8, pa3);
#undef ATT_PK4
            pv_d0(o, vb0 + b * SHM_V, pa0, pa1, pa2, pa3);
        } else if (tpn != nullptr) ATT_TSTAGE(tpn);
        tp = tpn;
        asm volatile("s_waitcnt vmcnt(0)" ::: "memory"); __syncthreads();
    }
#undef ATT_STAGE
#undef ATT_TSTAGE
    l_reg += __builtin_amdgcn_exp2f(sink_l2 - m_reg);
    if (hi == 0) li_l[r32] = l_reg;
    asm volatile("s_waitcnt lgkmcnt(0)" ::: "memory");
    { LAS unsigned short* St = (LAS unsigned short*)T_lds + hi * (4 * 128) + r32;
#pragma unroll
      for (int r = 0; r < 16; ++r) { const float rl = __builtin_amdgcn_rcpf(li_h[(r & 3) + 8 * (r >> 2)]);
#pragma unroll
          for (int d0 = 0; d0 < 4; ++d0) { const float v = o[d0][r] * rl; St[((r & 3) + 8 * (r >> 2)) * 128 + d0 * 32] = (unsigned short)(cvtpk(v, v) & 0xffffu); } }
      asm volatile("s_waitcnt lgkmcnt(0)" ::: "memory");
      bf16* Ow = Ob + (size_t)(wid * 32 + (lane >> 4)) * LDO + (lane & 15) * 8;
#pragma unroll
      for (int i = 0; i < 8; ++i) { const u32x4 w = *(const LAS u32x4*)(T_lds + i * 1024 + lane * 16); *(u32x4*)(Ow + (size_t)(i * 4) * LDO) = w; }
      asm volatile("s_waitcnt lgkmcnt(0)" ::: "memory"); }
}
}

__device__ __forceinline__ void p0_tables(Frame& F) {
    float* tA = (float*)(F.ws + WS_TBLA); float* tB = (float*)(F.ws + WS_TBLB);
    const float ninf = -__builtin_inff();
    const int gt = blockIdx.x * (NWAVES * 64) + F.tid, ngt = F.G * NWAVES * 64;
    for (int e = gt; e < 8 * 10 * 2048; e += ngt) {
        const int h = e / 20480, rem = e - h * 20480, idx = rem >> 11, w_ = rem & 2047, i = w_ >> 8, lane = (w_ >> 2) & 63, ee = w_ & 3;
        const int r = 4 * (i & 3) + ee, hi = lane >> 5, q = lane & 31, key = ((i >> 2) << 5) + att::crow(r, hi);
        const int d = 32 * idx - 128 + q - key, ad = d < 0 ? -d : d;
        tA[e] = ad <= 128 ? -exp2f(-(float)(h + 1)) * (float)ad * (1.0f / ATT_SCALE) : ninf;
    }
    for (int e = gt; e < NLAYER * 8 * 15 * 2 * 2048; e += ngt) {
        const int w_ = e & 2047, t = e >> 11, wc = t & 1, t2 = t >> 1, dr = t2 % 15, t3 = t2 / 15, h = t3 & 7, l = t3 >> 3;
        const int i = w_ >> 8, lane = (w_ >> 2) & 63, ee = w_ & 3, r = 4 * (i & 3) + ee, hi = lane >> 5, q = lane & 31, kc = ((i >> 2) << 5) + att::crow(r, hi);
        const int c = 32 * wc + q, cc0 = c - 8 < 0 ? 0 : (c - 8 > 48 ? 48 : c - 8);
        int dcv = kc - c; dcv = dcv < -15 ? -15 : (dcv > 15 ? 15 : dcv);
        const bool ok = kc >= cc0 && kc < cc0 + 16;
        tB[e] = ok ? F.in[I_RPB][((l * 8 + h) * 15 + dr) * 31 + dcv + 15] * (1.0f / ATT_SCALE) : ninf;
    }
}


__device__ __forceinline__ void qk_norm_phase(Frame& F, const int l) {
    bf16* Z = (bf16*)(F.ws + WS_Z);
    const int sub = F.lane >> 4, li = F.lane & 15;
    for (int tl = F.gw; tl < TC; tl += F.ngw) {
        bf16* zr = Z + (size_t)tl * INC;
#pragma unroll
        for (int it = 0; it < 7; ++it) { const int hh = it * 4 + sub;
            if (hh < 26) {
                const int col = (hh < 10 ? hh * HD : 1536 + (hh - 10) * HD) + li * 8;
                const float* g = F.in[hh < 8 ? I_QNA : (hh < 10 ? I_KNA : (hh < 18 ? I_QNB : I_KNB))] + l * HD + li * 8;
                const v4u w = *(const v4u*)(zr + col);
                float f[8] = {bflo(w.x), bfhi(w.x), bflo(w.y), bfhi(w.y), bflo(w.z), bfhi(w.z), bflo(w.w), bfhi(w.w)};
                float ss = 0.f;
#pragma unroll
                for (int i = 0; i < 8; ++i) ss = fmaf(f[i], f[i], ss);
                ss += __shfl_xor(ss, 1); ss += __shfl_xor(ss, 2); ss += __shfl_xor(ss, 4); ss += __shfl_xor(ss, 8);
                const float rs = rsqrtf(ss * (1.f / HD) + RMS_EPS);
                const f32x4 g0 = *(const f32x4*)g, g1 = *(const f32x4*)(g + 4);
                v4u o; o.x = pk2(f[0] * rs * g0.x, f[1] * rs * g0.y); o.y = pk2(f[2] * rs * g0.z, f[3] * rs * g0.w); o.z = pk2(f[4] * rs * g1.x, f[5] * rs * g1.y); o.w = pk2(f[6] * rs * g1.z, f[7] * rs * g1.w);
                *(v4u*)(zr + col) = o;
            } }
    }
}

template <int MIXER> __device__ __forceinline__ void attn_fast(Frame& F, const int l, const int c0) {
    const bf16* Z = (const bf16*)(F.ws + WS_Z); bf16* O = (bf16*)(F.ws + WS_O);
    const float* tblA = (const float*)(F.ws + WS_TBLA); const float* tblB = (const float*)(F.ws + WS_TBLB) + (size_t)l * (8 * 15 * 2 * 2048);
    for (int ui = blockIdx.x; ui < (TC / 256) * 8; ui += F.G) {
        const int qb = ui >> 3, h = ui & 7, row0 = c0 + qb * 256;
        const int S = row0 < TP ? 2048 : 4096, pos0 = row0 < TP ? (row0 & 2047) : ((row0 - TP) & 4095);
        const int lq = qb * 256;
        if (MIXER == 0) {
            const int kvh = h >> 2, jlo = pos0 == 0 ? 2 : 0, jhi = (pos0 + 256 == S) ? 5 : 7, NT = jhi - jlo + 1;
            const int lk = lq - 128 + 64 * jlo;
            const float* tb = tblA + (size_t)h * (10 * 2048);
            const int wv = F.wave;
            auto tfn = [=](int j) -> const float* { const int idx = wv - 2 * (jlo + j) + 8; return ((unsigned)idx < 10u) ? tb + idx * 2048 : nullptr; };
            att::attn_unit<INC, D>(Z + (size_t)lq * INC + ZC_QA + h * HD, Z + (size_t)lk * INC + ZC_KA + kvh * HD, Z + (size_t)lk * INC + ZC_VA + kvh * HD,
                                   O + (size_t)lq * D + h * HD, NT, tfn, F.in[I_SINK][l * 8 + h] * LOG2E, F.lds + RING_OFF, F.tid);
        } else {
            const int rows = S >> 6, u4 = pos0 >> 6;
            const int lo_ = u4 - 4 < 0 ? 0 : (u4 - 4 > rows - 8 ? rows - 8 : u4 - 4), hiq = u4 + 3 - 4 < 0 ? 0 : (u4 - 1 > rows - 8 ? rows - 8 : u4 - 1);
            const int NT = hiq + 7 - lo_ + 1, lk = lq - pos0 + 64 * lo_;
            const int r = u4 + (F.wave >> 1), r0 = r - 4 < 0 ? 0 : (r - 4 > rows - 8 ? rows - 8 : r - 4);
            const float* tb = tblB + (size_t)(h * 15 * 2 + (F.wave & 1)) * 2048;
            auto tfn = [=](int j) -> const float* { const int kr = lo_ + j; return (kr >= r0 && kr <= r0 + 7) ? tb + (kr - r + 7) * (2 * 2048) : nullptr; };
            att::attn_unit<INC, D>(Z + (size_t)lq * INC + ZC_QB + h * HD, Z + (size_t)lk * INC + ZC_KB + h * HD, Z + (size_t)lk * INC + ZC_VB + h * HD,
                                   O + (size_t)lq * D + 1024 + h * HD, NT, tfn, -__builtin_inff(), F.lds + RING_OFF, F.tid);
        }
    }
}

#ifndef ATTN_FAST
#define ATTN_FAST 1
#endif
#ifndef SITE_MASK
#define SITE_MASK 0xffff
#endif
#define SITE(k) ((SITE_MASK >> (k)) & 1)
constexpr int PH_PER = 9, N_PHASES = 1 + 2 * 2 * PH_PER;
template <int l, int c> __device__ __forceinline__ void layer_chunk(Frame& F, const XcdBarrier& bar, const int lo, const int hi) {
#define RUN(ph) ((ph) >= lo && (ph) < hi)
#define SEAM(ph) do { if ((ph) + 1 < hi) xcd_barrier(bar); } while (0)
        unsigned char* wl = F.ws + WS_W + (size_t)l * W_LAYER;
        const pg8::bf16_t* WinT = (const pg8::bf16_t*)(wl + WO_IN); const pg8::bf16_t* WbrT = (const pg8::bf16_t*)(wl + WO_BR); const pg8::bf16_t* WoutT = (const pg8::bf16_t*)(wl + WO_OUT);
        const pg8::bf16_t* W1T = (const pg8::bf16_t*)(wl + WO_1); const pg8::bf16_t* W2T = (const pg8::bf16_t*)(wl + WO_2);
        pg8::bf16_t* Hb = (pg8::bf16_t*)(F.ws + WS_H); pg8::bf16_t* Zb = (pg8::bf16_t*)(F.ws + WS_Z); pg8::bf16_t* Ob = (pg8::bf16_t*)(F.ws + WS_O); pg8::bf16_t* Mb = (pg8::bf16_t*)(F.ws + WS_MB);
        {
            const int c0 = c * TC, pb = 1 + (l * NCH + c) * PH_PER;
            if (SITE(1) && RUN(pb + 0)) { norm_phase(F, l, 0, c0, l == 0); SEAM(pb + 0); }
            if (SITE(2) && RUN(pb + 1)) { pg8::Gemm g{Hb, WinT, TC, INC, D, D, D}; pg8::StaticOrder S; S.init(TC, INC, F.G, (int)blockIdx.x);
                pg8::EpiStore<0> E{Zb, INC};
                pg8::gemm_phase<pg8::EpiStore<0>, pg8::StaticOrder, PG8_ALIGN, PG8_SP2>(F.lds + RING_OFF, g, S, E); SEAM(pb + 1); }
            if (SITE(3) && RUN(pb + 2)) {
#if ATTN_FAST
                qk_norm_phase(F, l); xcd_barrier(bar); attn_fast<0>(F, l, c0); attn_fast<1>(F, l, c0);
#else
                attn_simple_A(F, l, c0); attn_simple_B(F, l, c0);
#endif
                SEAM(pb + 2); }
            if (SITE(4) && RUN(pb + 3)) { pg8::Gemm g{Ob, WbrT, TC, D, 1024, D, D}; pg8::StaticOrder S; S.init(TC, D, F.G, (int)blockIdx.x);
                pg8::EpiGate<0> E{Zb + ZC_GA, INC, nullptr, Hb, D};
                pg8::gemm_phase<pg8::EpiGate<0>, pg8::StaticOrder, PG8_ALIGN, PG8_SP2>(F.lds + RING_OFF, g, S, E); SEAM(pb + 3); }
            if (SITE(5) && RUN(pb + 4)) { pg8::Gemm g{Ob + 1024, WbrT + 1024, TC, D, 1024, D, D}; pg8::StaticOrder S; S.init(TC, D, F.G, (int)blockIdx.x);
                pg8::EpiGate<1> E{Zb + ZC_GB, INC, Hb, Mb, D};
                pg8::gemm_phase<pg8::EpiGate<1>, pg8::StaticOrder, PG8_ALIGN, PG8_SP2>(F.lds + RING_OFF, g, S, E); SEAM(pb + 4); }
            if (SITE(6) && RUN(pb + 5)) { pg8::Gemm g{Mb, WoutT, TC, D, D, D, D}; pg8::StaticOrder S; S.init(TC, D, F.G, (int)blockIdx.x);
                pg8::EpiRes E{l == 0 ? F.in[I_XP] : nullptr, F.in[I_XS], F.out, F.mod + ((size_t)l * NSEQ * 6 + 2) * D, c0};
                pg8::gemm_phase<pg8::EpiRes, pg8::StaticOrder, PG8_ALIGN, PG8_SP2>(F.lds + RING_OFF, g, S, E); SEAM(pb + 5); }
            if (SITE(7) && RUN(pb + 6)) { norm_phase(F, l, 1, c0, false); SEAM(pb + 6); }
            if (SITE(8) && RUN(pb + 7)) { pg8::Gemm g{Hb, W1T, TC, DFF, D, D, D}; pg8::StaticOrder S; S.init(TC, DFF, F.G, (int)blockIdx.x);
                pg8::EpiStore<1> E{Zb, DFF};
                pg8::gemm_phase<pg8::EpiStore<1>, pg8::StaticOrder, PG8_ALIGN, PG8_SP2>(F.lds + RING_OFF, g, S, E); SEAM(pb + 7); }
            if (SITE(9) && RUN(pb + 8)) { pg8::Gemm g{Zb, W2T, TC, D, DFF, DFF, DFF}; pg8::StaticOrder S; S.init(TC, D, F.G, (int)blockIdx.x);
                pg8::EpiRes E{nullptr, F.in[I_XS], F.out, F.mod + ((size_t)l * NSEQ * 6 + 5) * D, c0};
                pg8::gemm_phase<pg8::EpiRes, pg8::StaticOrder, PG8_ALIGN, PG8_SP2>(F.lds + RING_OFF, g, S, E); SEAM(pb + 8); }
        }
#undef RUN
#undef SEAM
}

struct Args { const float* in[N_IN]; float* out; unsigned char* ws; int ph_lo, ph_hi; };
__global__ void __launch_bounds__(NWAVES * 64, 2) enc_fwd(Args a) {
    extern __shared__ __attribute__((aligned(16))) unsigned char lds_raw[];
    Frame F;
    F.lds = (LAS unsigned char*)lds_raw;
    F.tid = threadIdx.x; F.lane = F.tid & 63; F.wave = __builtin_amdgcn_readfirstlane(F.tid >> 6);
    F.G = gridDim.x; F.gw = blockIdx.x * NWAVES + F.wave; F.ngw = F.G * NWAVES;
#pragma unroll
    for (int i = 0; i < N_IN; ++i) F.in[i] = a.in[i];
    F.out = a.out; F.ws = a.ws; F.mod = (float*)(a.ws + WS_MOD);
    gu32* ctl = (gu32*)(a.ws + WS_CTL);
    for (int u = F.tid; u < (LDS_BYTES - LDSCTL_OFF) / 4; u += NWAVES * 64) ((LAS unsigned*)(F.lds + LDSCTL_OFF))[u] = 0u;
    __syncthreads();
    volatile LAS unsigned* MISC = (volatile LAS unsigned*)(F.lds + MISC_OFF);
    XcdBarrier bar = xcd_barrier_post((unsigned*)(ctl + CW_BAR), MISC + 8);
    const int lo = a.ph_lo, hi = a.ph_hi;
#define RUN(ph) ((ph) >= lo && (ph) < hi)
#define SEAM(ph) do { if ((ph) + 1 < hi) xcd_barrier(bar); } while (0)

    if (SITE(0) && RUN(0)) { p0_mod(F); p0_tables(F); p0_weights(F); SEAM(0); }

    layer_chunk<0, 0>(F, bar, lo, hi); layer_chunk<0, 1>(F, bar, lo, hi); layer_chunk<1, 0>(F, bar, lo, hi); layer_chunk<1, 1>(F, bar, lo, hi);
    if (hi == N_PHASES && blockIdx.x == 0 && F.tid == 0) { if (__hip_atomic_load(ctl + CW_BAR + XB_TMO, RLX_AGENT) != 0u) F.out[0] = __builtin_nanf(""); }
#undef RUN
#undef SEAM
}

extern "C" void kernel_launch(void* const* d_in, const int* in_sizes, int n_in, void* d_out, int out_size, void* d_ws, size_t ws_size, hipStream_t stream) {
    static int grid = 0;
    if (grid == 0) {
        if (n_in != N_IN || out_size != TTOK * D || ws_size < WS_END) { fprintf(stderr, "kernel_launch: shape/workspace mismatch (n_in %d, out %d, ws %zu, need %zu); nothing launched\n", n_in, out_size, ws_size, (size_t)WS_END); grid = -1; return; }
        int dev = 0, cus = 0;
        if (hipGetDevice(&dev) != hipSuccess || hipDeviceGetAttribute(&cus, hipDeviceAttributeMultiprocessorCount, dev) != hipSuccess) { grid = -1; return; }
        if (hipFuncSetAttribute((const void*)enc_fwd, hipFuncAttributeMaxDynamicSharedMemorySize, LDS_BYTES) != hipSuccess) { fprintf(stderr, "kernel_launch: hipFuncSetAttribute failed\n"); grid = -1; return; }
        int per_cu = 0;
        if (hipOccupancyMaxActiveBlocksPerMultiprocessor(&per_cu, (const void*)enc_fwd, NWAVES * 64, LDS_BYTES) != hipSuccess || per_cu < 1) { fprintf(stderr, "kernel_launch: occupancy query says %d blocks per CU\n", per_cu); }
        (void)hipGetLastError();
        grid = cus;
    }
    if (grid < 0) return;
    if (hipMemsetAsync((char*)d_ws + WS_CTL, 0, CTL_ZERO_BYTES, stream) != hipSuccess) return;
    Args a{};
    for (int i = 0; i < N_IN; ++i) a.in[i] = (const float*)d_in[i];
    a.out = (float*)d_out; a.ws = (unsigned char*)d_ws;
#if MK_MULTI
    for (int ph = 0; ph < N_PHASES; ++ph) { a.ph_lo = ph; a.ph_hi = ph + 1; hipLaunchKernelGGL(enc_fwd, dim3(grid), dim3(NWAVES * 64), LDS_BYTES, stream, a); }
#else
    a.ph_lo = 0; a.ph_hi = N_PHASES;
    hipLaunchKernelGGL(enc_fwd, dim3(grid), dim3(NWAVES * 64), LDS_BYTES, stream, a);
#endif
    const hipError_t le = hipPeekAtLastError();
    if (le != hipSuccess) fprintf(stderr, "kernel_launch: launch failed: %s\n", hipGetErrorName(le));
}
```

```cpp
#include <hip/hip_runtime.h>
#include <cstdio>
#include <cstdint>
namespace pg8 {
#define PG8_LAS __attribute__((address_space(3)))
typedef unsigned short bf16_t;
typedef short bf16x8 __attribute__((ext_vector_type(8)));
typedef float f32x4 __attribute__((ext_vector_type(4)));
typedef unsigned u32x4 __attribute__((ext_vector_type(4)));
constexpr int BM = 256, BK = 64, HALF = 128, HTB = HALF * BK * 2  , STAGE_BYTES = 8 * HTB, NXCD = 8, WGM = 8;

__host__ __device__ __forceinline__ int lds_byte(int r, int c) { const int st = (r >> 4) * 2 + (c >> 5), rr = r & 15, cc = c & 31, ob = rr * 64 + cc * 2; return st * 1024 + (ob ^ (((ob >> 9) & 1) << 5)); }
__host__ __device__ __forceinline__ void stage_rc(int b, int& R, int& C) { const int st = b / 1024, sb = b % 1024, swz = sb ^ (((sb >> 9) & 1) << 5); R = (st >> 1) * 16 + swz / 64; C = (st & 1) * 32 + (swz % 64) / 2; }
__host__ __device__ __forceinline__ int perm32(int rho) { const int n = rho >> 4, i = rho & 15; return 8 * (i >> 2) + 4 * n + (i & 3); }

struct Unit { int pm, pn; };
struct Gemm { const bf16_t* A; const bf16_t* Bt; int M, N, K, lda, ldb; };

struct StaticOrder {
    int nM, nN, nwg, G, c;
    __host__ __device__ void init(int M, int N, int G_, int c_) { nM = M / BM; nN = N / BM; nwg = nM * nN; G = G_; c = c_; }
    __host__ __device__ bool next(int i, Unit& u) const {
        const long L = (long)i * G + c; if (L >= nwg) return false;
        int wgid = (int)L; { const int q = nwg / NXCD, r = nwg % NXCD, xcd = wgid % NXCD, off = wgid / NXCD; wgid = (xcd < r ? xcd * (q + 1) : r * (q + 1) + (xcd - r) * q) + off; }
        const int nig = WGM * nN, gid = wgid / nig, fm = gid * WGM, gsz = (nM - fm) < WGM ? (nM - fm) : WGM;
        u.pm = fm + ((wgid % nig) % gsz); u.pn = (wgid % nig) / gsz; return true;
    }
    __device__ __forceinline__ void a_ready(const Unit&) const {}
    __device__ __forceinline__ void done(const Unit&) const {}
};
__device__ __forceinline__ unsigned cvt_pk_bf16(float lo, float hi) { unsigned r; asm volatile("v_cvt_pk_bf16_f32 %0, %1, %2" : "=v"(r) : "v"(lo), "v"(hi)); return r; }
typedef float f32x2 __attribute__((ext_vector_type(2)));
template <class Epi, class Sched, bool ALIGN_EPI = false, bool SP2 = false>
__device__ __forceinline__ void gemm_phase(PG8_LAS unsigned char* lds, const Gemm g, const Sched& S, const Epi& E) {
    const int tid = threadIdx.x, wid = __builtin_amdgcn_readfirstlane(tid >> 6), lane = tid & 63, wr = wid >> 2, wc = wid & 3, fr = lane & 15, fq = lane >> 4;
    const int K = g.K, nt = K / BK;
    unsigned voffA[2], voffB[2];
#pragma unroll
    for (int i = 0; i < 2; ++i) { int R, C; stage_rc(tid * 16 + i * 8192, R, C); const int Rb = Epi::PERM ? ((R & ~31) + perm32(R & 31)) : R;
        voffA[i] = (unsigned)(R * g.lda + C) * 2u; voffB[i] = (unsigned)(Rb * g.ldb + C) * 2u; }
    const size_t kstep = (size_t)(BK * 2);
    const size_t hstepA = (size_t)HALF * g.lda * 2, hstepB = (size_t)HALF * g.ldb * 2;
    const size_t tstepA = 2 * hstepA, tstepB = 2 * hstepB;
    const unsigned ldsw = (unsigned)wid * 1024u;
    const int aoff = lds_byte(wr * 64 + fr, fq * 8), boff = lds_byte(wc * 32 + fr, fq * 8);
#define PG8_SA(b, h) (((b) * 2 + (h)) * HTB)
#define PG8_SB(b, h) ((4 + (b) * 2 + (h)) * HTB)
#define PG8_STAGE(bufoff, gbase, voff) do { _Pragma("unroll") for (int _i = 0; _i < 2; ++_i) \
        __builtin_amdgcn_global_load_lds((const unsigned*)((const char*)(gbase) + (voff)[_i]), (PG8_LAS unsigned*)(lds + (bufoff) + ldsw + _i * 8192), 16, 0, 0); } while (0)
#define PG8_LDA(dst, b, h) do { _Pragma("unroll") for (int m = 0; m < 4; ++m) _Pragma("unroll") for (int k = 0; k < 2; ++k) dst[m][k] = *(const PG8_LAS bf16x8*)(lds + PG8_SA(b, h) + aoff + m * 2048 + k * 1024); } while (0)
#define PG8_LDB(dst, b, h) do { _Pragma("unroll") for (int n = 0; n < 2; ++n) _Pragma("unroll") for (int k = 0; k < 2; ++k) dst[n][k] = *(const PG8_LAS bf16x8*)(lds + PG8_SB(b, h) + boff + n * 2048 + k * 1024); } while (0)
#define PG8_MMA(ai, bj, At, Bt) do { __builtin_amdgcn_s_setprio(1); _Pragma("unroll") for (int m = 0; m < 4; ++m) _Pragma("unroll") for (int n = 0; n < 2; ++n) _Pragma("unroll") for (int k = 0; k < 2; ++k) \
        acc[ai][bj][m][n] = __builtin_amdgcn_mfma_f32_16x16x32_bf16(Bt[n][k], At[m][k], acc[ai][bj][m][n], 0, 0, 0); __builtin_amdgcn_s_setprio(0); } while (0)
#define PG8_WAIT_V(n) asm volatile("s_waitcnt vmcnt(" #n ")" ::: "memory")
#define PG8_WAIT_L(n) asm volatile("s_waitcnt lgkmcnt(" #n ")" ::: "memory")
#define PG8_BAR __builtin_amdgcn_s_barrier()
#define PG8_SCHED __builtin_amdgcn_sched_barrier(0)
    Unit cur, nxt; int ui = 0;
    if (!S.next(0, cur)) return;
    f32x4 acc[2][2][4][2];
#pragma unroll
    for (int a = 0; a < 2; ++a)
#pragma unroll
        for (int b = 0; b < 2; ++b)
#pragma unroll
            for (int m = 0; m < 4; ++m)
#pragma unroll
                for (int n = 0; n < 2; ++n) acc[a][b][m][n] = (f32x4){0.f, 0.f, 0.f, 0.f};
    bf16x8 At[4][2], B0[2][2], B1[2][2];
    const char* cA = (const char*)g.A + (size_t)cur.pm * tstepA; const char* cB = (const char*)g.Bt + (size_t)cur.pn * tstepB;
    S.a_ready(cur);
    if constexpr (SP2) {
        PG8_STAGE(PG8_SB(0, 0), cB, voffB); PG8_STAGE(PG8_SB(0, 1), cB + hstepB, voffB); PG8_STAGE(PG8_SA(0, 0), cA, voffA); PG8_STAGE(PG8_SA(0, 1), cA + hstepA, voffA);
        if (wr == 1) PG8_BAR;
        PG8_WAIT_V(2); PG8_BAR;
        PG8_STAGE(PG8_SB(1, 0), cB + kstep, voffB); PG8_STAGE(PG8_SA(1, 0), cA + kstep, voffA); PG8_STAGE(PG8_SB(1, 1), cB + hstepB + kstep, voffB);
        PG8_WAIT_V(6); PG8_BAR;
    } else {
        PG8_STAGE(PG8_SB(0, 0), cB, voffB); PG8_STAGE(PG8_SA(0, 0), cA, voffA); PG8_STAGE(PG8_SB(0, 1), cB + hstepB, voffB); PG8_STAGE(PG8_SA(0, 1), cA + hstepA, voffA);
        if (wr == 1) PG8_BAR;
        PG8_WAIT_V(4); PG8_BAR;
        PG8_STAGE(PG8_SB(1, 0), cB + kstep, voffB); PG8_STAGE(PG8_SA(1, 0), cA + kstep, voffA); PG8_STAGE(PG8_SB(1, 1), cB + hstepB + kstep, voffB);
        PG8_WAIT_V(6); PG8_BAR;
    }
    for (;;) {
        const bool has_next = S.next(ui + 1, nxt);
        const char* nA = has_next ? (const char*)g.A + (size_t)nxt.pm * tstepA : cA; const char* nB = has_next ? (const char*)g.Bt + (size_t)nxt.pn * tstepB : cB;
        for (int t = 0; t < nt; t += 2) {
            const bool last = (t == nt - 2);
            const char* a1 = cA + (size_t)(t + 1) * kstep;
            const char* a2 = last ? nA : cA + (size_t)(t + 2) * kstep; const char* b2 = last ? nB : cB + (size_t)(t + 2) * kstep;
            const char* a3 = a2 + kstep; const char* b3 = b2 + kstep;
            if (last && has_next) S.a_ready(nxt);
            if constexpr (SP2) {
            PG8_LDB(B0, 0, 0); PG8_LDB(B1, 0, 1); PG8_SCHED; PG8_LDA(At, 0, 0); PG8_STAGE(PG8_SA(1, 1), a1 + hstepA, voffA);
            PG8_WAIT_V(8); PG8_WAIT_L(0); PG8_BAR; PG8_MMA(0, 0, At, B0); PG8_MMA(0, 1, At, B1); PG8_BAR; PG8_SCHED;
            PG8_LDA(At, 0, 1); PG8_STAGE(PG8_SB(0, 0), b2, voffB); PG8_STAGE(PG8_SB(0, 1), b2 + hstepB, voffB); PG8_STAGE(PG8_SA(0, 0), a2, voffA);
            PG8_WAIT_V(8); PG8_WAIT_L(0); PG8_BAR; PG8_MMA(1, 0, At, B0); PG8_MMA(1, 1, At, B1); PG8_BAR; PG8_SCHED;
            PG8_LDB(B0, 1, 0); PG8_LDB(B1, 1, 1); PG8_SCHED; PG8_LDA(At, 1, 0); PG8_STAGE(PG8_SA(0, 1), a2 + hstepA, voffA);
            PG8_WAIT_V(8); PG8_WAIT_L(0); PG8_BAR; PG8_MMA(0, 0, At, B0); PG8_MMA(0, 1, At, B1); PG8_BAR; PG8_SCHED;
            PG8_LDA(At, 1, 1); PG8_STAGE(PG8_SB(1, 0), b3, voffB); PG8_STAGE(PG8_SB(1, 1), b3 + hstepB, voffB); PG8_STAGE(PG8_SA(1, 0), a3, voffA);
            PG8_WAIT_V(8); PG8_WAIT_L(0); PG8_BAR; PG8_MMA(1, 0, At, B0); PG8_MMA(1, 1, At, B1); PG8_BAR; PG8_SCHED;
            } else {
            PG8_LDB(B0, 0, 0); PG8_SCHED; PG8_LDA(At, 0, 0); PG8_STAGE(PG8_SA(1, 1), a1 + hstepA, voffA);
            PG8_WAIT_L(8); PG8_BAR; PG8_WAIT_L(0); PG8_MMA(0, 0, At, B0); PG8_BAR; PG8_SCHED;
            PG8_LDB(B1, 0, 1); PG8_STAGE(PG8_SB(0, 0), b2, voffB);
            PG8_BAR; PG8_WAIT_L(0); PG8_MMA(0, 1, At, B1); PG8_BAR;
            PG8_LDA(At, 0, 1); PG8_STAGE(PG8_SA(0, 0), a2, voffA);
            PG8_BAR; PG8_WAIT_L(0); PG8_MMA(1, 0, At, B0); PG8_BAR; PG8_SCHED;
            PG8_STAGE(PG8_SB(0, 1), b2 + hstepB, voffB);
            PG8_WAIT_V(6); PG8_BAR; PG8_MMA(1, 1, At, B1); PG8_BAR;
            PG8_LDB(B0, 1, 0); PG8_SCHED; PG8_LDA(At, 1, 0); PG8_STAGE(PG8_SA(0, 1), a2 + hstepA, voffA);
            PG8_WAIT_L(8); PG8_BAR; PG8_WAIT_L(0); PG8_MMA(0, 0, At, B0); PG8_BAR; PG8_SCHED;
            PG8_LDB(B1, 1, 1); PG8_STAGE(PG8_SB(1, 0), b3, voffB);
            PG8_BAR; PG8_WAIT_L(0); PG8_MMA(0, 1, At, B1); PG8_BAR;
            PG8_LDA(At, 1, 1); PG8_STAGE(PG8_SA(1, 0), a3, voffA);
            PG8_BAR; PG8_WAIT_L(0); PG8_MMA(1, 0, At, B0); PG8_BAR; PG8_SCHED;
            PG8_STAGE(PG8_SB(1, 1), b3 + hstepB, voffB);
            PG8_WAIT_V(6); PG8_BAR; PG8_MMA(1, 1, At, B1); PG8_BAR;
            }
        }
        if constexpr (ALIGN_EPI) { if (wr == 0) PG8_BAR; }
        if constexpr (!Epi::AFTER_DRAIN) { E(acc, cur, wr, wc, fr, fq); S.done(cur); }
        if (!has_next) break;
#pragma unroll
        for (int a = 0; a < 2; ++a)
#pragma unroll
            for (int b = 0; b < 2; ++b)
#pragma unroll
                for (int m = 0; m < 4; ++m)
#pragma unroll
                    for (int n = 0; n < 2; ++n) acc[a][b][m][n] = (f32x4){0.f, 0.f, 0.f, 0.f};
        cur = nxt; cA = nA; cB = nB; ++ui;
        if constexpr (ALIGN_EPI) { if (wr == 1) PG8_BAR; }
    }
    PG8_WAIT_V(0);
    if constexpr (!ALIGN_EPI) { if (wr == 0) PG8_BAR; }
    PG8_BAR;
    if constexpr (Epi::AFTER_DRAIN) { E.fused(acc, cur, wr, wc, fr, fq, lds, wid, lane); S.done(cur); }
#undef PG8_SA
#undef PG8_SB
#undef PG8_STAGE
#undef PG8_LDA
#undef PG8_LDB
#undef PG8_MMA
#undef PG8_WAIT_V
#undef PG8_WAIT_L
#undef PG8_BAR
#undef PG8_SCHED
}
}

namespace pg8 {
__device__ __forceinline__ float bf_lo(unsigned w) { return __uint_as_float(w << 16); }
__device__ __forceinline__ float bf_hi(unsigned w) { return __uint_as_float(w & 0xffff0000u); }
__device__ __forceinline__ float sigmoidf_fast(float g) { return __builtin_amdgcn_rcpf(1.0f + __builtin_amdgcn_exp2f(-1.4426950408889634f * g)); }

template <int ACT  > struct EpiStore {
    static constexpr bool PERM = true, AFTER_DRAIN = false;
    bf16_t* O; int ldc;
    __device__ __forceinline__ void operator()(const f32x4 (&acc)[2][2][4][2], const Unit& u, int wr, int wc, int fr, int fq) const {
        const int row0 = u.pm * BM + wr * 64 + fr, col0 = u.pn * BM + wc * 32 + 8 * fq;
#pragma unroll
        for (int ai = 0; ai < 2; ++ai)
#pragma unroll
            for (int m = 0; m < 4; ++m) { bf16_t* rowp = O + (size_t)(row0 + ai * HALF + m * 16) * ldc + col0;
#pragma unroll
                for (int bj = 0; bj < 2; ++bj) { f32x4 v0 = acc[ai][bj][m][0], v1 = acc[ai][bj][m][1];
                    if (ACT == 1) { const f32x4 z = (f32x4){0.f, 0.f, 0.f, 0.f}; v0 = __builtin_elementwise_max(v0, z); v1 = __builtin_elementwise_max(v1, z); v0 = v0 * v0; v1 = v1 * v1; }
                    u32x4 w; w.x = cvt_pk_bf16(v0[0], v0[1]); w.y = cvt_pk_bf16(v0[2], v0[3]); w.z = cvt_pk_bf16(v1[0], v1[1]); w.w = cvt_pk_bf16(v1[2], v1[3]);
                    *(u32x4*)(rowp + bj * HALF) = w; } }
    }
};
struct EpiZ {
    static constexpr bool PERM = true, AFTER_DRAIN = false;
    bf16_t* O; int ldc; const float* qna; const float* kna; const float* qnb; const float* knb; PG8_LAS float* part;
    __device__ __forceinline__ void operator()(const f32x4 (&acc)[2][2][4][2], const Unit& u, int wr, int wc, int fr, int fq) const {
        const int row0 = u.pm * BM + wr * 64 + fr, col0 = u.pn * BM + wc * 32 + 8 * fq;
        const float* gain = u.pn < 4 ? qna : (u.pn == 4 ? kna : (u.pn == 5 ? nullptr : (u.pn < 10 ? qnb : (u.pn < 14 ? knb : nullptr))));
        float rs[2][4][2];
        f32x4 g0 = (f32x4){1.f, 1.f, 1.f, 1.f}, g1 = g0;
        if (gain != nullptr) {
#pragma unroll
            for (int ai = 0; ai < 2; ++ai)
#pragma unroll
                for (int m = 0; m < 4; ++m)
#pragma unroll
                    for (int bj = 0; bj < 2; ++bj) { const f32x4 a = acc[ai][bj][m][0], b = acc[ai][bj][m][1];
                        float ss = (a[0] * a[0] + a[1] * a[1]) + (a[2] * a[2] + a[3] * a[3]) + (b[0] * b[0] + b[1] * b[1]) + (b[2] * b[2] + b[3] * b[3]);
                        ss += __shfl_xor(ss, 16); ss += __shfl_xor(ss, 32);
                        if (fq == 0) part[((ai * HALF + wr * 64 + m * 16 + fr) * 2 + bj) * 4 + wc] = ss; }
            asm volatile("s_waitcnt lgkmcnt(0)" ::: "memory"); __builtin_amdgcn_s_barrier(); asm volatile("" ::: "memory");
#pragma unroll
            for (int ai = 0; ai < 2; ++ai)
#pragma unroll
                for (int m = 0; m < 4; ++m)
#pragma unroll
                    for (int bj = 0; bj < 2; ++bj) { const f32x4 p = *(const PG8_LAS f32x4*)(part + ((ai * HALF + wr * 64 + m * 16 + fr) * 2 + bj) * 4);
                        rs[ai][m][bj] = rsqrtf(((p[0] + p[1]) + (p[2] + p[3])) * (1.f / 128.f) + 1e-6f); }
            g0 = *(const f32x4*)(gain + wc * 32 + 8 * fq); g1 = *(const f32x4*)(gain + wc * 32 + 8 * fq + 4);
        } else {
#pragma unroll
            for (int ai = 0; ai < 2; ++ai)
#pragma unroll
                for (int m = 0; m < 4; ++m) { rs[ai][m][0] = 1.f; rs[ai][m][1] = 1.f; }
        }
#pragma unroll
        for (int ai = 0; ai < 2; ++ai)
#pragma unroll
            for (int m = 0; m < 4; ++m) { bf16_t* rowp = O + (size_t)(row0 + ai * HALF + m * 16) * ldc + col0;
#pragma unroll
                for (int bj = 0; bj < 2; ++bj) { const f32x4 v0 = acc[ai][bj][m][0] * g0 * rs[ai][m][bj], v1 = acc[ai][bj][m][1] * g1 * rs[ai][m][bj];
                    u32x4 w; w.x = cvt_pk_bf16(v0[0], v0[1]); w.y = cvt_pk_bf16(v0[2], v0[3]); w.z = cvt_pk_bf16(v1[0], v1[1]); w.w = cvt_pk_bf16(v1[2], v1[3]);
                    *(u32x4*)(rowp + bj * HALF) = w; } }
    }
};
template <int MODE> struct EpiGate {
    static constexpr bool PERM = true, AFTER_DRAIN = false;
    const bf16_t* G; int ldg; const bf16_t* P; bf16_t* O; int ldo;
    __device__ __forceinline__ void operator()(const f32x4 (&acc)[2][2][4][2], const Unit& u, int wr, int wc, int fr, int fq) const {
        const int row0 = u.pm * BM + wr * 64 + fr, col0 = u.pn * BM + wc * 32 + 8 * fq;
#pragma unroll
        for (int ai = 0; ai < 2; ++ai) {
            u32x4 gw[4][2], pw[4][2];
#pragma unroll
            for (int m = 0; m < 4; ++m)
#pragma unroll
                for (int bj = 0; bj < 2; ++bj) { const size_t row = (size_t)(row0 + ai * HALF + m * 16); const int col = col0 + bj * HALF;
                    gw[m][bj] = *(const u32x4*)(G + row * ldg + col); if (MODE == 1) pw[m][bj] = *(const u32x4*)(P + row * ldo + col); }
            asm volatile("" ::: "memory");
#pragma unroll
            for (int m = 0; m < 4; ++m)
#pragma unroll
                for (int bj = 0; bj < 2; ++bj) { const size_t row = (size_t)(row0 + ai * HALF + m * 16); const int col = col0 + bj * HALF; const u32x4 g4 = gw[m][bj];
                    f32x4 v0 = acc[ai][bj][m][0], v1 = acc[ai][bj][m][1];
                    v0[0] *= sigmoidf_fast(bf_lo(g4.x)); v0[1] *= sigmoidf_fast(bf_hi(g4.x)); v0[2] *= sigmoidf_fast(bf_lo(g4.y)); v0[3] *= sigmoidf_fast(bf_hi(g4.y));
                    v1[0] *= sigmoidf_fast(bf_lo(g4.z)); v1[1] *= sigmoidf_fast(bf_hi(g4.z)); v1[2] *= sigmoidf_fast(bf_lo(g4.w)); v1[3] *= sigmoidf_fast(bf_hi(g4.w));
                    if (MODE == 1) { const u32x4 p4 = pw[m][bj];
                        v0[0] += bf_lo(p4.x); v0[1] += bf_hi(p4.x); v0[2] += bf_lo(p4.y); v0[3] += bf_hi(p4.y);
                        v1[0] += bf_lo(p4.z); v1[1] += bf_hi(p4.z); v1[2] += bf_lo(p4.w); v1[3] += bf_hi(p4.w); }
                    u32x4 w; w.x = cvt_pk_bf16(v0[0], v0[1]); w.y = cvt_pk_bf16(v0[2], v0[3]); w.z = cvt_pk_bf16(v1[0], v1[1]); w.w = cvt_pk_bf16(v1[2], v1[3]);
                    *(u32x4*)(O + row * ldo + col) = w; }
            asm volatile("" ::: "memory");
        }
    }
};
struct EpiRes {
    static constexpr bool PERM = false, AFTER_DRAIN = false;
    const float* xp; const float* xs; const float* xb; float* out; const float* modg; int row_off;
    __device__ __forceinline__ void operator()(const f32x4 (&acc)[2][2][4][2], const Unit& u, int wr, int wc, int fr, int fq) const {
        const int rowg = row_off + u.pm * BM;
        const int b = rowg < 32768 ? (rowg >> 11) : 16 + ((rowg - 32768) >> 12);
        const float* gvec = modg + (size_t)b * (6 * 2048);
        const float* base = xp ? (rowg < 32768 ? xp + (size_t)rowg * 2048 : xs + (size_t)(rowg - 32768) * 2048) : xb + (size_t)rowg * 2048;
        float* op = out + (size_t)rowg * 2048;
        const int r0 = wr * 64 + fr, col0 = u.pn * BM + wc * 32 + 4 * fq;
        f32x4 gv[2][2];
#pragma unroll
        for (int bj = 0; bj < 2; ++bj)
#pragma unroll
            for (int n = 0; n < 2; ++n) gv[bj][n] = *(const f32x4*)(gvec + col0 + bj * HALF + n * 16);
#pragma unroll
        for (int ai = 0; ai < 2; ++ai) {
            f32x4 bs[4][2][2];
#pragma unroll
            for (int m = 0; m < 4; ++m)
#pragma unroll
                for (int bj = 0; bj < 2; ++bj)
#pragma unroll
                    for (int n = 0; n < 2; ++n) bs[m][bj][n] = *(const f32x4*)(base + (size_t)(r0 + ai * HALF + m * 16) * 2048 + col0 + bj * HALF + n * 16);
            asm volatile("" ::: "memory");
#pragma unroll
            for (int m = 0; m < 4; ++m)
#pragma unroll
                for (int bj = 0; bj < 2; ++bj)
#pragma unroll
                    for (int n = 0; n < 2; ++n) *(f32x4*)(op + (size_t)(r0 + ai * HALF + m * 16) * 2048 + col0 + bj * HALF + n * 16) = bs[m][bj][n] + gv[bj][n] * acc[ai][bj][m][n];
            asm volatile("" ::: "memory");
        }
    }
};
}

#ifndef MK_MULTI
#define MK_MULTI 0
#endif
#ifndef PG8_SP2
#define PG8_SP2 true
#endif
#ifndef PG8_ALIGN
#define PG8_ALIGN true
#endif

constexpr int NWAVES = 8;
constexpr int D = 2048, TTOK = 49152, TP = 32768, NSEQ = 20, INC = 8704, DFF = 8192, HD = 128;
constexpr int TC = 24576, NCH = 2, NLAYER = 2;
constexpr float RMS_EPS = 1e-6f, ATT_SCALE = 0.08838834764831845f, LOG2E = 1.4426950408889634f;
constexpr int ZC_QA = 0, ZC_KA = 1024, ZC_VA = 1280, ZC_QB = 1536, ZC_KB = 2560, ZC_VB = 3584, ZC_GA = 4608, ZC_GB = 6656;
static_assert(TTOK == NCH * TC && TC % 256 == 0 && TP % 256 == 0, "chunks");
enum { I_XP = 0, I_XS, I_CP, I_CS, I_WADA, I_BADA, I_LN1, I_LN2, I_WIN, I_QNA, I_KNA, I_QNB, I_KNB, I_SINK, I_RPB, I_WBRA, I_WBRB, I_WOUT, I_W1, I_W2, N_IN };

constexpr size_t MiB = 1u << 20;
constexpr size_t WS_CTL = 0, CTL_ZERO_BYTES = 1 * MiB;
constexpr size_t WS_MOD = 1 * MiB;
constexpr size_t WS_TBLA = 3 * MiB, WS_TBLB = 4 * MiB;
constexpr size_t WS_W = 8 * MiB, W_LAYER = 114 * MiB;
constexpr size_t WO_IN = 0, WO_BR = 34 * MiB, WO_OUT = 42 * MiB, WO_1 = 50 * MiB, WO_2 = 82 * MiB;
constexpr size_t WS_H = WS_W + 2 * W_LAYER;
constexpr size_t WS_Z = WS_H + 96 * MiB;
constexpr size_t WS_O = WS_Z + 408 * MiB;
constexpr size_t WS_MB = WS_O + 96 * MiB;
constexpr size_t WS_END = WS_MB + 96 * MiB;
static_assert((size_t)INC * 2048 * 2 == 34 * MiB && (size_t)TC * INC * 2 == 408 * MiB && (size_t)TC * D * 2 == 96 * MiB, "sizes");
constexpr int CW_TMO = 0, CW_BAR = 4096;

constexpr int RING_OFF = 0, RING_BYTES = 133120;
constexpr int LDSCTL_OFF = RING_BYTES, MISC_OFF = LDSCTL_OFF + 320;
constexpr int LDS_BYTES = 147456;
constexpr int PART_OFF = 135168;
static_assert(MISC_OFF + 128 <= PART_OFF && PART_OFF + 8192 <= LDS_BYTES, "LDS map");

#define GAS __attribute__((address_space(1)))
#define LAS __attribute__((address_space(3)))
typedef unsigned short bf16;
typedef unsigned v4u __attribute__((ext_vector_type(4)));
typedef unsigned v2u __attribute__((ext_vector_type(2)));
typedef float f32x4 __attribute__((ext_vector_type(4)));
typedef GAS unsigned gu32;
#define RLX_AGENT __ATOMIC_RELAXED, __HIP_MEMORY_SCOPE_AGENT
#define LDS_WAIT() asm volatile("s_waitcnt lgkmcnt(0)" ::: "memory")
#define VM_WAIT() asm volatile("s_waitcnt vmcnt(0)" ::: "memory")
__device__ __forceinline__ unsigned f2bf(float f) { unsigned u = __builtin_bit_cast(unsigned, f); return (u + 0x7fffu + ((u >> 16) & 1u)) >> 16; }
__device__ __forceinline__ unsigned pk2(float lo, float hi) { return f2bf(lo) | (f2bf(hi) << 16); }
__device__ __forceinline__ float bflo(unsigned w) { return __uint_as_float(w << 16); }
__device__ __forceinline__ float bfhi(unsigned w) { return __uint_as_float(w & 0xffff0000u); }
__device__ __forceinline__ float wave_sum(float v) {
#pragma unroll
    for (int o = 1; o < 64; o <<= 1) v += __shfl_xor(v, o);
    return v;
}
__device__ __forceinline__ int seq_of(int row) { return row < TP ? (row >> 11) : 16 + ((row - TP) >> 12); }

#define XB_TMO      128
#define XB_XCNT(j)  (256  + 64 * (j))
#define XB_XSUB(j)  (1280 + 64 * (j))
#define XB_XGEN(j)  (2304 + 64 * (j))
#define XB_TOP      3328
#define XB_TOPGEN   3392
#define XCD_BAR_WORDS 3456
#define XB_SPIN_CAP (1u << 18)

__device__ __forceinline__ unsigned xb_ld(unsigned* p)              { return __hip_atomic_load(p, __ATOMIC_RELAXED, __HIP_MEMORY_SCOPE_AGENT); }
__device__ __forceinline__ unsigned xb_add(unsigned* p, unsigned v) { return __hip_atomic_fetch_add(p, v, __ATOMIC_RELAXED, __HIP_MEMORY_SCOPE_AGENT); }
__device__ __forceinline__ unsigned xb_xcc_id() { return (unsigned)__builtin_amdgcn_s_getreg((3 << 11) | 20) & 0xFu; }
#define XB_SPIN(cond, bar) do { unsigned _sp = 0; while (cond) { __builtin_amdgcn_s_sleep(1); \
    if ((++_sp & 255u) == 0u) { if (xb_ld(&(bar)[XB_TMO])) break; if (_sp > XB_SPIN_CAP) { atomicAdd(&(bar)[XB_TMO], 1u); break; } } } } while (0)

struct XcdBarrier {
    unsigned* bar; unsigned x;
    volatile LAS unsigned* st;
};

__device__ __forceinline__ XcdBarrier xcd_barrier_post(unsigned* bar, volatile LAS unsigned* st) {
    XcdBarrier b; b.bar = bar; b.x = xb_xcc_id(); b.st = st;
    if (threadIdx.x == 0) (void)xb_add(&bar[XB_XCNT(b.x)], 1u);
    return b;
}
__device__ __forceinline__ void xcd_barrier_complete(unsigned* bar, unsigned x, unsigned& nloc, unsigned& nx) {
    const unsigned G = gridDim.x * gridDim.y * gridDim.z;
    unsigned sum, cnt, mine, sp = 0u;
    for (;;) {
        sum = 0u; cnt = 0u; mine = 0u;
#pragma unroll
        for (unsigned j = 0; j < 16; ++j) { const unsigned c = xb_ld(&bar[XB_XCNT(j)]); sum += c; cnt += (c > 0u) ? 1u : 0u; mine = (j == x) ? c : mine; }
        if (sum == G) break;
        __builtin_amdgcn_s_sleep(1);
        if ((++sp & 255u) == 0u) { if (xb_ld(&bar[XB_TMO])) break; if (sp > XB_SPIN_CAP) { atomicAdd(&bar[XB_TMO], 1u); break; } }
    }
    nloc = mine > 0u ? mine : 1u; nx = cnt > 0u ? cnt : 1u;
}

__device__ __forceinline__ void xcd_barrier(const XcdBarrier& b) {
    asm volatile("s_waitcnt vmcnt(0)" ::: "memory");
    __syncthreads();
    if (threadIdx.x == 0) {
        unsigned* bar = b.bar;
        __builtin_amdgcn_s_waitcnt(0);
        unsigned nloc = b.st[0], nx = b.st[1];
        if (nloc == 0u) { xcd_barrier_complete(bar, b.x, nloc, nx); b.st[0] = nloc; b.st[1] = nx; }
        const unsigned old = xb_add(&bar[XB_XSUB(b.x)], 1u);
        const unsigned gen = old / nloc;
        if (old + 1u == (gen + 1u) * nloc) {
            __builtin_amdgcn_fence(__ATOMIC_RELEASE, "agent");
            asm volatile("s_waitcnt vmcnt(0)" ::: "memory");
            const unsigned og = xb_add(&bar[XB_TOP], 1u);
            const unsigned tg = og / nx;
            if (og + 1u == (tg + 1u) * nx) xb_add(&bar[XB_TOPGEN], 1u);
            else XB_SPIN(xb_ld(&bar[XB_TOPGEN]) == tg, bar);
            __builtin_amdgcn_fence(__ATOMIC_ACQUIRE, "agent");
            xb_add(&bar[XB_XGEN(b.x)], 1u);
            asm volatile("s_waitcnt vmcnt(0)" ::: "memory");
        } else {
            XB_SPIN(xb_ld(&bar[XB_XGEN(b.x)]) == gen, bar);
            __builtin_amdgcn_fence(__ATOMIC_ACQUIRE, "agent");
            asm volatile("s_waitcnt vmcnt(0)" ::: "memory");
        }
    }
    __syncthreads();
}


struct Frame {
    LAS unsigned char* lds;
    int tid, lane, wave, G, gw, ngw;
    const float* in[N_IN];
    float* out; unsigned char* ws;
    float* mod;
};

__device__ __forceinline__ void transpose_item(const float* W, int N, bf16* WT, int ldT, int koff, LAS float* scr, int item, int lane) {
    const int nblk = N / 32, kb = item / nblk, nb = item - kb * nblk, k0 = 64 * kb, n0 = 32 * nb;
#pragma unroll 8
    for (int i = 0; i < 32; ++i) { const int kk = 2 * i + (lane >> 5); scr[kk * 33 + (lane & 31)] = W[(size_t)(k0 + kk) * N + n0 + (lane & 31)]; }
    LDS_WAIT(); asm volatile("" ::: "memory");
    const int c = lane & 7;
#pragma unroll
    for (int j = 0; j < 4; ++j) { const int n = (lane >> 3) + 8 * j; const LAS float* s = scr + (8 * c) * 33 + n;
        v4u o; o.x = pk2(s[0 * 33], s[1 * 33]); o.y = pk2(s[2 * 33], s[3 * 33]); o.z = pk2(s[4 * 33], s[5 * 33]); o.w = pk2(s[6 * 33], s[7 * 33]);
        *(GAS v4u*)(WT + (size_t)(n0 + n) * ldT + koff + k0 + 8 * c) = o; }
    LDS_WAIT(); asm volatile("" ::: "memory");
}

__device__ __forceinline__ void p0_weights(Frame& F) {
    LAS float* scr = (LAS float*)(F.lds + RING_OFF + F.wave * 16384);
    constexpr int I_IN = (D / 64) * (INC / 32), I_BR = (1024 / 64) * (D / 32), I_OUT = (D / 64) * (D / 32), I_1 = (D / 64) * (DFF / 32), I_2 = (DFF / 64) * (D / 32);
    constexpr int PER_LAYER = I_IN + 2 * I_BR + I_OUT + I_1 + I_2;
    for (int it = F.gw; it < NLAYER * PER_LAYER; it += F.ngw) {
        const int l = it / PER_LAYER; int r = it - l * PER_LAYER;
        unsigned char* wl = F.ws + WS_W + (size_t)l * W_LAYER;
        if (r < I_IN) { transpose_item(F.in[I_WIN] + (size_t)l * D * INC, INC, (bf16*)(wl + WO_IN), D, 0, scr, r, F.lane); continue; } r -= I_IN;
        if (r < I_BR) { transpose_item(F.in[I_WBRA] + (size_t)l * 1024 * D, D, (bf16*)(wl + WO_BR), 2048, 0, scr, r, F.lane); continue; } r -= I_BR;
        if (r < I_BR) { transpose_item(F.in[I_WBRB] + (size_t)l * 1024 * D, D, (bf16*)(wl + WO_BR), 2048, 1024, scr, r, F.lane); continue; } r -= I_BR;
        if (r < I_OUT) { transpose_item(F.in[I_WOUT] + (size_t)l * D * D, D, (bf16*)(wl + WO_OUT), D, 0, scr, r, F.lane); continue; } r -= I_OUT;
        if (r < I_1) { transpose_item(F.in[I_W1] + (size_t)l * D * DFF, DFF, (bf16*)(wl + WO_1), D, 0, scr, r, F.lane); continue; } r -= I_1;
        transpose_item(F.in[I_W2] + (size_t)l * DFF * D, D, (bf16*)(wl + WO_2), DFF, 0, scr, r, F.lane);
    }
}

__device__ __forceinline__ void p0_mod(Frame& F) {
    LAS float* scr = (LAS float*)(F.lds + RING_OFF + F.wave * 8192);
    LAS float* red = (LAS float*)(F.lds + RING_OFF + 65536);
    const float* cp = F.in[I_CP]; const float* cs = F.in[I_CS];
    for (int task = blockIdx.x; task < NLAYER * 192; task += F.G) {
        const int l = task / 192, n0 = (task - l * 192) * 64;
        const float* W = F.in[I_WADA] + (size_t)l * D * 12288 + n0 + F.lane;
        float acc[NSEQ];
#pragma unroll
        for (int b = 0; b < NSEQ; ++b) acc[b] = 0.f;
        for (int kc = 0; kc < 4; ++kc) {
            const int k0 = F.wave * 256 + kc * 64;
#pragma unroll
            for (int b = 0; b < NSEQ; ++b) { const float cv = (b < 16) ? cp[b * D + k0 + F.lane] : cs[(b - 16) * D + k0 + F.lane];
                scr[F.lane * NSEQ + b] = cv / (1.0f + __expf(-cv)); }
            LDS_WAIT(); asm volatile("" ::: "memory");
#pragma unroll 4
            for (int kk = 0; kk < 64; ++kk) { const float w = W[(size_t)(k0 + kk) * 12288];
#pragma unroll
                for (int b = 0; b < NSEQ; ++b) acc[b] = fmaf(scr[kk * NSEQ + b], w, acc[b]); }
            LDS_WAIT(); asm volatile("" ::: "memory");
        }
#pragma unroll
        for (int b = 0; b < NSEQ; ++b) red[(F.wave * NSEQ + b) * 64 + F.lane] = acc[b];
        __syncthreads();
        for (int idx = F.tid; idx < NSEQ * 64; idx += NWAVES * 64) { const int b = idx >> 6, ln = idx & 63; float s = 0.f;
#pragma unroll
            for (int w = 0; w < NWAVES; ++w) s += red[(w * NSEQ + b) * 64 + ln];
            F.mod[((size_t)l * NSEQ + b) * 12288 + n0 + ln] = s + F.in[I_BADA][l * 12288 + n0 + ln]; }
        __syncthreads();
    }
}

__device__ __forceinline__ void norm_phase(Frame& F, int l, int which, int c0, bool from_inputs) {
    bf16* H = (bf16*)(F.ws + WS_H);
    const float* lnw = F.in[which ? I_LN2 : I_LN1] + l * D;
    for (int tl = F.gw; tl < TC; tl += F.ngw) {
        const int row = c0 + tl, b = seq_of(row);
        const float* xrow = from_inputs ? (row < TP ? F.in[I_XP] + (size_t)row * D : F.in[I_XS] + (size_t)(row - TP) * D) : F.out + (size_t)row * D;
        const float* sh = F.mod + (((size_t)l * NSEQ + b) * 6 + which * 3) * D; const float* sc = sh + D;
        const GAS f32x4* xr = (const GAS f32x4*)xrow + F.lane;
        f32x4 v[8]; float ss = 0.f;
#pragma unroll
        for (int j = 0; j < 8; ++j) { v[j] = xr[64 * j]; ss += (v[j].x * v[j].x + v[j].y * v[j].y) + (v[j].z * v[j].z + v[j].w * v[j].w); }
        const float rstd = rsqrtf(wave_sum(ss) * (1.f / D) + RMS_EPS);
        GAS v2u* o8 = (GAS v2u*)(H + (size_t)tl * D) + F.lane;
#pragma unroll
        for (int j = 0; j < 8; ++j) { const int col = 4 * F.lane + 256 * j;
            const f32x4 g = *(const f32x4*)(lnw + col), s1 = *(const f32x4*)(sc + col), s0 = *(const f32x4*)(sh + col);
            const f32x4 y = (v[j] * rstd) * g * (s1 + 1.0f) + s0;
            v2u w; w.x = pk2(y.x, y.y); w.y = pk2(y.z, y.w); o8[64 * j] = w; }
    }
}

__device__ __forceinline__ void attn_simple_A(Frame& F, int l, int c0) {
    const bf16* Z = (const bf16*)(F.ws + WS_Z); bf16* O = (bf16*)(F.ws + WS_O);
    const float* qn = F.in[I_QNA] + l * HD; const float* kn = F.in[I_KNA] + l * HD; const float* sink = F.in[I_SINK] + l * 8;
    const float g0 = qn[2 * F.lane] * kn[2 * F.lane] * ATT_SCALE, g1 = qn[2 * F.lane + 1] * kn[2 * F.lane + 1] * ATT_SCALE;
    for (int item = F.gw; item < TC * 8; item += F.ngw) {
        const int tl = item >> 3, h = item & 7, kvh = h >> 2, row = c0 + tl;
        const int S = row < TP ? 2048 : 4096, pos = row < TP ? (row & 2047) : ((row - TP) & 4095);
        const bf16* zr = Z + (size_t)tl * INC;
        const unsigned qw = *(const unsigned*)(zr + ZC_QA + h * HD + 2 * F.lane);
        float q0 = bflo(qw), q1 = bfhi(qw);
        const float rq = rsqrtf(wave_sum(q0 * q0 + q1 * q1) * (1.f / HD) + RMS_EPS);
        q0 *= rq * g0; q1 *= rq * g1;
        float m = sink[h], lsum = 1.f, o0 = 0.f, o1 = 0.f;
        const float slope = exp2f(-(float)(h + 1));
        const int slo = pos - 128 < 0 ? 0 : pos - 128, shi = pos + 128 > S - 1 ? S - 1 : pos + 128;
        for (int s = slo; s <= shi; ++s) {
            const bf16* kr = zr + (ptrdiff_t)(s - pos) * INC;
            const unsigned kw = *(const unsigned*)(kr + ZC_KA + kvh * HD + 2 * F.lane), vw = *(const unsigned*)(kr + ZC_VA + kvh * HD + 2 * F.lane);
            const float k0 = bflo(kw), k1 = bfhi(kw);
            float dot = q0 * k0 + q1 * k1, kss = k0 * k0 + k1 * k1;
#pragma unroll
            for (int o = 1; o < 64; o <<= 1) { dot += __shfl_xor(dot, o); kss += __shfl_xor(kss, o); }
            const float sc = dot * rsqrtf(kss * (1.f / HD) + RMS_EPS) - slope * fabsf((float)(pos - s));
            const float mn = fmaxf(m, sc), al = __expf(m - mn), p = __expf(sc - mn);
            lsum = lsum * al + p; o0 = o0 * al + p * bflo(vw); o1 = o1 * al + p * bfhi(vw); m = mn;
        }
        const float inv = 1.f / lsum;
        *(unsigned*)(O + (size_t)tl * D + h * HD + 2 * F.lane) = pk2(o0 * inv, o1 * inv);
    }
}
__device__ __forceinline__ void attn_simple_B(Frame& F, int l, int c0) {
    const bf16* Z = (const bf16*)(F.ws + WS_Z); bf16* O = (bf16*)(F.ws + WS_O);
    const float* qn = F.in[I_QNB] + l * HD; const float* kn = F.in[I_KNB] + l * HD; const float* rpb = F.in[I_RPB] + (size_t)l * 8 * 15 * 31;
    const float g0 = qn[2 * F.lane] * kn[2 * F.lane] * ATT_SCALE, g1 = qn[2 * F.lane + 1] * kn[2 * F.lane + 1] * ATT_SCALE;
    for (int item = F.gw; item < TC * 8; item += F.ngw) {
        const int tl = item >> 3, h = item & 7, row = c0 + tl;
        const int S = row < TP ? 2048 : 4096, pos = row < TP ? (row & 2047) : ((row - TP) & 4095), rows = S >> 6;
        const int r = pos >> 6, c = pos & 63;
        const int r0 = r - 4 < 0 ? 0 : (r - 4 > rows - 8 ? rows - 8 : r - 4), cc0 = c - 8 < 0 ? 0 : (c - 8 > 48 ? 48 : c - 8);
        const bf16* zr = Z + (size_t)tl * INC;
        const unsigned qw = *(const unsigned*)(zr + ZC_QB + h * HD + 2 * F.lane);
        float q0 = bflo(qw), q1 = bfhi(qw);
        const float rq = rsqrtf(wave_sum(q0 * q0 + q1 * q1) * (1.f / HD) + RMS_EPS);
        q0 *= rq * g0; q1 *= rq * g1;
        float m = -1e30f, lsum = 0.f, o0 = 0.f, o1 = 0.f;
        for (int j = 0; j < 8; ++j) { const int kr_ = r0 + j, dr = kr_ - r + 7;
            for (int kk = 0; kk < 16; ++kk) { const int kc = cc0 + kk; int dcv = kc - c; dcv = dcv < -15 ? -15 : (dcv > 15 ? 15 : dcv);
                const float bias = rpb[(h * 15 + dr) * 31 + dcv + 15];
                const bf16* kp = zr + (ptrdiff_t)(kr_ * 64 + kc - pos) * INC;
                const unsigned kw = *(const unsigned*)(kp + ZC_KB + h * HD + 2 * F.lane), vw = *(const unsigned*)(kp + ZC_VB + h * HD + 2 * F.lane);
                const float k0 = bflo(kw), k1 = bfhi(kw);
                float dot = q0 * k0 + q1 * k1, kss = k0 * k0 + k1 * k1;
#pragma unroll
                for (int o = 1; o < 64; o <<= 1) { dot += __shfl_xor(dot, o); kss += __shfl_xor(kss, o); }
                const float sc = dot * rsqrtf(kss * (1.f / HD) + RMS_EPS) + bias;
                const float mn = fmaxf(m, sc), al = __expf(m - mn), p = __expf(sc - mn);
                lsum = lsum * al + p; o0 = o0 * al + p * bflo(vw); o1 = o1 * al + p * bfhi(vw); m = mn; } }
        const float inv = 1.f / lsum;
        *(unsigned*)(O + (size_t)tl * D + 1024 + h * HD + 2 * F.lane) = pk2(o0 * inv, o1 * inv);
    }
}


namespace att {
typedef short bf16x8 __attribute__((ext_vector_type(8)));
typedef short s16x4 __attribute__((ext_vector_type(4)));
typedef float f32x16 __attribute__((ext_vector_type(16)));
typedef float f32x4 __attribute__((ext_vector_type(4)));
typedef unsigned u32x4 __attribute__((ext_vector_type(4)));
constexpr int SHM_V = 64 * 128 * 2, SHM_K = 64 * 128 * 2;
constexpr int OFF_V = 0, OFF_K = 2 * SHM_V, OFF_WS = 2 * SHM_V + 2 * SHM_K, ATT_LDS = OFF_WS + 8 * 64 * 4;
constexpr float THR_L2 = 11.5f;
#define ATT_KSWZ(row, colB) ((row) * 256 + ((colB) ^ (((row) & 7) << 4)))
#define ATT_SBAR() __builtin_amdgcn_sched_barrier(0)
__device__ __forceinline__ int crow(int r, int hi) { return (r & 3) + 8 * (r >> 2) + 4 * hi; }
__device__ __forceinline__ unsigned cvtpk(float lo, float hi) { unsigned r; asm volatile("v_cvt_pk_bf16_f32 %0, %1, %2" : "=v"(r) : "v"(lo), "v"(hi)); return r; }
__device__ __forceinline__ void qkt(f32x16& p0, f32x16& p1, const LAS unsigned char* Ks, const bf16x8 (&qr)[8], int r32, int hi) {
#pragma unroll
    for (int d0 = 0; d0 < 8; ++d0) { const int cb = (d0 * 16 + hi * 8) * 2;
        const bf16x8 b0 = *(const LAS bf16x8*)(Ks + ATT_KSWZ(r32, cb));
        const bf16x8 b1 = *(const LAS bf16x8*)(Ks + ATT_KSWZ(32 + r32, cb));
        p0 = __builtin_amdgcn_mfma_f32_32x32x16_bf16(b0, qr[d0], p0, 0, 0, 0);
        p1 = __builtin_amdgcn_mfma_f32_32x32x16_bf16(b1, qr[d0], p1, 0, 0, 0); }
}
__device__ __forceinline__ int v_st(int k, int c) { const int kk = (k & ~0xC) | ((k & 4) << 1) | ((k & 8) >> 1); return ((kk >> 3) * 4 + (c >> 5)) * 512 + ((kk & 7) * 32 + (c & 31)) * 2; }
__device__ __forceinline__ int v_rd_base(int lane) { return ((lane & 3) << 3) | (((lane >> 2) & 3) << 6) | (((lane >> 4) & 1) << 5) | (((lane >> 5) & 1) << 8); }
constexpr int v_rd_off(int d0, int ks, int half) { return d0 * 512 + ks * 4096 + half * 2048; }
template <int OFF> __device__ __forceinline__ s16x4 tr_read(int vb) { s16x4 r; asm volatile("ds_read_b64_tr_b16 %0, %1 offset:%2" : "=&v"(r) : "v"(vb), "i"(OFF) : "memory"); return r; }
template <int D0> __device__ __forceinline__ void pv_one(f32x16& od, int vb, bf16x8 pa0, bf16x8 pa1, bf16x8 pa2, bf16x8 pa3) {
    const s16x4 l0 = tr_read<v_rd_off(D0, 0, 0)>(vb), h0 = tr_read<v_rd_off(D0, 0, 1)>(vb), l1 = tr_read<v_rd_off(D0, 1, 0)>(vb), h1 = tr_read<v_rd_off(D0, 1, 1)>(vb);
    const s16x4 l2 = tr_read<v_rd_off(D0, 2, 0)>(vb), h2 = tr_read<v_rd_off(D0, 2, 1)>(vb), l3 = tr_read<v_rd_off(D0, 3, 0)>(vb), h3 = tr_read<v_rd_off(D0, 3, 1)>(vb);
    asm volatile("s_waitcnt lgkmcnt(0)" ::: "memory"); ATT_SBAR();
#define ATT_PK(L, H) (bf16x8){L[0], L[1], L[2], L[3], H[0], H[1], H[2], H[3]}
    od = __builtin_amdgcn_mfma_f32_32x32x16_bf16(pa0, ATT_PK(l0, h0), od, 0, 0, 0);
    od = __builtin_amdgcn_mfma_f32_32x32x16_bf16(pa1, ATT_PK(l1, h1), od, 0, 0, 0);
    od = __builtin_amdgcn_mfma_f32_32x32x16_bf16(pa2, ATT_PK(l2, h2), od, 0, 0, 0);
    od = __builtin_amdgcn_mfma_f32_32x32x16_bf16(pa3, ATT_PK(l3, h3), od, 0, 0, 0);
#undef ATT_PK
}
__device__ __forceinline__ void pv_d0(f32x16 (&o)[4], int vb, bf16x8 pa0, bf16x8 pa1, bf16x8 pa2, bf16x8 pa3) {
    pv_one<0>(o[0], vb, pa0, pa1, pa2, pa3); pv_one<1>(o[1], vb, pa0, pa1, pa2, pa3); pv_one<2>(o[2], vb, pa0, pa1, pa2, pa3); pv_one<3>(o[3], vb, pa0, pa1, pa2, pa3);
}
__device__ __forceinline__ float swap_max(float v) { auto rr = __builtin_amdgcn_permlane32_swap(__float_as_uint(v), __float_as_uint(v), false, false); return fmaxf(__uint_as_float(rr[0]), __uint_as_float(rr[1])); }
__device__ __forceinline__ float swap_add(float v) { auto rr = __builtin_amdgcn_permlane32_swap(__float_as_uint(v), __float_as_uint(v), false, false); return __uint_as_float(rr[0]) + __uint_as_float(rr[1]); }
__device__ __forceinline__ bf16x8 knorm8(bf16x8 raw, const float (&g)[8]) {
    const u32x4 w = __builtin_bit_cast(u32x4, raw);
    float f[8] = {__uint_as_float(w.x << 16), __uint_as_float(w.x & 0xffff0000u), __uint_as_float(w.y << 16), __uint_as_float(w.y & 0xffff0000u),
                  __uint_as_float(w.z << 16), __uint_as_float(w.z & 0xffff0000u), __uint_as_float(w.w << 16), __uint_as_float(w.w & 0xffff0000u)};
    float ss = 0.f;
#pragma unroll
    for (int i = 0; i < 8; ++i) ss = fmaf(f[i], f[i], ss);
    ss += __shfl_xor(ss, 1); ss += __shfl_xor(ss, 2); ss += __shfl_xor(ss, 4); ss += __shfl_xor(ss, 8);
    const float rs = rsqrtf(ss * (1.f / 128.f) + 1e-6f);
    u32x4 o; o.x = cvtpk(f[0] * rs * g[0], f[1] * rs * g[1]); o.y = cvtpk(f[2] * rs * g[2], f[3] * rs * g[3]); o.z = cvtpk(f[4] * rs * g[4], f[5] * rs * g[5]); o.w = cvtpk(f[6] * rs * g[6], f[7] * rs * g[7]);
    return __builtin_bit_cast(bf16x8, o);
}

constexpr int OFF_T = 2 * SHM_V + 2 * SHM_K, OFF_WS2 = OFF_T + 8 * 8192, ATT_LDS2 = OFF_WS2 + 8 * 256;
__device__ __forceinline__ void glds16(const void* g, LAS unsigned char* l) { __builtin_amdgcn_global_load_lds((const unsigned*)g, (LAS unsigned*)l, 16, 0, 0); }
template <int LDZ, int LDO, class TblFn>
__device__ __forceinline__ void attn_unit(const bf16* __restrict__ Zq, const bf16* __restrict__ Zk, const bf16* __restrict__ Zv, bf16* __restrict__ Ob, const int NT,
                                          const TblFn& tbl, const float sink_l2, LAS unsigned char* lds, const int tid) {
    const int wid = __builtin_amdgcn_readfirstlane(tid >> 6), lane = tid & 63, r32 = lane & 31, hi = lane >> 5;
    LAS unsigned char* V_lds = lds + OFF_V; LAS unsigned char* K_lds = lds + OFF_K; LAS unsigned char* T_lds = lds + OFF_T + wid * 8192;
    LAS float* wsf = (LAS float*)(lds + OFF_WS2) + wid * 64; LAS float* li_l = wsf; LAS float* al_l = wsf + 32;
    const LAS float* li_h = li_l + 4 * hi; const LAS float* al_h = al_l + 4 * hi;
    constexpr float C = 0.08838834764831845f * 1.4426950408889634f;
    float m_reg = -1e30f, l_reg = 0.f; f32x16 o[4] = {}; bf16x8 qr[8];
    { const bf16* Qw = Zq + (size_t)(wid * 32 + r32) * LDZ + hi * 8;
#pragma unroll
      for (int d0 = 0; d0 < 8; ++d0) qr[d0] = *(const bf16x8*)(Qw + d0 * 16); }
    unsigned kof[2], vof[2];
#pragma unroll
    for (int i = 0; i < 2; ++i) { const int p = (wid * 2 + i) * 64 + lane;
        { const int row = p >> 4, ch = (p & 15) ^ (row & 7); kof[i] = (unsigned)(row * LDZ + ch * 8); }
        { const int sub = p >> 5, g = p & 31, kk = (sub >> 2) * 8 + (g >> 2), c = (sub & 3) * 32 + (g & 3) * 8, k = (kk & ~0xC) | ((kk & 4) << 1) | ((kk & 8) >> 1);
          vof[i] = (unsigned)(k * LDZ + c); } }
    const int vb0 = (int)(unsigned)(uintptr_t)V_lds + v_rd_base(lane);
#define ATT_STAGE(t, b) do { const bf16* _k = Zk + (size_t)(t) * 64 * LDZ; const bf16* _v = Zv + (size_t)(t) * 64 * LDZ; \
        glds16(_k + kof[0], K_lds + (b) * SHM_K + (wid * 2) * 1024); glds16(_k + kof[1], K_lds + (b) * SHM_K + (wid * 2 + 1) * 1024); \
        glds16(_v + vof[0], V_lds + (b) * SHM_V + (wid * 2) * 1024); glds16(_v + vof[1], V_lds + (b) * SHM_V + (wid * 2 + 1) * 1024); } while (0)
#define ATT_TSTAGE(tp_) do { _Pragma("unroll") for (int i = 0; i < 8; ++i) glds16((tp_) + (i * 64 + lane) * 4, T_lds + i * 1024); } while (0)
    const float* tp = tbl(0);
    ATT_STAGE(0, 0); if (tp != nullptr) ATT_TSTAGE(tp);
    asm volatile("s_waitcnt vmcnt(0)" ::: "memory"); __syncthreads();
    for (int j = 0; j < NT; ++j) {
        const int b = j & 1;
        if (j + 1 < NT) ATT_STAGE(j + 1, b ^ 1);
        const float* tpn = (j + 1 < NT) ? tbl(j + 1) : nullptr;
        if (tp != nullptr) {
            f32x16 p0, p1;
#pragma unroll
            for (int i = 0; i < 4; ++i) { const f32x4 a = *(const LAS f32x4*)(T_lds + (i * 64 + lane) * 16), c4 = *(const LAS f32x4*)(T_lds + ((4 + i) * 64 + lane) * 16);
                p0[4 * i + 0] = a.x; p0[4 * i + 1] = a.y; p0[4 * i + 2] = a.z; p0[4 * i + 3] = a.w; p1[4 * i + 0] = c4.x; p1[4 * i + 1] = c4.y; p1[4 * i + 2] = c4.z; p1[4 * i + 3] = c4.w; }
            asm volatile("s_waitcnt lgkmcnt(0)" ::: "memory");
            if (tpn != nullptr) ATT_TSTAGE(tpn);
            qkt(p0, p1, K_lds + b * SHM_K, qr, r32, hi);
            float pmax = p0[0];
#pragma unroll
            for (int r = 1; r < 16; ++r) pmax = fmaxf(pmax, p0[r]);
#pragma unroll
            for (int r = 0; r < 16; ++r) pmax = fmaxf(pmax, p1[r]);
            pmax = swap_max(pmax) * C;
            if (!__all(pmax - m_reg <= THR_L2)) {
                const float mn = fmaxf(m_reg, pmax), alpha = __builtin_amdgcn_exp2f(m_reg - mn); m_reg = mn; l_reg *= alpha;
                if (hi == 0) al_l[r32] = alpha;
                asm volatile("s_waitcnt lgkmcnt(0)" ::: "memory");
#pragma unroll
                for (int d = 0; d < 4; ++d)
#pragma unroll
                    for (int r = 0; r < 16; ++r) o[d][r] *= al_h[(r & 3) + 8 * (r >> 2)];
            }
            float ps = 0.f; const float nm = -m_reg;
#pragma unroll
            for (int r = 0; r < 16; ++r) { p0[r] = __builtin_amdgcn_exp2f(fmaf(p0[r], C, nm)); p1[r] = __builtin_amdgcn_exp2f(fmaf(p1[r], C, nm)); ps += p0[r] + p1[r]; }
            l_reg += swap_add(ps);
            bf16x8 pa0, pa1, pa2, pa3;
#define ATT_PK4(P, BASE, OUT) do { const unsigned a0 = cvtpk(P[BASE + 0], P[BASE + 1]), a1 = cvtpk(P[BASE + 2], P[BASE + 3]); \
            const unsigned b0 = cvtpk(P[BASE + 4], P[BASE + 5]), b1 = cvtpk(P[BASE + 6], P[BASE + 7]); \
            auto r0 = __builtin_amdgcn_permlane32_swap(a0, b0, false, false); auto r1 = __builtin_amdgcn_permlane32_swap(a1, b1, false, false); \
            u32x4 w = {r0[0], r1[0], r0[1], r1[1]}; OUT = __builtin_bit_cast(bf16x8, w); } while (0)
            ATT_PK4(p0, 0, pa0); ATT_PK4(p0, 8, pa1); ATT_PK4(p1, 0, pa2); ATT_PK4(p1, 8, pa3);
#undef ATT_PK4
            pv_d0(o, vb0 + b * SHM_V, pa0, pa1, pa2, pa3);
        } else if (tpn != nullptr) ATT_TSTAGE(tpn);
        tp = tpn;
        asm volatile("s_waitcnt vmcnt(0)" ::: "memory"); __syncthreads();
    }
#undef ATT_STAGE
#undef ATT_TSTAGE
    l_reg += __builtin_amdgcn_exp2f(sink_l2 - m_reg);
    if (hi == 0) li_l[r32] = l_reg;
    asm volatile("s_waitcnt lgkmcnt(0)" ::: "memory");
    { LAS unsigned short* St = (LAS unsigned short*)T_lds + hi * (4 * 128) + r32;
#pragma unroll
      for (int r = 0; r < 16; ++r) { const float rl = __builtin_amdgcn_rcpf(li_h[(r & 3) + 8 * (r >> 2)]);
#pragma unroll
          for (int d0 = 0; d0 < 4; ++d0) { const float v = o[d0][r] * rl; St[((r & 3) + 8 * (r >> 2)) * 128 + d0 * 32] = (unsigned short)(cvtpk(v, v) & 0xffffu); } }
      asm volatile("s_waitcnt lgkmcnt(0)" ::: "memory");
      bf16* Ow = Ob + (size_t)(wid * 32 + (lane >> 4)) * LDO + (lane & 15) * 8;
#pragma unroll
      for (int i = 0; i < 8; ++i) { const u32x4 w = *(const LAS u32x4*)(T_lds + i * 1024 + lane * 16); *(u32x4*)(Ow + (size_t)(i * 4) * LDO) = w; }
      asm volatile("s_waitcnt lgkmcnt(0)" ::: "memory"); }
}
}

__device__ __forceinline__ void p0_tables(Frame& F) {
    float* tA = (float*)(F.ws + WS_TBLA); float* tB = (float*)(F.ws + WS_TBLB);
    const float ninf = -__builtin_inff();
    const int gt = blockIdx.x * (NWAVES * 64) + F.tid, ngt = F.G * NWAVES * 64;
    for (int e = gt; e < 8 * 10 * 2048; e += ngt) {
        const int h = e / 20480, rem = e - h * 20480, idx = rem >> 11, w_ = rem & 2047, i = w_ >> 8, lane = (w_ >> 2) & 63, ee = w_ & 3;
        const int r = 4 * (i & 3) + ee, hi = lane >> 5, q = lane & 31, key = ((i >> 2) << 5) + att::crow(r, hi);
        const int d = 32 * idx - 128 + q - key, ad = d < 0 ? -d : d;
        tA[e] = ad <= 128 ? -exp2f(-(float)(h + 1)) * (float)ad * (1.0f / ATT_SCALE) : ninf;
    }
    for (int e = gt; e < NLAYER * 8 * 15 * 2 * 2048; e += ngt) {
        const int w_ = e & 2047, t = e >> 11, wc = t & 1, t2 = t >> 1, dr = t2 % 15, t3 = t2 / 15, h = t3 & 7, l = t3 >> 3;
        const int i = w_ >> 8, lane = (w_ >> 2) & 63, ee = w_ & 3, r = 4 * (i & 3) + ee, hi = lane >> 5, q = lane & 31, kc = ((i >> 2) << 5) + att::crow(r, hi);
        const int c = 32 * wc + q, cc0 = c - 8 < 0 ? 0 : (c - 8 > 48 ? 48 : c - 8);
        int dcv = kc - c; dcv = dcv < -15 ? -15 : (dcv > 15 ? 15 : dcv);
        const bool ok = kc >= cc0 && kc < cc0 + 16;
        tB[e] = ok ? F.in[I_RPB][((l * 8 + h) * 15 + dr) * 31 + dcv + 15] * (1.0f / ATT_SCALE) : ninf;
    }
}


__device__ __forceinline__ void qk_norm_phase(Frame& F, const int l) {
    bf16* Z = (bf16*)(F.ws + WS_Z);
    const int sub = F.lane >> 4, li = F.lane & 15;
    for (int tl = F.gw; tl < TC; tl += F.ngw) {
        bf16* zr = Z + (size_t)tl * INC;
#pragma unroll
        for (int it = 0; it < 7; ++it) { const int hh = it * 4 + sub;
            if (hh < 26) {
                const int col = (hh < 10 ? hh * HD : 1536 + (hh - 10) * HD) + li * 8;
                const float* g = F.in[hh < 8 ? I_QNA : (hh < 10 ? I_KNA : (hh < 18 ? I_QNB : I_KNB))] + l * HD + li * 8;
                const v4u w = *(const v4u*)(zr + col);
                float f[8] = {bflo(w.x), bfhi(w.x), bflo(w.y), bfhi(w.y), bflo(w.z), bfhi(w.z), bflo(w.w), bfhi(w.w)};
                float ss = 0.f;
#pragma unroll
                for (int i = 0; i < 8; ++i) ss = fmaf(f[i], f[i], ss);
                ss += __shfl_xor(ss, 1); ss += __shfl_xor(ss, 2); ss += __shfl_xor(ss, 4); ss += __shfl_xor(ss, 8);
                const float rs = rsqrtf(ss * (1.f / HD) + RMS_EPS);
                const f32x4 g0 = *(const f32x4*)g, g1 = *(const f32x4*)(g + 4);
                v4u o; o.x = pk2(f[0] * rs * g0.x, f[1] * rs * g0.y); o.y = pk2(f[2] * rs * g0.z, f[3] * rs * g0.w); o.z = pk2(f[4] * rs * g1.x, f[5] * rs * g1.y); o.w = pk2(f[6] * rs * g1.z, f[7] * rs * g1.w);
                *(v4u*)(zr + col) = o;
            } }
    }
}

template <int MIXER> __device__ __forceinline__ void attn_fast(Frame& F, const int l, const int c0) {
    const bf16* Z = (const bf16*)(F.ws + WS_Z); bf16* O = (bf16*)(F.ws + WS_O);
    const float* tblA = (const float*)(F.ws + WS_TBLA); const float* tblB = (const float*)(F.ws + WS_TBLB) + (size_t)l * (8 * 15 * 2 * 2048);
    for (int ui = blockIdx.x; ui < (TC / 256) * 8; ui += F.G) {
        const int qb = ui >> 3, h = ui & 7, row0 = c0 + qb * 256;
        const int S = row0 < TP ? 2048 : 4096, pos0 = row0 < TP ? (row0 & 2047) : ((row0 - TP) & 4095);
        const int lq = qb * 256;
        if (MIXER == 0) {
            const int kvh = h >> 2, jlo = pos0 == 0 ? 2 : 0, jhi = (pos0 + 256 == S) ? 5 : 7, NT = jhi - jlo + 1;
            const int lk = lq - 128 + 64 * jlo;
            const float* tb = tblA + (size_t)h * (10 * 2048);
            const int wv = F.wave;
            auto tfn = [=](int j) -> const float* { const int idx = wv - 2 * (jlo + j) + 8; return ((unsigned)idx < 10u) ? tb + idx * 2048 : nullptr; };
            att::attn_unit<INC, D>(Z + (size_t)lq * INC + ZC_QA + h * HD, Z + (size_t)lk * INC + ZC_KA + kvh * HD, Z + (size_t)lk * INC + ZC_VA + kvh * HD,
                                   O + (size_t)lq * D + h * HD, NT, tfn, F.in[I_SINK][l * 8 + h] * LOG2E, F.lds + RING_OFF, F.tid);
        } else {
            const int rows = S >> 6, u4 = pos0 >> 6;
            const int lo_ = u4 - 4 < 0 ? 0 : (u4 - 4 > rows - 8 ? rows - 8 : u4 - 4), hiq = u4 + 3 - 4 < 0 ? 0 : (u4 - 1 > rows - 8 ? rows - 8 : u4 - 1);
            const int NT = hiq + 7 - lo_ + 1, lk = lq - pos0 + 64 * lo_;
            const int r = u4 + (F.wave >> 1), r0 = r - 4 < 0 ? 0 : (r - 4 > rows - 8 ? rows - 8 : r - 4);
            const float* tb = tblB + (size_t)(h * 15 * 2 + (F.wave & 1)) * 2048;
            auto tfn = [=](int j) -> const float* { const int kr = lo_ + j; return (kr >= r0 && kr <= r0 + 7) ? tb + (kr - r + 7) * (2 * 2048) : nullptr; };
            att::attn_unit<INC, D>(Z + (size_t)lq * INC + ZC_QB + h * HD, Z + (size_t)lk * INC + ZC_KB + h * HD, Z + (size_t)lk * INC + ZC_VB + h * HD,
                                   O + (size_t)lq * D + 1024 + h * HD, NT, tfn, -__builtin_inff(), F.lds + RING_OFF, F.tid);
        }
    }
}

#ifndef ATTN_FAST
#define ATTN_FAST 1
#endif
#ifndef SITE_MASK
#define SITE_MASK 0xffff
#endif
#define SITE(k) ((SITE_MASK >> (k)) & 1)
#ifndef REPEAT_MASK
#define REPEAT_MASK 0
#endif
#define REP(k) ((REPEAT_MASK >> (k)) & 1)
constexpr int PH_PER = 9, N_PHASES = 1 + 2 * 2 * PH_PER;
template <int l, int c> __device__ __forceinline__ void layer_chunk(Frame& F, const XcdBarrier& bar, const int lo, const int hi) {
#define RUN(ph) ((ph) >= lo && (ph) < hi)
#define SEAM(ph) do { if ((ph) + 1 < hi) xcd_barrier(bar); } while (0)
        unsigned char* wl = F.ws + WS_W + (size_t)l * W_LAYER;
        const pg8::bf16_t* WinT = (const pg8::bf16_t*)(wl + WO_IN); const pg8::bf16_t* WbrT = (const pg8::bf16_t*)(wl + WO_BR); const pg8::bf16_t* WoutT = (const pg8::bf16_t*)(wl + WO_OUT);
        const pg8::bf16_t* W1T = (const pg8::bf16_t*)(wl + WO_1); const pg8::bf16_t* W2T = (const pg8::bf16_t*)(wl + WO_2);
        pg8::bf16_t* Hb = (pg8::bf16_t*)(F.ws + WS_H); pg8::bf16_t* Zb = (pg8::bf16_t*)(F.ws + WS_Z); pg8::bf16_t* Ob = (pg8::bf16_t*)(F.ws + WS_O); pg8::bf16_t* Mb = (pg8::bf16_t*)(F.ws + WS_MB);
        {
            const int c0 = c * TC, pb = 1 + (l * NCH + c) * PH_PER;
            if (SITE(1) && RUN(pb + 0)) { { constexpr int rep = 0; (void)rep;  norm_phase(F, l, 0, c0, l == 0); SEAM(pb + 0);  }
                if (REP(1)) { constexpr int rep = 1; (void)rep;  norm_phase(F, l, 0, c0, l == 0); SEAM(pb + 0);  } }
            if (SITE(2) && RUN(pb + 1)) { { constexpr int rep = 0; (void)rep;  pg8::Gemm g{Hb, WinT, TC, INC, D, D, D}; pg8::StaticOrder S; S.init(TC, INC, F.G, (int)blockIdx.x);
                pg8::EpiZ E{Zb, INC, F.in[I_QNA] + l * HD, F.in[I_KNA] + l * HD, F.in[I_QNB] + l * HD, F.in[I_KNB] + l * HD, (PG8_LAS float*)(F.lds + PART_OFF)};
                pg8::gemm_phase<pg8::EpiZ, pg8::StaticOrder, true, PG8_SP2>(F.lds + RING_OFF, g, S, E); SEAM(pb + 1);  }
                if (REP(2)) { constexpr int rep = 1; (void)rep;  pg8::Gemm g{Hb, WinT, TC, INC, D, D, D}; pg8::StaticOrder S; S.init(TC, INC, F.G, (int)blockIdx.x);
                pg8::EpiZ E{Zb, INC, F.in[I_QNA] + l * HD, F.in[I_KNA] + l * HD, F.in[I_QNB] + l * HD, F.in[I_KNB] + l * HD, (PG8_LAS float*)(F.lds + PART_OFF)};
                pg8::gemm_phase<pg8::EpiZ, pg8::StaticOrder, true, PG8_SP2>(F.lds + RING_OFF, g, S, E); SEAM(pb + 1);  } }
            if (SITE(3) && RUN(pb + 2)) { { constexpr int rep = 0; (void)rep;
#if ATTN_FAST
                attn_fast<0>(F, l, c0); attn_fast<1>(F, l, c0);
#else
                attn_simple_A(F, l, c0); attn_simple_B(F, l, c0);
#endif
                SEAM(pb + 2);  }
                if (REP(3)) { constexpr int rep = 1; (void)rep;
#if ATTN_FAST
                attn_fast<0>(F, l, c0); attn_fast<1>(F, l, c0);
#else
                attn_simple_A(F, l, c0); attn_simple_B(F, l, c0);
#endif
                SEAM(pb + 2);  } }
            if (SITE(4) && RUN(pb + 3)) { { constexpr int rep = 0; (void)rep;  pg8::Gemm g{Ob, WbrT, TC, D, 1024, D, D}; pg8::StaticOrder S; S.init(TC, D, F.G, (int)blockIdx.x);
                pg8::EpiGate<0> E{Zb + ZC_GA, INC, nullptr, Hb, D};
                pg8::gemm_phase<pg8::EpiGate<0>, pg8::StaticOrder, PG8_ALIGN, PG8_SP2>(F.lds + RING_OFF, g, S, E); SEAM(pb + 3);  }
                if (REP(4)) { constexpr int rep = 1; (void)rep;  pg8::Gemm g{Ob, WbrT, TC, D, 1024, D, D}; pg8::StaticOrder S; S.init(TC, D, F.G, (int)blockIdx.x);
                pg8::EpiGate<0> E{Zb + ZC_GA, INC, nullptr, Hb, D};
                pg8::gemm_phase<pg8::EpiGate<0>, pg8::StaticOrder, PG8_ALIGN, PG8_SP2>(F.lds + RING_OFF, g, S, E); SEAM(pb + 3);  } }
            if (SITE(5) && RUN(pb + 4)) { { constexpr int rep = 0; (void)rep;  pg8::Gemm g{Ob + 1024, WbrT + 1024, TC, D, 1024, D, D}; pg8::StaticOrder S; S.init(TC, D, F.G, (int)blockIdx.x);
                pg8::EpiGate<1> E{Zb + ZC_GB, INC, Hb, Mb, D};
                pg8::gemm_phase<pg8::EpiGate<1>, pg8::StaticOrder, PG8_ALIGN, PG8_SP2>(F.lds + RING_OFF, g, S, E); SEAM(pb + 4);  }
                if (REP(5)) { constexpr int rep = 1; (void)rep;  pg8::Gemm g{Ob + 1024, WbrT + 1024, TC, D, 1024, D, D}; pg8::StaticOrder S; S.init(TC, D, F.G, (int)blockIdx.x);
                pg8::EpiGate<1> E{Zb + ZC_GB, INC, Hb, Mb, D};
                pg8::gemm_phase<pg8::EpiGate<1>, pg8::StaticOrder, PG8_ALIGN, PG8_SP2>(F.lds + RING_OFF, g, S, E); SEAM(pb + 4);  } }
            if (SITE(6) && RUN(pb + 5)) { { constexpr int rep = 0; (void)rep;  pg8::Gemm g{Mb, WoutT, TC, D, D, D, D}; pg8::StaticOrder S; S.init(TC, D, F.G, (int)blockIdx.x);
                pg8::EpiRes E{l == 0 ? F.in[I_XP] : nullptr, F.in[I_XS], F.out, (REP(6) && rep) ? (float*)(F.ws + WS_Z) - (size_t)c0 * D : F.out, F.mod + ((size_t)l * NSEQ * 6 + 2) * D, c0};
                pg8::gemm_phase<pg8::EpiRes, pg8::StaticOrder, PG8_ALIGN, PG8_SP2>(F.lds + RING_OFF, g, S, E); SEAM(pb + 5);  }
                if (REP(6)) { constexpr int rep = 1; (void)rep;  pg8::Gemm g{Mb, WoutT, TC, D, D, D, D}; pg8::StaticOrder S; S.init(TC, D, F.G, (int)blockIdx.x);
                pg8::EpiRes E{l == 0 ? F.in[I_XP] : nullptr, F.in[I_XS], F.out, (REP(6) && rep) ? (float*)(F.ws + WS_Z) - (size_t)c0 * D : F.out, F.mod + ((size_t)l * NSEQ * 6 + 2) * D, c0};
                pg8::gemm_phase<pg8::EpiRes, pg8::StaticOrder, PG8_ALIGN, PG8_SP2>(F.lds + RING_OFF, g, S, E); SEAM(pb + 5);  } }
            if (SITE(7) && RUN(pb + 6)) { { constexpr int rep = 0; (void)rep;  norm_phase(F, l, 1, c0, false); SEAM(pb + 6);  }
                if (REP(7)) { constexpr int rep = 1; (void)rep;  norm_phase(F, l, 1, c0, false); SEAM(pb + 6);  } }
#ifdef PROBE_G5_HALFK
            if (SITE(8) && RUN(pb + 7)) { pg8::Gemm g{Hb, W1T, TC, DFF, 1024, D, D}; pg8::StaticOrder S; S.init(TC, DFF, F.G, (int)blockIdx.x);
                pg8::EpiStore<1> E{Zb, DFF};
                pg8::gemm_phase<pg8::EpiStore<1>, pg8::StaticOrder, PG8_ALIGN, PG8_SP2>(F.lds + RING_OFF, g, S, E); xcd_barrier(bar); }
#endif
            if (SITE(8) && RUN(pb + 7)) { { constexpr int rep = 0; (void)rep;  pg8::Gemm g{Hb, W1T, TC, DFF, D, D, D}; pg8::StaticOrder S; S.init(TC, DFF, F.G, (int)blockIdx.x);
                pg8::EpiStore<1> E{Zb, DFF};
                pg8::gemm_phase<pg8::EpiStore<1>, pg8::StaticOrder, PG8_ALIGN, PG8_SP2>(F.lds + RING_OFF, g, S, E); SEAM(pb + 7);  }
                if (REP(8)) { constexpr int rep = 1; (void)rep;  pg8::Gemm g{Hb, W1T, TC, DFF, D, D, D}; pg8::StaticOrder S; S.init(TC, DFF, F.G, (int)blockIdx.x);
                pg8::EpiStore<1> E{Zb, DFF};
                pg8::gemm_phase<pg8::EpiStore<1>, pg8::StaticOrder, PG8_ALIGN, PG8_SP2>(F.lds + RING_OFF, g, S, E); SEAM(pb + 7);  } }
            if (SITE(9) && RUN(pb + 8)) { { constexpr int rep = 0; (void)rep;  pg8::Gemm g{Zb, W2T, TC, D, DFF, DFF, DFF}; pg8::StaticOrder S; S.init(TC, D, F.G, (int)blockIdx.x);
                pg8::EpiRes E{nullptr, F.in[I_XS], F.out, (REP(9) && rep) ? (float*)(F.ws + WS_O) - (size_t)c0 * D : F.out, F.mod + ((size_t)l * NSEQ * 6 + 5) * D, c0};
                pg8::gemm_phase<pg8::EpiRes, pg8::StaticOrder, PG8_ALIGN, PG8_SP2>(F.lds + RING_OFF, g, S, E); SEAM(pb + 8);  }
                if (REP(9)) { constexpr int rep = 1; (void)rep;  pg8::Gemm g{Zb, W2T, TC, D, DFF, DFF, DFF}; pg8::StaticOrder S; S.init(TC, D, F.G, (int)blockIdx.x);
                pg8::EpiRes E{nullptr, F.in[I_XS], F.out, (REP(9) && rep) ? (float*)(F.ws + WS_O) - (size_t)c0 * D : F.out, F.mod + ((size_t)l * NSEQ * 6 + 5) * D, c0};
                pg8::gemm_phase<pg8::EpiRes, pg8::StaticOrder, PG8_ALIGN, PG8_SP2>(F.lds + RING_OFF, g, S, E); SEAM(pb + 8);  } }
        }
#undef RUN
#undef SEAM
}

struct Args { const float* in[N_IN]; float* out; unsigned char* ws; int ph_lo, ph_hi; };
__global__ void __launch_bounds__(NWAVES * 64, 2) enc_fwd(Args a) {
    extern __shared__ __attribute__((aligned(16))) unsigned char lds_raw[];
    Frame F;
    F.lds = (LAS unsigned char*)lds_raw;
    F.tid = threadIdx.x; F.lane = F.tid & 63; F.wave = __builtin_amdgcn_readfirstlane(F.tid >> 6);
    F.G = gridDim.x; F.gw = blockIdx.x * NWAVES + F.wave; F.ngw = F.G * NWAVES;
#pragma unroll
    for (int i = 0; i < N_IN; ++i) F.in[i] = a.in[i];
    F.out = a.out; F.ws = a.ws; F.mod = (float*)(a.ws + WS_MOD);
    gu32* ctl = (gu32*)(a.ws + WS_CTL);
    for (int u = F.tid; u < (LDS_BYTES - LDSCTL_OFF) / 4; u += NWAVES * 64) ((LAS unsigned*)(F.lds + LDSCTL_OFF))[u] = 0u;
    __syncthreads();
    volatile LAS unsigned* MISC = (volatile LAS unsigned*)(F.lds + MISC_OFF);
    XcdBarrier bar = xcd_barrier_post((unsigned*)(ctl + CW_BAR), MISC + 8);
    const int lo = a.ph_lo, hi = a.ph_hi;
#define RUN(ph) ((ph) >= lo && (ph) < hi)
#define SEAM(ph) do { if ((ph) + 1 < hi) xcd_barrier(bar); } while (0)

    if (SITE(0) && RUN(0)) { { constexpr int rep = 0; (void)rep;  p0_mod(F); p0_tables(F); p0_weights(F); SEAM(0);  }
        if (REP(0)) { constexpr int rep = 1; (void)rep;  p0_mod(F); p0_tables(F); p0_weights(F); SEAM(0);  } }

    layer_chunk<0, 0>(F, bar, lo, hi); layer_chunk<0, 1>(F, bar, lo, hi); layer_chunk<1, 0>(F, bar, lo, hi); layer_chunk<1, 1>(F, bar, lo, hi);
    if (hi == N_PHASES && blockIdx.x == 0 && F.tid == 0) { if (__hip_atomic_load(ctl + CW_BAR + XB_TMO, RLX_AGENT) != 0u) F.out[0] = __builtin_nanf(""); }
#undef RUN
#undef SEAM
}

extern "C" void kernel_launch(void* const* d_in, const int* in_sizes, int n_in, void* d_out, int out_size, void* d_ws, size_t ws_size, hipStream_t stream) {
    static int grid = 0;
    if (grid == 0) {
        if (n_in != N_IN || out_size != TTOK * D || ws_size < WS_END) { fprintf(stderr, "kernel_launch: shape/workspace mismatch (n_in %d, out %d, ws %zu, need %zu); nothing launched\n", n_in, out_size, ws_size, (size_t)WS_END); grid = -1; return; }
        int dev = 0, cus = 0;
        if (hipGetDevice(&dev) != hipSuccess || hipDeviceGetAttribute(&cus, hipDeviceAttributeMultiprocessorCount, dev) != hipSuccess) { grid = -1; return; }
        if (hipFuncSetAttribute((const void*)enc_fwd, hipFuncAttributeMaxDynamicSharedMemorySize, LDS_BYTES) != hipSuccess) { fprintf(stderr, "kernel_launch: hipFuncSetAttribute failed\n"); grid = -1; return; }
        int per_cu = 0;
        if (hipOccupancyMaxActiveBlocksPerMultiprocessor(&per_cu, (const void*)enc_fwd, NWAVES * 64, LDS_BYTES) != hipSuccess || per_cu < 1) { fprintf(stderr, "kernel_launch: occupancy query says %d blocks per CU\n", per_cu); }
        (void)hipGetLastError();
        grid = cus;
    }
    if (grid < 0) return;
    if (hipMemsetAsync((char*)d_ws + WS_CTL, 0, CTL_ZERO_BYTES, stream) != hipSuccess) return;
    Args a{};
    for (int i = 0; i < N_IN; ++i) a.in[i] = (const float*)d_in[i];
    a.out = (float*)d_out; a.ws = (unsigned char*)d_ws;
#if MK_MULTI
    for (int ph = 0; ph < N_PHASES; ++ph) { a.ph_lo = ph; a.ph_hi = ph + 1; hipLaunchKernelGGL(enc_fwd, dim3(grid), dim3(NWAVES * 64), LDS_BYTES, stream, a); }
#else
    a.ph_lo = 0; a.ph_hi = N_PHASES;
    hipLaunchKernelGGL(enc_fwd, dim3(grid), dim3(NWAVES * 64), LDS_BYTES, stream, a);
#endif
    const hipError_t le = hipPeekAtLastError();
    if (le != hipSuccess) fprintf(stderr, "kernel_launch: launch failed: %s\n", hipGetErrorName(le));
}
```

```cpp
#include <hip/hip_runtime.h>
#include <cstdio>
#include <cstdint>
namespace pg8 {
#define PG8_LAS __attribute__((address_space(3)))
typedef unsigned short bf16_t;
typedef short bf16x8 __attribute__((ext_vector_type(8)));
typedef float f32x4 __attribute__((ext_vector_type(4)));
typedef unsigned u32x4 __attribute__((ext_vector_type(4)));
typedef int pg8_i32x4 __attribute__((ext_vector_type(4)));
typedef int pg8_i32x8 __attribute__((ext_vector_type(8)));
constexpr int BM = 256, BK = 64, HALF = 128, HTB = HALF * BK * 2  , STAGE_BYTES = 8 * HTB, NXCD = 8, WGM = 4;

__host__ __device__ __forceinline__ int lds_byte(int r, int c) { const int st = (r >> 4) * 2 + (c >> 5), rr = r & 15, cc = c & 31, ob = rr * 64 + cc * 2; return st * 1024 + (ob ^ (((ob >> 9) & 1) << 5)); }
__host__ __device__ __forceinline__ void stage_rc(int b, int& R, int& C) { const int st = b / 1024, sb = b % 1024, swz = sb ^ (((sb >> 9) & 1) << 5); R = (st >> 1) * 16 + swz / 64; C = (st & 1) * 32 + (swz % 64) / 2; }
__host__ __device__ __forceinline__ int perm32(int rho) { const int n = rho >> 4, i = rho & 15; return 8 * (i >> 2) + 4 * n + (i & 3); }

struct Unit { int pm, pn; };
struct Gemm { const bf16_t* A; const bf16_t* Bt; int M, N, K, lda, ldb; };

struct StaticOrder {
    int nM, nN, nwg, G, c; bool revm = false;
    bool rev = false;
    __host__ __device__ void init(int M, int N, int G_, int c_) { nM = M / BM; nN = N / BM; nwg = nM * nN; G = G_; c = c_; }
    __host__ __device__ bool next(int i, Unit& u) const {
        const long L = (long)i * G + c; if (L >= nwg) return false;
        int wgid = (int)L; { const int q = nwg / NXCD, r = nwg % NXCD, xcd = wgid % NXCD, off = wgid / NXCD; wgid = (xcd < r ? xcd * (q + 1) : r * (q + 1) + (xcd - r) * q) + off; }
        const int nig = WGM * nN; int gid = wgid / nig;
        if (revm) { const int q = nwg / NXCD; if (nwg % NXCD == 0 && q % nig == 0) { const int ngc = q / nig, x = gid / ngc; gid = x * ngc + (ngc - 1 - (gid - x * ngc)); } }
        const int fm = gid * WGM, gsz = (nM - fm) < WGM ? (nM - fm) : WGM;
        u.pm = fm + ((wgid % nig) % gsz); u.pn = (wgid % nig) / gsz; if (rev) u.pn = nN - 1 - u.pn; return true;
    }
    __device__ __forceinline__ void a_ready(const Unit&) const {}
    __device__ __forceinline__ void done(const Unit&) const {}
};
__device__ __forceinline__ unsigned cvt_pk_bf16(float lo, float hi) { unsigned r; asm volatile("v_cvt_pk_bf16_f32 %0, %1, %2" : "=v"(r) : "v"(lo), "v"(hi)); return r; }
typedef float f32x2 __attribute__((ext_vector_type(2)));
template <class Epi, class Sched, bool ALIGN_EPI = false, bool SP2 = false, bool FP8 = false>
__device__ __forceinline__ void gemm_phase(PG8_LAS unsigned char* lds, const Gemm g, const Sched& S, const Epi& E, const unsigned delay_ticks = 0u) {
    int tid_ = threadIdx.x; asm volatile("" : "+v"(tid_));
    const int tid = tid_, wid = __builtin_amdgcn_readfirstlane(tid >> 6), lane = tid & 63, wr = wid >> 2, wc = wid & 3, fr = lane & 15, fq = lane >> 4;
    const int K = g.K, nt = K / BK;
    unsigned voffA[2], voffB[2];
#pragma unroll
    for (int i = 0; i < 2; ++i) { int R, C; stage_rc(tid * 16 + i * 8192, R, C); const int Rb = Epi::PERM ? ((R & ~31) + perm32(R & 31)) : R;
        voffA[i] = (unsigned)(R * g.lda + C) * 2u; voffB[i] = (unsigned)(Rb * g.ldb + C) * 2u; }
    const size_t kstep = (size_t)(BK * 2);
    const size_t hstepA = (size_t)HALF * g.lda * 2, hstepB = (size_t)HALF * g.ldb * 2;
    const size_t tstepA = 2 * hstepA, tstepB = 2 * hstepB;
    const unsigned ldsw = (unsigned)wid * 1024u;
    const int aoff = lds_byte(wr * 64 + fr, fq * 8), boff = lds_byte(wc * 32 + fr, fq * 8);
#define PG8_SA(b, h) (((b) * 2 + (h)) * HTB)
#define PG8_SB(b, h) ((4 + (b) * 2 + (h)) * HTB)
#define PG8_STAGE(bufoff, gbase, voff) do { _Pragma("unroll") for (int _i = 0; _i < 2; ++_i) \
        __builtin_amdgcn_global_load_lds((const unsigned*)((const char*)(gbase) + (voff)[_i]), (PG8_LAS unsigned*)(lds + (bufoff) + ldsw + _i * 8192), 16, 0, 0); } while (0)
#define PG8_LDA(dst, b, h) do { if constexpr (FP8) { _Pragma("unroll") for (int m = 0; m < 4; ++m) dst##8[m] = __builtin_shufflevector(*(const PG8_LAS pg8_i32x4*)(lds + PG8_SA(b, h) + aoff + m * 2048), *(const PG8_LAS pg8_i32x4*)(lds + PG8_SA(b, h) + aoff + m * 2048 + 1024), 0, 1, 2, 3, 4, 5, 6, 7); } \
        else { _Pragma("unroll") for (int m = 0; m < 4; ++m) _Pragma("unroll") for (int k = 0; k < 2; ++k) dst[m][k] = *(const PG8_LAS bf16x8*)(lds + PG8_SA(b, h) + aoff + m * 2048 + k * 1024); } } while (0)
#define PG8_LDB(dst, b, h) do { if constexpr (FP8) { _Pragma("unroll") for (int n = 0; n < 2; ++n) dst##8[n] = __builtin_shufflevector(*(const PG8_LAS pg8_i32x4*)(lds + PG8_SB(b, h) + boff + n * 2048), *(const PG8_LAS pg8_i32x4*)(lds + PG8_SB(b, h) + boff + n * 2048 + 1024), 0, 1, 2, 3, 4, 5, 6, 7); } \
        else { _Pragma("unroll") for (int n = 0; n < 2; ++n) _Pragma("unroll") for (int k = 0; k < 2; ++k) dst[n][k] = *(const PG8_LAS bf16x8*)(lds + PG8_SB(b, h) + boff + n * 2048 + k * 1024); } } while (0)
#define PG8_CAT8(lo, hi) __builtin_shufflevector(__builtin_bit_cast(pg8_i32x4, lo), __builtin_bit_cast(pg8_i32x4, hi), 0, 1, 2, 3, 4, 5, 6, 7)
#define PG8_MMA(ai, bj, At, Bt) do { __builtin_amdgcn_s_setprio(1); \
        if constexpr (FP8) { _Pragma("unroll") for (int m = 0; m < 4; ++m) _Pragma("unroll") for (int n = 0; n < 2; ++n) \
            asm volatile("v_mfma_scale_f32_16x16x128_f8f6f4 %0, %1, %2, %0, %3, %3 op_sel_hi:[0,0,0]" : "+v"(acc[ai][bj][m][n]) : "v"(Bt##8[n]), "v"(At##8[m]), "v"(one_e8m0)); } \
        else { _Pragma("unroll") for (int m = 0; m < 4; ++m) _Pragma("unroll") for (int n = 0; n < 2; ++n) _Pragma("unroll") for (int k = 0; k < 2; ++k) \
            acc[ai][bj][m][n] = __builtin_amdgcn_mfma_f32_16x16x32_bf16(Bt[n][k], At[m][k], acc[ai][bj][m][n], 0, 0, 0); } \
        __builtin_amdgcn_s_setprio(0); } while (0)
#define PG8_WAIT_V(n) asm volatile("s_waitcnt vmcnt(" #n ")" ::: "memory")
#define PG8_WAIT_L(n) asm volatile("s_waitcnt lgkmcnt(" #n ")" ::: "memory")
#define PG8_BAR __builtin_amdgcn_s_barrier()
#define PG8_SCHED __builtin_amdgcn_sched_barrier(0)
    if (delay_ticks) { const unsigned long long t0 = __builtin_amdgcn_s_memrealtime(); while (__builtin_amdgcn_s_memrealtime() - t0 < (unsigned long long)delay_ticks) __builtin_amdgcn_s_sleep(8); }
    Unit cur, nxt; int ui = 0;
    if (!S.next(0, cur)) return;
    f32x4 acc[2][2][4][2];
#pragma unroll
    for (int a = 0; a < 2; ++a)
#pragma unroll
        for (int b = 0; b < 2; ++b)
#pragma unroll
            for (int m = 0; m < 4; ++m)
#pragma unroll
                for (int n = 0; n < 2; ++n) acc[a][b][m][n] = (f32x4){0.f, 0.f, 0.f, 0.f};
    bf16x8 At[4][2], B0[2][2], B1[2][2];
    const int one_e8m0 = 127;
    pg8_i32x8 At8[4], B08[2], B18[2];
    const char* cA = (const char*)g.A + (size_t)cur.pm * tstepA; const char* cB = (const char*)g.Bt + (size_t)cur.pn * tstepB;
    S.a_ready(cur);
    if constexpr (SP2) {
        PG8_STAGE(PG8_SB(0, 0), cB, voffB); PG8_STAGE(PG8_SB(0, 1), cB + hstepB, voffB); PG8_STAGE(PG8_SA(0, 0), cA, voffA); PG8_STAGE(PG8_SA(0, 1), cA + hstepA, voffA);
        if (wr == 1) PG8_BAR;
        PG8_WAIT_V(2); PG8_BAR;
        PG8_STAGE(PG8_SB(1, 0), cB + kstep, voffB); PG8_STAGE(PG8_SA(1, 0), cA + kstep, voffA); PG8_STAGE(PG8_SB(1, 1), cB + hstepB + kstep, voffB);
        PG8_WAIT_V(6); PG8_BAR;
    } else {
        PG8_STAGE(PG8_SB(0, 0), cB, voffB); PG8_STAGE(PG8_SA(0, 0), cA, voffA); PG8_STAGE(PG8_SB(0, 1), cB + hstepB, voffB); PG8_STAGE(PG8_SA(0, 1), cA + hstepA, voffA);
        if (wr == 1) PG8_BAR;
        PG8_WAIT_V(4); PG8_BAR;
        PG8_STAGE(PG8_SB(1, 0), cB + kstep, voffB); PG8_STAGE(PG8_SA(1, 0), cA + kstep, voffA); PG8_STAGE(PG8_SB(1, 1), cB + hstepB + kstep, voffB);
        PG8_WAIT_V(6); PG8_BAR;
    }
    for (;;) {
        const bool has_next = S.next(ui + 1, nxt);
        const char* nA = has_next ? (const char*)g.A + (size_t)nxt.pm * tstepA : cA; const char* nB = has_next ? (const char*)g.Bt + (size_t)nxt.pn * tstepB : cB;
        auto kloop = [&](const int tb, const int te) __attribute__((always_inline)) {
        for (int t = tb; t < te; t += 2) {
            const bool last = (t == nt - 2);
            const char* a1 = cA + (size_t)(t + 1) * kstep;
            const char* a2 = last ? nA : cA + (size_t)(t + 2) * kstep; const char* b2 = last ? nB : cB + (size_t)(t + 2) * kstep;
            const char* a3 = a2 + kstep; const char* b3 = b2 + kstep;
            if (last && has_next) S.a_ready(nxt);
            if constexpr (SP2) {
            PG8_LDB(B0, 0, 0); PG8_LDB(B1, 0, 1); PG8_SCHED; PG8_LDA(At, 0, 0); PG8_STAGE(PG8_SA(1, 1), a1 + hstepA, voffA);
            PG8_WAIT_V(8); PG8_WAIT_L(0); PG8_BAR; PG8_MMA(0, 0, At, B0); PG8_MMA(0, 1, At, B1); PG8_BAR; PG8_SCHED;
            PG8_LDA(At, 0, 1); PG8_STAGE(PG8_SB(0, 0), b2, voffB); PG8_STAGE(PG8_SB(0, 1), b2 + hstepB, voffB); PG8_STAGE(PG8_SA(0, 0), a2, voffA);
            PG8_WAIT_V(8); PG8_WAIT_L(0); PG8_BAR; PG8_MMA(1, 0, At, B0); PG8_MMA(1, 1, At, B1); PG8_BAR; PG8_SCHED;
            PG8_LDB(B0, 1, 0); PG8_LDB(B1, 1, 1); PG8_SCHED; PG8_LDA(At, 1, 0); PG8_STAGE(PG8_SA(0, 1), a2 + hstepA, voffA);
            PG8_WAIT_V(8); PG8_WAIT_L(0); PG8_BAR; PG8_MMA(0, 0, At, B0); PG8_MMA(0, 1, At, B1); PG8_BAR; PG8_SCHED;
            PG8_LDA(At, 1, 1); PG8_STAGE(PG8_SB(1, 0), b3, voffB); PG8_STAGE(PG8_SB(1, 1), b3 + hstepB, voffB); PG8_STAGE(PG8_SA(1, 0), a3, voffA);
            PG8_WAIT_V(8); PG8_WAIT_L(0); PG8_BAR; PG8_MMA(1, 0, At, B0); PG8_MMA(1, 1, At, B1); PG8_BAR; PG8_SCHED;
            } else {
            PG8_LDB(B0, 0, 0); PG8_SCHED; PG8_LDA(At, 0, 0); PG8_STAGE(PG8_SA(1, 1), a1 + hstepA, voffA);
            PG8_WAIT_L(8); PG8_BAR; PG8_WAIT_L(0); PG8_MMA(0, 0, At, B0); PG8_BAR; PG8_SCHED;
            PG8_LDB(B1, 0, 1); PG8_STAGE(PG8_SB(0, 0), b2, voffB);
            PG8_BAR; PG8_WAIT_L(0); PG8_MMA(0, 1, At, B1); PG8_BAR;
            PG8_LDA(At, 0, 1); PG8_STAGE(PG8_SA(0, 0), a2, voffA);
            PG8_BAR; PG8_WAIT_L(0); PG8_MMA(1, 0, At, B0); PG8_BAR; PG8_SCHED;
            PG8_STAGE(PG8_SB(0, 1), b2 + hstepB, voffB);
            PG8_WAIT_V(6); PG8_BAR; PG8_MMA(1, 1, At, B1); PG8_BAR;
            PG8_LDB(B0, 1, 0); PG8_SCHED; PG8_LDA(At, 1, 0); PG8_STAGE(PG8_SA(0, 1), a2 + hstepA, voffA);
            PG8_WAIT_L(8); PG8_BAR; PG8_WAIT_L(0); PG8_MMA(0, 0, At, B0); PG8_BAR; PG8_SCHED;
            PG8_LDB(B1, 1, 1); PG8_STAGE(PG8_SB(1, 0), b3, voffB);
            PG8_BAR; PG8_WAIT_L(0); PG8_MMA(0, 1, At, B1); PG8_BAR;
            PG8_LDA(At, 1, 1); PG8_STAGE(PG8_SA(1, 0), a3, voffA);
            PG8_BAR; PG8_WAIT_L(0); PG8_MMA(1, 0, At, B0); PG8_BAR; PG8_SCHED;
            PG8_STAGE(PG8_SB(1, 1), b3 + hstepB, voffB);
            PG8_WAIT_V(6); PG8_BAR; PG8_MMA(1, 1, At, B1); PG8_BAR;
            }
        }
        };
        if constexpr (Epi::HAS_MID) { kloop(0, nt / 2); { int fr_m = fr, fq_m = fq; asm volatile("" : "+v"(fr_m), "+v"(fq_m)); E.mid(acc, cur, wr, wc, fr_m, fq_m); } kloop(nt / 2, nt); }
        else kloop(0, nt);
        if constexpr (FP8) asm volatile("s_nop 7\n\ts_nop 7\n\ts_nop 7" ::: "memory");
        if constexpr (ALIGN_EPI) { if (wr == 0) PG8_BAR; }
        if constexpr (!Epi::AFTER_DRAIN) { int fr_e = fr, fq_e = fq; asm volatile("" : "+v"(fr_e), "+v"(fq_e));
            E(acc, cur, wr, wc, fr_e, fq_e); S.done(cur); }
        if (!has_next) break;
#pragma unroll
        for (int a = 0; a < 2; ++a)
#pragma unroll
            for (int b = 0; b < 2; ++b)
#pragma unroll
                for (int m = 0; m < 4; ++m)
#pragma unroll
                    for (int n = 0; n < 2; ++n) acc[a][b][m][n] = (f32x4){0.f, 0.f, 0.f, 0.f};
        cur = nxt; cA = nA; cB = nB; ++ui;
        if constexpr (ALIGN_EPI) { if (wr == 1) PG8_BAR; }
    }
    PG8_WAIT_V(0);
    if constexpr (!ALIGN_EPI) { if (wr == 0) PG8_BAR; }
    PG8_BAR;
    if constexpr (Epi::AFTER_DRAIN) { E.fused(acc, cur, wr, wc, fr, fq, lds, wid, lane); S.done(cur); }
#undef PG8_SA
#undef PG8_SB
#undef PG8_STAGE
#undef PG8_LDA
#undef PG8_LDB
#undef PG8_MMA
#undef PG8_CAT8
#undef PG8_WAIT_V
#undef PG8_WAIT_L
#undef PG8_BAR
#undef PG8_SCHED
}
}

namespace pg8 {
__device__ __forceinline__ float bf_lo(unsigned w) { return __uint_as_float(w << 16); }
__device__ __forceinline__ float bf_hi(unsigned w) { return __uint_as_float(w & 0xffff0000u); }
__device__ __forceinline__ float sigmoidf_fast(float g) { return __builtin_amdgcn_rcpf(1.0f + __builtin_amdgcn_exp2f(-1.4426950408889634f * g)); }

template <int ACT  > struct EpiStore {
    static constexpr bool PERM = true, AFTER_DRAIN = false, HAS_MID = false;
    bf16_t* O; int ldc;
    __device__ __forceinline__ void operator()(const f32x4 (&acc)[2][2][4][2], const Unit& u, int wr, int wc, int fr, int fq) const {
        const int row0 = u.pm * BM + wr * 64 + fr, col0 = u.pn * BM + wc * 32 + 8 * fq;
#pragma unroll
        for (int ai = 0; ai < 2; ++ai)
#pragma unroll
            for (int m = 0; m < 4; ++m) { bf16_t* rowp = O + (size_t)(row0 + ai * HALF + m * 16) * ldc + col0;
#pragma unroll
                for (int bj = 0; bj < 2; ++bj) { f32x4 v0 = acc[ai][bj][m][0], v1 = acc[ai][bj][m][1];
                    if (ACT == 1) { const f32x4 z = (f32x4){0.f, 0.f, 0.f, 0.f}; v0 = __builtin_elementwise_max(v0, z); v1 = __builtin_elementwise_max(v1, z); v0 = v0 * v0; v1 = v1 * v1; }
                    u32x4 w; w.x = cvt_pk_bf16(v0[0], v0[1]); w.y = cvt_pk_bf16(v0[2], v0[3]); w.z = cvt_pk_bf16(v1[0], v1[1]); w.w = cvt_pk_bf16(v1[2], v1[3]);
                    *(u32x4*)(rowp + bj * HALF) = w; } }
    }
};
typedef unsigned long long ssq_t;
__device__ __forceinline__ ssq_t ssq_fix(float t) { return (ssq_t)(t * 16777216.0f); }
__device__ __forceinline__ float ssq_flt(ssq_t v) { return fmaf((float)(unsigned)(v >> 32), 4294967296.0f, (float)(unsigned)v) * (1.0f / 16777216.0f); }
constexpr int PFB_PAR = 3072;
struct PrefetchOrder : StaticOrder {
    const ssq_t* ssq; const float* shw; int ldw; int row_off; PG8_LAS unsigned char* buf; mutable int cnt;
    __device__ __forceinline__ void a_ready(const Unit& u) const {
        const int par = cnt & 1; ++cnt;
        const int tid = threadIdx.x, wave = __builtin_amdgcn_readfirstlane(tid >> 6), lane = tid & 63;
        if (wave == 0) { __builtin_amdgcn_global_load_lds((const unsigned*)(ssq + u.pm * BM + lane * 2), (PG8_LAS unsigned*)(buf + par * PFB_PAR), 16, 0, 0);
            __builtin_amdgcn_global_load_lds((const unsigned*)(ssq + u.pm * BM + 128 + lane * 2), (PG8_LAS unsigned*)(buf + par * PFB_PAR + 1024), 16, 0, 0); }
        else if (wave == 1) { const int rowg = row_off + u.pm * BM, b = rowg < 32768 ? (rowg >> 11) : 16 + ((rowg - 32768) >> 12);
            __builtin_amdgcn_global_load_lds((const unsigned*)(shw + (size_t)b * ldw + u.pn * BM + lane * 4), (PG8_LAS unsigned*)(buf + par * PFB_PAR + 2048), 16, 0, 0); }
    }
};
struct EpiZ {
    static constexpr bool PERM = true, AFTER_DRAIN = false, HAS_MID = false;
    bf16_t* O; int ldc; const float* qna; const float* kna; const float* qnb; const float* knb; PG8_LAS float* part;
    PG8_LAS unsigned char* buf; mutable int cnt;
    __device__ __forceinline__ void operator()(const f32x4 (&acc)[2][2][4][2], const Unit& u, int wr, int wc, int fr, int fq) const {
        const int row0 = u.pm * BM + wr * 64 + fr, col0 = u.pn * BM + wc * 32 + 8 * fq;
        const float* gain = u.pn < 4 ? qna : (u.pn == 4 ? kna : (u.pn == 5 ? nullptr : (u.pn < 10 ? qnb : (u.pn < 14 ? knb : nullptr))));
        const PG8_LAS ssq_t* pq = (const PG8_LAS ssq_t*)(buf + (cnt & 1) * PFB_PAR); const PG8_LAS float* pv = (const PG8_LAS float*)(buf + (cnt & 1) * PFB_PAR + 2048); ++cnt;
        f32x4 (&A)[2][2][4][2] = const_cast<f32x4 (&)[2][2][4][2]>(acc);
        { float rd[2][4];
#pragma unroll
          for (int ai = 0; ai < 2; ++ai)
#pragma unroll
              for (int m = 0; m < 4; ++m) rd[ai][m] = ssq_flt(pq[wr * 64 + fr + ai * HALF + m * 16]);
#pragma unroll
          for (int ai = 0; ai < 2; ++ai)
#pragma unroll
              for (int m = 0; m < 4; ++m) rd[ai][m] = rsqrtf(rd[ai][m] * (1.f / 2048.f) + 1e-6f) * (1.0f / 64.0f);
#pragma unroll
          for (int bj = 0; bj < 2; ++bj) { const f32x4 s0 = *(const PG8_LAS f32x4*)(pv + wc * 32 + 8 * fq + bj * HALF), s1 = *(const PG8_LAS f32x4*)(pv + wc * 32 + 8 * fq + bj * HALF + 4);
#pragma unroll
              for (int ai = 0; ai < 2; ++ai)
#pragma unroll
                  for (int m = 0; m < 4; ++m) { A[ai][bj][m][0] = A[ai][bj][m][0] * rd[ai][m] + s0; A[ai][bj][m][1] = A[ai][bj][m][1] * rd[ai][m] + s1; } } }
        if (gain != nullptr) {
#pragma unroll
            for (int ai = 0; ai < 2; ++ai)
#pragma unroll
                for (int m = 0; m < 4; ++m)
#pragma unroll
                    for (int bj = 0; bj < 2; ++bj) { const f32x4 a = A[ai][bj][m][0], b = A[ai][bj][m][1];
                        float ss = (a[0] * a[0] + a[1] * a[1]) + (a[2] * a[2] + a[3] * a[3]) + (b[0] * b[0] + b[1] * b[1]) + (b[2] * b[2] + b[3] * b[3]);
                        ss += __shfl_xor(ss, 16); ss += __shfl_xor(ss, 32);
                        if (fq == 0) part[((ai * HALF + wr * 64 + m * 16 + fr) * 2 + bj) * 4 + wc] = ss; }
            asm volatile("s_waitcnt lgkmcnt(0)" ::: "memory"); __builtin_amdgcn_s_barrier(); asm volatile("" ::: "memory");
            const f32x4 g0 = *(const f32x4*)(gain + wc * 32 + 8 * fq), g1 = *(const f32x4*)(gain + wc * 32 + 8 * fq + 4);
#pragma unroll
            for (int ai = 0; ai < 2; ++ai)
#pragma unroll
                for (int m = 0; m < 4; ++m) { bf16_t* rowp = O + (size_t)(row0 + ai * HALF + m * 16) * ldc + col0;
#pragma unroll
                    for (int bj = 0; bj < 2; ++bj) { const f32x4 p = *(const PG8_LAS f32x4*)(part + ((ai * HALF + wr * 64 + m * 16 + fr) * 2 + bj) * 4);
                        const float rs = rsqrtf(((p[0] + p[1]) + (p[2] + p[3])) * (1.f / 128.f) + 1e-6f);
                        const f32x4 v0 = A[ai][bj][m][0] * g0 * rs, v1 = A[ai][bj][m][1] * g1 * rs;
                        u32x4 w; w.x = cvt_pk_bf16(v0[0], v0[1]); w.y = cvt_pk_bf16(v0[2], v0[3]); w.z = cvt_pk_bf16(v1[0], v1[1]); w.w = cvt_pk_bf16(v1[2], v1[3]);
                        *(u32x4*)(rowp + bj * HALF) = w; } }
        } else {
            if (u.pn >= 18) {
                constexpr int GA0 = 4608, GB0 = 6656; const int d0 = (u.pn - 18) * HALF + wc * 32 + 8 * fq;
#pragma unroll
                for (int ai = 0; ai < 2; ++ai)
#pragma unroll
                    for (int m = 0; m < 4; ++m) { bf16_t* rowp = O + (size_t)(row0 + ai * HALF + m * 16) * ldc + d0;
                        f32x4 r0, r1, s0, s1;
#pragma unroll
                        for (int e = 0; e < 4; ++e) {
                            const float ea0 = 1.0f + __builtin_amdgcn_exp2f(-1.4426950408889634f * A[ai][0][m][0][e]), eb0 = 1.0f + __builtin_amdgcn_exp2f(-1.4426950408889634f * A[ai][1][m][0][e]);
                            const float ea1 = 1.0f + __builtin_amdgcn_exp2f(-1.4426950408889634f * A[ai][0][m][1][e]), eb1 = 1.0f + __builtin_amdgcn_exp2f(-1.4426950408889634f * A[ai][1][m][1][e]);
                            r0[e] = eb0 * __builtin_amdgcn_rcpf(ea0); s0[e] = __builtin_amdgcn_rcpf(eb0); r1[e] = eb1 * __builtin_amdgcn_rcpf(ea1); s1[e] = __builtin_amdgcn_rcpf(eb1); }
                        u32x4 w; w.x = cvt_pk_bf16(r0[0], r0[1]); w.y = cvt_pk_bf16(r0[2], r0[3]); w.z = cvt_pk_bf16(r1[0], r1[1]); w.w = cvt_pk_bf16(r1[2], r1[3]);
                        *(u32x4*)(rowp + GA0) = w;
                        w.x = cvt_pk_bf16(s0[0], s0[1]); w.y = cvt_pk_bf16(s0[2], s0[3]); w.z = cvt_pk_bf16(s1[0], s1[1]); w.w = cvt_pk_bf16(s1[2], s1[3]);
                        *(u32x4*)(rowp + GB0) = w; }
            } else {
#pragma unroll
            for (int ai = 0; ai < 2; ++ai)
#pragma unroll
                for (int m = 0; m < 4; ++m) { bf16_t* rowp = O + (size_t)(row0 + ai * HALF + m * 16) * ldc + col0;
#pragma unroll
                    for (int bj = 0; bj < 2; ++bj) { const f32x4 v0 = A[ai][bj][m][0], v1 = A[ai][bj][m][1];
                        u32x4 w; w.x = cvt_pk_bf16(v0[0], v0[1]); w.y = cvt_pk_bf16(v0[2], v0[3]); w.z = cvt_pk_bf16(v1[0], v1[1]); w.w = cvt_pk_bf16(v1[2], v1[3]);
                        *(u32x4*)(rowp + bj * HALF) = w; } }
            }
        }
    }
};
template <int MODE> struct EpiGate {
    static constexpr bool PERM = true, AFTER_DRAIN = false, HAS_MID = false;
    const bf16_t* G; int ldg; const bf16_t* P; bf16_t* O; int ldo;
    __device__ __forceinline__ void operator()(const f32x4 (&acc)[2][2][4][2], const Unit& u, int wr, int wc, int fr, int fq) const {
        const int row0 = u.pm * BM + wr * 64 + fr, col0 = u.pn * BM + wc * 32 + 8 * fq;
#pragma unroll
        for (int ai = 0; ai < 2; ++ai) {
            u32x4 gw[4][2], pw[4][2];
#pragma unroll
            for (int m = 0; m < 4; ++m)
#pragma unroll
                for (int bj = 0; bj < 2; ++bj) { const size_t row = (size_t)(row0 + ai * HALF + m * 16); const int col = col0 + bj * HALF;
                    gw[m][bj] = *(const u32x4*)(G + row * ldg + col); if (MODE == 1) pw[m][bj] = *(const u32x4*)(P + row * ldo + col); }
            asm volatile("" ::: "memory");
#pragma unroll
            for (int m = 0; m < 4; ++m)
#pragma unroll
                for (int bj = 0; bj < 2; ++bj) { const size_t row = (size_t)(row0 + ai * HALF + m * 16); const int col = col0 + bj * HALF; const u32x4 g4 = gw[m][bj];
                    f32x4 v0 = acc[ai][bj][m][0], v1 = acc[ai][bj][m][1];
                    v0[0] *= sigmoidf_fast(bf_lo(g4.x)); v0[1] *= sigmoidf_fast(bf_hi(g4.x)); v0[2] *= sigmoidf_fast(bf_lo(g4.y)); v0[3] *= sigmoidf_fast(bf_hi(g4.y));
                    v1[0] *= sigmoidf_fast(bf_lo(g4.z)); v1[1] *= sigmoidf_fast(bf_hi(g4.z)); v1[2] *= sigmoidf_fast(bf_lo(g4.w)); v1[3] *= sigmoidf_fast(bf_hi(g4.w));
                    if (MODE == 1) { const u32x4 p4 = pw[m][bj];
                        v0[0] += bf_lo(p4.x); v0[1] += bf_hi(p4.x); v0[2] += bf_lo(p4.y); v0[3] += bf_hi(p4.y);
                        v1[0] += bf_lo(p4.z); v1[1] += bf_hi(p4.z); v1[2] += bf_lo(p4.w); v1[3] += bf_hi(p4.w); }
                    u32x4 w; w.x = cvt_pk_bf16(v0[0], v0[1]); w.y = cvt_pk_bf16(v0[2], v0[3]); w.z = cvt_pk_bf16(v1[0], v1[1]); w.w = cvt_pk_bf16(v1[2], v1[3]);
                    *(u32x4*)(O + row * ldo + col) = w; }
            asm volatile("" ::: "memory");
        }
    }
};
template <int LDG, int LDO, bool FP8OUT, bool ACC64 = false> struct EpiGateMid {
    static constexpr bool PERM = true, AFTER_DRAIN = false, HAS_MID = true;
    const bf16_t* GA; const bf16_t* GB; bf16_t* O;
    __device__ __forceinline__ void mid(f32x4 (&acc)[2][2][4][2], const Unit& u, int wr, int wc, int fr, int fq) const {
        asm volatile("" : "+v"(fr), "+v"(fq));
        const unsigned go = (unsigned)((u.pm * BM + wr * 64 + fr) * LDG + u.pn * BM + wc * 32 + 8 * fq);
#pragma unroll
        for (int hb = 0; hb < 4; ++hb) { const int bj = hb >> 1, ai = hb & 1;
            u32x4 ga[4];
#pragma unroll
            for (int m = 0; m < 4; ++m) { const unsigned o = go + (unsigned)((ai * HALF + m * 16) * LDG + bj * HALF); ga[m] = *(const u32x4*)(GA + o); }
            asm volatile("" ::: "memory");
#pragma unroll
            for (int m = 0; m < 4; ++m) {
                f32x4& v0 = acc[ai][bj][m][0]; f32x4& v1 = acc[ai][bj][m][1];
                v0[0] *= bf_lo(ga[m].x); v0[1] *= bf_hi(ga[m].x); v0[2] *= bf_lo(ga[m].y); v0[3] *= bf_hi(ga[m].y);
                v1[0] *= bf_lo(ga[m].z); v1[1] *= bf_hi(ga[m].z); v1[2] *= bf_lo(ga[m].w); v1[3] *= bf_hi(ga[m].w);
                asm volatile("" : "+v"(v0), "+v"(v1)); }
        }
    }
    __device__ __forceinline__ void operator()(const f32x4 (&acc)[2][2][4][2], const Unit& u, int wr, int wc, int fr, int fq) const {
        asm volatile("" : "+v"(fr), "+v"(fq));
        const unsigned go = (unsigned)((u.pm * BM + wr * 64 + fr) * LDG + u.pn * BM + wc * 32 + 8 * fq), oo = (unsigned)((u.pm * BM + wr * 64 + fr) * LDO + u.pn * BM + wc * 32 + 8 * fq);
#pragma unroll
        for (int ai = 0; ai < 2; ++ai) {
            u32x4 gw[4][2];
#pragma unroll
            for (int m = 0; m < 4; ++m)
#pragma unroll
                for (int bj = 0; bj < 2; ++bj) gw[m][bj] = *(const u32x4*)(GB + (go + (unsigned)((ai * HALF + m * 16) * LDG + bj * HALF)));
            asm volatile("" ::: "memory");
#pragma unroll
            for (int m = 0; m < 4; ++m)
#pragma unroll
                for (int bj = 0; bj < 2; ++bj) { const u32x4 g4 = gw[m][bj]; f32x4 v0 = acc[ai][bj][m][0], v1 = acc[ai][bj][m][1];
                    if (ACC64) { v0 = v0 * (1.0f / 64.0f); v1 = v1 * (1.0f / 64.0f); }
                    v0[0] *= bf_lo(g4.x); v0[1] *= bf_hi(g4.x); v0[2] *= bf_lo(g4.y); v0[3] *= bf_hi(g4.y);
                    v1[0] *= bf_lo(g4.z); v1[1] *= bf_hi(g4.z); v1[2] *= bf_lo(g4.w); v1[3] *= bf_hi(g4.w);
                    if constexpr (FP8OUT) { int w0 = 0, w1 = 0; w0 = __builtin_amdgcn_cvt_pk_fp8_f32(v0[0], v0[1], w0, false); w0 = __builtin_amdgcn_cvt_pk_fp8_f32(v0[2], v0[3], w0, true);
                        w1 = __builtin_amdgcn_cvt_pk_fp8_f32(v1[0], v1[1], w1, false); w1 = __builtin_amdgcn_cvt_pk_fp8_f32(v1[2], v1[3], w1, true);
                        typedef int i32x2 __attribute__((ext_vector_type(2))); *(i32x2*)((unsigned char*)O + (oo + (unsigned)((ai * HALF + m * 16) * LDO + bj * HALF))) = (i32x2){w0, w1}; }
                    else { u32x4 w; w.x = cvt_pk_bf16(v0[0], v0[1]); w.y = cvt_pk_bf16(v0[2], v0[3]); w.z = cvt_pk_bf16(v1[0], v1[1]); w.w = cvt_pk_bf16(v1[2], v1[3]);
                    *(u32x4*)(O + (oo + (unsigned)((ai * HALF + m * 16) * LDO + bj * HALF))) = w; } }
            asm volatile("" ::: "memory");
        }
    }
};
struct EpiRes {
    static constexpr bool PERM = false, AFTER_DRAIN = false, HAS_MID = false;
    const float* xp; const float* xs; const float* xb; float* out; const float* modg; int row_off;
    __device__ __forceinline__ void operator()(const f32x4 (&acc)[2][2][4][2], const Unit& u, int wr, int wc, int fr, int fq) const {
        const int rowg = row_off + u.pm * BM;
        const int b = rowg < 32768 ? (rowg >> 11) : 16 + ((rowg - 32768) >> 12);
        const float* gvec = modg + (size_t)b * (6 * 2048);
        const float* base = xp ? (rowg < 32768 ? xp + (size_t)rowg * 2048 : xs + (size_t)(rowg - 32768) * 2048) : xb + (size_t)rowg * 2048;
        float* op = out + (size_t)rowg * 2048;
        const int r0 = wr * 64 + fr, col0 = u.pn * BM + wc * 32 + 4 * fq;
        f32x4 gv[2][2];
#pragma unroll
        for (int bj = 0; bj < 2; ++bj)
#pragma unroll
            for (int n = 0; n < 2; ++n) gv[bj][n] = *(const f32x4*)(gvec + col0 + bj * HALF + n * 16);
#pragma unroll
        for (int ai = 0; ai < 2; ++ai) {
            f32x4 bs[4][2][2];
#pragma unroll
            for (int m = 0; m < 4; ++m)
#pragma unroll
                for (int bj = 0; bj < 2; ++bj)
#pragma unroll
                    for (int n = 0; n < 2; ++n) bs[m][bj][n] = *(const f32x4*)(base + (size_t)(r0 + ai * HALF + m * 16) * 2048 + col0 + bj * HALF + n * 16);
            asm volatile("" ::: "memory");
#pragma unroll
            for (int m = 0; m < 4; ++m)
#pragma unroll
                for (int bj = 0; bj < 2; ++bj)
#pragma unroll
                    for (int n = 0; n < 2; ++n) *(f32x4*)(op + (size_t)(r0 + ai * HALF + m * 16) * 2048 + col0 + bj * HALF + n * 16) = bs[m][bj][n] + gv[bj][n] * acc[ai][bj][m][n];
            asm volatile("" ::: "memory");
        }
    }
};
template <bool ACC64 = false> struct EpiMlp1 {
    static constexpr bool PERM = true, AFTER_DRAIN = false, HAS_MID = false;
    bf16_t* O; int ldc; PG8_LAS unsigned char* buf; mutable int cnt;
    __device__ __forceinline__ void operator()(const f32x4 (&acc)[2][2][4][2], const Unit& u, int wr, int wc, int fr, int fq) const {
        const int row0 = u.pm * BM + wr * 64 + fr, col0 = u.pn * BM + wc * 32 + 8 * fq;
        const PG8_LAS ssq_t* pq = (const PG8_LAS ssq_t*)(buf + (cnt & 1) * PFB_PAR); const PG8_LAS float* pv = (const PG8_LAS float*)(buf + (cnt & 1) * PFB_PAR + 2048); ++cnt;
        f32x4 s0[2], s1[2]; float rs[2][4];
#pragma unroll
        for (int bj = 0; bj < 2; ++bj) { s0[bj] = *(const PG8_LAS f32x4*)(pv + wc * 32 + 8 * fq + bj * HALF); s1[bj] = *(const PG8_LAS f32x4*)(pv + wc * 32 + 8 * fq + bj * HALF + 4); }
#pragma unroll
        for (int ai = 0; ai < 2; ++ai)
#pragma unroll
            for (int m = 0; m < 4; ++m) rs[ai][m] = ssq_flt(pq[wr * 64 + fr + ai * HALF + m * 16]);
#pragma unroll
        for (int ai = 0; ai < 2; ++ai)
#pragma unroll
            for (int m = 0; m < 4; ++m) { const float r = rsqrtf(rs[ai][m] * (1.f / 2048.f) + 1e-6f) * (ACC64 ? (1.0f / 64.0f) : 1.0f); bf16_t* rowp = O + (size_t)(row0 + ai * HALF + m * 16) * ldc + col0;
#pragma unroll
                for (int bj = 0; bj < 2; ++bj) { const f32x4 z = (f32x4){0.f, 0.f, 0.f, 0.f};
                    f32x4 v0 = __builtin_elementwise_max(acc[ai][bj][m][0] * r + s0[bj], z), v1 = __builtin_elementwise_max(acc[ai][bj][m][1] * r + s1[bj], z); v0 = v0 * v0; v1 = v1 * v1;
                    u32x4 w; w.x = cvt_pk_bf16(v0[0], v0[1]); w.y = cvt_pk_bf16(v0[2], v0[3]); w.z = cvt_pk_bf16(v1[0], v1[1]); w.w = cvt_pk_bf16(v1[2], v1[3]);
                    __builtin_nontemporal_store(w, (u32x4*)(rowp + bj * HALF)); } }
    }
};
template <bool FP8OUT> struct EpiRes2 {
    static constexpr bool PERM = false, AFTER_DRAIN = false, HAS_MID = false;
    const float* xp; const float* xs; const float* xb; float* out; const float* modg; int row_off;
    const float* lnw; const float* modsc; bf16_t* XA; float* ssq;
    __device__ __forceinline__ void operator()(const f32x4 (&acc)[2][2][4][2], const Unit& u, int wr, int wc, int fr, int fq) const {
        const int rowg = row_off + u.pm * BM;
        const int b = rowg < 32768 ? (rowg >> 11) : 16 + ((rowg - 32768) >> 12);
        const float* gvec = modg + (size_t)b * (6 * 2048); const float* scv = modsc + (size_t)b * (6 * 2048);
        const float* base = xp ? (rowg < 32768 ? xp + (size_t)rowg * 2048 : xs + (size_t)(rowg - 32768) * 2048) : xb + (size_t)rowg * 2048;
        float* op = out + (size_t)rowg * 2048; bf16_t* xa = FP8OUT ? (bf16_t*)((unsigned char*)XA + (size_t)(u.pm * BM) * 2048) : XA + (size_t)(u.pm * BM) * 2048;
        const int r0 = wr * 64 + fr, col0 = u.pn * BM + wc * 32 + 4 * fq;
        const unsigned rb = (unsigned)(r0 * 2048 + col0);
        float ss[2][4];
#pragma unroll
        for (int ai = 0; ai < 2; ++ai)
#pragma unroll
            for (int m = 0; m < 4; ++m) ss[ai][m] = 0.f;
#pragma unroll
        for (int bn = 0; bn < 4; ++bn) { const int bj = bn >> 1, n = bn & 1, c = col0 + bj * HALF + n * 16;
            const f32x4 gvv = *(const f32x4*)(gvec + c), avv = *(const f32x4*)(lnw + c) * (*(const f32x4*)(scv + c) + 1.0f);
            f32x4 bs[2][4];
#pragma unroll
            for (int ai = 0; ai < 2; ++ai)
#pragma unroll
                for (int m = 0; m < 4; ++m) bs[ai][m] = *(const f32x4*)(base + (rb + (unsigned)((ai * HALF + m * 16) * 2048 + bj * HALF + n * 16)));
            asm volatile("" ::: "memory");
#pragma unroll
            for (int ai = 0; ai < 2; ++ai)
#pragma unroll
                for (int m = 0; m < 4; ++m) { const unsigned ro = rb + (unsigned)((ai * HALF + m * 16) * 2048 + bj * HALF + n * 16); const f32x4 xn = bs[ai][m] + gvv * acc[ai][bj][m][n];
                    *(f32x4*)(op + ro) = xn; ss[ai][m] += (xn[0] * xn[0] + xn[1] * xn[1]) + (xn[2] * xn[2] + xn[3] * xn[3]);
                    const f32x4 y = xn * avv;
                    if constexpr (FP8OUT) { int w8 = 0; w8 = __builtin_amdgcn_cvt_pk_fp8_f32(y[0], y[1], w8, false); w8 = __builtin_amdgcn_cvt_pk_fp8_f32(y[2], y[3], w8, true); *(int*)((unsigned char*)xa + ro) = w8; }
                    else { typedef unsigned u32x2 __attribute__((ext_vector_type(2))); u32x2 w; w.x = cvt_pk_bf16(y[0], y[1]); w.y = cvt_pk_bf16(y[2], y[3]); *(u32x2*)(xa + ro) = w; } }
            asm volatile("" ::: "memory");
        }
#pragma unroll
        for (int ai = 0; ai < 2; ++ai)
#pragma unroll
            for (int m = 0; m < 4; ++m) { float t = ss[ai][m]; t += __shfl_xor(t, 16); t += __shfl_xor(t, 32);
                if (fq == 0) __hip_atomic_fetch_add(ssq + u.pm * BM + r0 + ai * HALF + m * 16, t, __ATOMIC_RELAXED, __HIP_MEMORY_SCOPE_AGENT); }
    }
};
template <int BASEK, int OUTK, int XAK, bool ACC64 = false> struct EpiResid {
    static constexpr bool PERM = true, AFTER_DRAIN = false, HAS_MID = false;
    const float* xp; const float* xs; bf16_t* xb; float* out; const float* modg; int row_off;
    const float* lnw; const float* modsc; void* XA; ssq_t* ssq; PG8_LAS float* part;
    __device__ __forceinline__ void operator()(const f32x4 (&acc)[2][2][4][2], const Unit& u, int wr, int wc, int fr, int fq) const {
        const int rowg = row_off + u.pm * BM;
        const int b = rowg < 32768 ? (rowg >> 11) : 16 + ((rowg - 32768) >> 12);
        const float* gvec = modg + (size_t)b * (6 * 2048); const float* scv = modsc + (size_t)b * (6 * 2048);
        const float* basef = rowg < 32768 ? xp + (size_t)rowg * 2048 : xs + (size_t)(rowg - 32768) * 2048;
        bf16_t* xbt = xb + (size_t)(u.pm * BM) * 2048; float* op = out + (size_t)rowg * 2048;
        const int r0 = wr * 64 + fr, col0 = u.pn * BM + wc * 32 + 8 * fq;
        const unsigned rb = (unsigned)(r0 * 2048 + col0);
        constexpr bool WIDE = (BASEK == 1 && XAK == 0);
        constexpr int NB = WIDE ? 2 : 4, RG = WIDE ? 8 : 4;
        float tsum[2][4];
#pragma unroll
        for (int hb = 0; hb < NB; ++hb) { const int bj = WIDE ? hb : (hb >> 1), ai0 = WIDE ? 0 : (hb & 1), c = col0 + bj * HALF;
            f32x4 g0 = *(const f32x4*)(gvec + c), g1 = *(const f32x4*)(gvec + c + 4);
            if (ACC64) { g0 = g0 * (1.0f / 64.0f); g1 = g1 * (1.0f / 64.0f); }
            f32x4 a0 = g0, a1 = g1;
            if (XAK) { a0 = *(const f32x4*)(lnw + c) * (*(const f32x4*)(scv + c) + 1.0f); a1 = *(const f32x4*)(lnw + c + 4) * (*(const f32x4*)(scv + c + 4) + 1.0f); }
            u32x4 bw[RG]; f32x4 bf0[RG], bf1[RG];
#pragma unroll
            for (int q = 0; q < RG; ++q) { const int ai = ai0 + (q >> 2), m = q & 3; const unsigned ro = rb + (unsigned)((ai * HALF + m * 16) * 2048 + bj * HALF);
                if (BASEK == 1) bw[q] = *(const u32x4*)(xbt + ro); else { bf0[q] = *(const f32x4*)(basef + ro); bf1[q] = *(const f32x4*)(basef + ro + 4); } }
            asm volatile("" ::: "memory");
#pragma unroll
            for (int q = 0; q < RG; ++q) { const int ai = ai0 + (q >> 2), m = q & 3; const unsigned ro = rb + (unsigned)((ai * HALF + m * 16) * 2048 + bj * HALF);
                f32x4 x0, x1;
                if (BASEK == 1) { const u32x4 w = bw[q]; x0 = (f32x4){bf_lo(w.x), bf_hi(w.x), bf_lo(w.y), bf_hi(w.y)}; x1 = (f32x4){bf_lo(w.z), bf_hi(w.z), bf_lo(w.w), bf_hi(w.w)}; }
                else { x0 = bf0[q]; x1 = bf1[q]; }
                x0 += g0 * acc[ai][bj][m][0]; x1 += g1 * acc[ai][bj][m][1];
                if (OUTK == 1) { u32x4 w; w.x = cvt_pk_bf16(x0[0], x0[1]); w.y = cvt_pk_bf16(x0[2], x0[3]); w.z = cvt_pk_bf16(x1[0], x1[1]); w.w = cvt_pk_bf16(x1[2], x1[3]); *(u32x4*)(xbt + ro) = w; }
                else { *(f32x4*)(op + ro) = x0; *(f32x4*)(op + ro + 4) = x1; }
                if (XAK) { float t = ((x0[0] * x0[0] + x0[1] * x0[1]) + (x0[2] * x0[2] + x0[3] * x0[3])) + ((x1[0] * x1[0] + x1[1] * x1[1]) + (x1[2] * x1[2] + x1[3] * x1[3]));
                    const f32x4 y0 = x0 * a0, y1 = x1 * a1;
                    if (XAK == 1) { u32x4 w; w.x = cvt_pk_bf16(y0[0], y0[1]); w.y = cvt_pk_bf16(y0[2], y0[3]); w.z = cvt_pk_bf16(y1[0], y1[1]); w.w = cvt_pk_bf16(y1[2], y1[3]);
                        *(u32x4*)((bf16_t*)XA + (size_t)(u.pm * BM) * 2048 + ro) = w; }
                    else { int w0 = 0, w1 = 0; w0 = __builtin_amdgcn_cvt_pk_fp8_f32(y0[0], y0[1], w0, false); w0 = __builtin_amdgcn_cvt_pk_fp8_f32(y0[2], y0[3], w0, true);
                        w1 = __builtin_amdgcn_cvt_pk_fp8_f32(y1[0], y1[1], w1, false); w1 = __builtin_amdgcn_cvt_pk_fp8_f32(y1[2], y1[3], w1, true);
                        typedef int i32x2 __attribute__((ext_vector_type(2))); *(i32x2*)((unsigned char*)XA + (size_t)(u.pm * BM) * 4096 + ro + (ro & ~2047u)) = (i32x2){w0, w1}; }
                    if (bj == 0) tsum[ai][m] = t;
                    else { t += tsum[ai][m]; t += __shfl_xor(t, 16); t += __shfl_xor(t, 32);
                        if (fq == 0) part[(r0 + ai * HALF + m * 16) * 4 + wc] = t; } } }
            asm volatile("" ::: "memory");
        }
        if (XAK) {
            asm volatile("s_waitcnt lgkmcnt(0)" ::: "memory"); __builtin_amdgcn_s_barrier();
            const int t_ = (wr * 4 + wc) * 64 + fq * 16 + fr;
            if (t_ < 256) { const f32x4 v = *(const PG8_LAS f32x4*)(part + t_ * 4);
                __hip_atomic_fetch_add(ssq + u.pm * BM + t_, ssq_fix((v[0] + v[1]) + (v[2] + v[3])), __ATOMIC_RELAXED, __HIP_MEMORY_SCOPE_AGENT); }
        }
    }
};
}

#ifndef G23_FP8
#define G23_FP8 1
#endif
#ifndef G5_FP8
#define G5_FP8 0
#endif
#ifndef G4_FP8
#define G4_FP8 1
#endif
#ifndef MK_MULTI
#define MK_MULTI 0
#endif
#ifndef PG8_SP2
#define PG8_SP2 true
#endif
#ifndef PG8_ALIGN
#define PG8_ALIGN true
#endif

constexpr int NWAVES = 8;
constexpr int D = 2048, TTOK = 49152, TP = 32768, NSEQ = 20, INC = 8704, DFF = 8192, HD = 128;
constexpr int TC = 24576, NCH = 2, NLAYER = 2;
constexpr float RMS_EPS = 1e-6f, ATT_SCALE = 0.08838834764831845f, LOG2E = 1.4426950408889634f;
constexpr int ZC_QA = 0, ZC_KA = 1024, ZC_VA = 1280, ZC_QB = 1536, ZC_KB = 2560, ZC_VB = 3584, ZC_GA = 4608, ZC_GB = 6656;
static_assert(TTOK == NCH * TC && TC % 256 == 0 && TP % 256 == 0, "chunks");
enum { I_XP = 0, I_XS, I_CP, I_CS, I_WADA, I_BADA, I_LN1, I_LN2, I_WIN, I_QNA, I_KNA, I_QNB, I_KNB, I_SINK, I_RPB, I_WBRA, I_WBRB, I_WOUT, I_W1, I_W2, N_IN };

constexpr size_t MiB = 1u << 20;
constexpr size_t WS_CTL = 0, CTL_ZERO_BYTES = 1 * MiB;
constexpr size_t WS_MOD = 1 * MiB;
constexpr size_t WS_TBLA = 3 * MiB, WS_TBLB = 4 * MiB;
constexpr size_t WS_W = 8 * MiB, W_LAYER = 114 * MiB;
constexpr size_t WO_IN = 0, WO_BR = 34 * MiB, WO_OUT = 42 * MiB, WO_1 = 50 * MiB, WO_2 = 82 * MiB;
constexpr size_t WS_H = WS_W + 2 * W_LAYER;
constexpr size_t WS_Z = WS_H + 96 * MiB;
constexpr size_t WS_O = WS_Z + 408 * MiB;
constexpr size_t WS_MB = WS_O + 48 * MiB;
constexpr size_t WS_SHW = WS_MB + 48 * MiB;
constexpr size_t WS_SSQ = WS_SHW + 3 * MiB;
constexpr size_t WS_XB = WS_SSQ + 2 * MiB;
constexpr size_t WS_END = WS_XB + 96 * MiB;
static_assert(G23_FP8 && G4_FP8, "the 48 MiB O / m buffers assume fp8 attention outputs and fp8 m");
static_assert((size_t)INC * 2048 * 2 == 34 * MiB && (size_t)TC * INC * 2 == 408 * MiB && (size_t)TC * D * 2 == 96 * MiB, "sizes");
constexpr int CW_TMO = 0, CW_BAR = 4096;
constexpr float WIN_SCALE = 64.0f;

constexpr int RING_OFF = 0, RING_BYTES = 133120;
constexpr int LDSCTL_OFF = RING_BYTES, MISC_OFF = LDSCTL_OFF + 320;
constexpr int LDS_BYTES = 149504;
constexpr int PART_OFF = 135168;
constexpr int PFB_OFF = PART_OFF + 8192;
static_assert(MISC_OFF + 128 <= PART_OFF && PFB_OFF + 2 * pg8::PFB_PAR <= LDS_BYTES, "LDS map");

#define GAS __attribute__((address_space(1)))
#define LAS __attribute__((address_space(3)))
typedef unsigned short bf16;
typedef unsigned v4u __attribute__((ext_vector_type(4)));
typedef unsigned v2u __attribute__((ext_vector_type(2)));
typedef float f32x4 __attribute__((ext_vector_type(4)));
typedef GAS unsigned gu32;
#define RLX_AGENT __ATOMIC_RELAXED, __HIP_MEMORY_SCOPE_AGENT
#define LDS_WAIT() asm volatile("s_waitcnt lgkmcnt(0)" ::: "memory")
#define VM_WAIT() asm volatile("s_waitcnt vmcnt(0)" ::: "memory")
__device__ __forceinline__ unsigned f2bf(float f) { unsigned u = __builtin_bit_cast(unsigned, f); return (u + 0x7fffu + ((u >> 16) & 1u)) >> 16; }
__device__ __forceinline__ unsigned pk2(float lo, float hi) { return f2bf(lo) | (f2bf(hi) << 16); }
__device__ __forceinline__ float bflo(unsigned w) { return __uint_as_float(w << 16); }
__device__ __forceinline__ float bfhi(unsigned w) { return __uint_as_float(w & 0xffff0000u); }
__device__ __forceinline__ float wave_sum(float v) {
#pragma unroll
    for (int o = 1; o < 64; o <<= 1) v += __shfl_xor(v, o);
    return v;
}
__device__ __forceinline__ int seq_of(int row) { return row < TP ? (row >> 11) : 16 + ((row - TP) >> 12); }

#define XB_TMO      128
#define XB_XCNT(j)  (256  + 64 * (j))
#define XB_XSUB(j)  (1280 + 64 * (j))
#define XB_XGEN(j)  (2304 + 64 * (j))
#define XB_TOP      3328
#define XB_TOPGEN   3392
#define XCD_BAR_WORDS 3456
#define GB_CNT(g)   (4096 + 64 * (g))
#define GB_GEN(g)   (5120 + 64 * (g))
#define GP_CNT(g, x) (8192  + 64 * ((g) * 16 + (x)))
#define GP_SUB(g, x) (16384 + 64 * ((g) * 16 + (x)))
#define XB_SPIN_CAP (1u << 18)

__device__ __forceinline__ unsigned xb_ld(unsigned* p)              { return __hip_atomic_load(p, __ATOMIC_RELAXED, __HIP_MEMORY_SCOPE_AGENT); }
__device__ __forceinline__ unsigned xb_add(unsigned* p, unsigned v) { return __hip_atomic_fetch_add(p, v, __ATOMIC_RELAXED, __HIP_MEMORY_SCOPE_AGENT); }
__device__ __forceinline__ unsigned xb_xcc_id() { return (unsigned)__builtin_amdgcn_s_getreg((3 << 11) | 20) & 0xFu; }
#define XB_SPIN(cond, bar) do { unsigned _sp = 0; while (cond) { __builtin_amdgcn_s_sleep(1); \
    if ((++_sp & 255u) == 0u) { if (xb_ld(&(bar)[XB_TMO])) break; if (_sp > XB_SPIN_CAP) { atomicAdd(&(bar)[XB_TMO], 1u); break; } } } } while (0)

struct XcdBarrier {
    unsigned* bar; unsigned x;
    volatile LAS unsigned* st;
};

__device__ __forceinline__ XcdBarrier xcd_barrier_post(unsigned* bar, volatile LAS unsigned* st) {
    XcdBarrier b; b.bar = bar; b.x = xb_xcc_id(); b.st = st;
    if (threadIdx.x == 0) { (void)xb_add(&bar[XB_XCNT(b.x)], 1u); (void)xb_add(&bar[GP_CNT(blockIdx.x & 7u, b.x)], 1u); }
    return b;
}
__device__ __forceinline__ void xcd_barrier_complete(unsigned* bar, unsigned x, unsigned& nloc, unsigned& nx) {
    const unsigned G = gridDim.x * gridDim.y * gridDim.z;
    unsigned sum, cnt, mine, sp = 0u;
    for (;;) {
        sum = 0u; cnt = 0u; mine = 0u;
#pragma unroll
        for (unsigned j = 0; j < 16; ++j) { const unsigned c = xb_ld(&bar[XB_XCNT(j)]); sum += c; cnt += (c > 0u) ? 1u : 0u; mine = (j == x) ? c : mine; }
        if (sum == G) break;
        __builtin_amdgcn_s_sleep(1);
        if ((++sp & 255u) == 0u) { if (xb_ld(&bar[XB_TMO])) break; if (sp > XB_SPIN_CAP) { atomicAdd(&bar[XB_TMO], 1u); break; } }
    }
    nloc = mine > 0u ? mine : 1u; nx = cnt > 0u ? cnt : 1u;
}

__device__ __forceinline__ void xcd_barrier(const XcdBarrier& b) {
    asm volatile("s_waitcnt vmcnt(0)" ::: "memory");
    __syncthreads();
    if (threadIdx.x == 0) {
        unsigned* bar = b.bar;
        __builtin_amdgcn_s_waitcnt(0);
        unsigned nloc = b.st[0], nx = b.st[1];
        if (nloc == 0u) { xcd_barrier_complete(bar, b.x, nloc, nx); b.st[0] = nloc; b.st[1] = nx; }
        const unsigned old = xb_add(&bar[XB_XSUB(b.x)], 1u);
        const unsigned gen = old / nloc;
        if (old + 1u == (gen + 1u) * nloc) {
            __builtin_amdgcn_fence(__ATOMIC_RELEASE, "agent");
            asm volatile("s_waitcnt vmcnt(0)" ::: "memory");
            const unsigned og = xb_add(&bar[XB_TOP], 1u);
            const unsigned tg = og / nx;
            if (og + 1u == (tg + 1u) * nx) xb_add(&bar[XB_TOPGEN], 1u);
            else XB_SPIN(xb_ld(&bar[XB_TOPGEN]) == tg, bar);
            __builtin_amdgcn_fence(__ATOMIC_ACQUIRE, "agent");
            xb_add(&bar[XB_XGEN(b.x)], 1u);
            asm volatile("s_waitcnt vmcnt(0)" ::: "memory");
        } else {
            XB_SPIN(xb_ld(&bar[XB_XGEN(b.x)]) == gen, bar);
            __builtin_amdgcn_fence(__ATOMIC_ACQUIRE, "agent");
            asm volatile("s_waitcnt vmcnt(0)" ::: "memory");
        }
    }
    __syncthreads();
}

__device__ __forceinline__ void grp_barrier(const XcdBarrier& b, const unsigned g, const bool nb = false, const unsigned lag = 0u) {
    asm volatile("s_waitcnt vmcnt(0)" ::: "memory");
    __syncthreads();
    if (threadIdx.x == 0) {
        unsigned* bar = b.bar;
        __builtin_amdgcn_s_waitcnt(0);
        unsigned nloc = b.st[2], npair = b.st[3];
        if (nloc == 0u) { npair = 0u;
#pragma unroll
            for (unsigned j = 0; j < 16; ++j) { const unsigned c = xb_ld(&bar[GP_CNT(g, j)]); npair += (c > 0u) ? 1u : 0u; nloc = (j == b.x) ? c : nloc; }
            nloc = nloc > 0u ? nloc : 1u; npair = npair > 0u ? npair : 1u; b.st[2] = nloc; b.st[3] = npair; }
        const unsigned old = xb_add(&bar[GP_SUB(g, b.x)], 1u);
        const unsigned gen = old / nloc;
        if (old + 1u == (gen + 1u) * nloc) {
            __builtin_amdgcn_fence(__ATOMIC_RELEASE, "agent");
            asm volatile("s_waitcnt vmcnt(0)" ::: "memory");
            if (npair == 1u) xb_add(&bar[GB_GEN(g)], 1u);
            else { const unsigned og = xb_add(&bar[GB_CNT(g)], 1u);
                if (og + 1u == (gen + 1u) * npair) xb_add(&bar[GB_GEN(g)], 1u); }
        }
        XB_SPIN(xb_ld(&bar[GB_GEN(g)]) == gen, bar);
        if (nb) { if (g > 0u) XB_SPIN((int)(xb_ld(&bar[GB_GEN(g - 1u)]) - (gen + 1u - lag)) < 0, bar);
                  if (g < 7u) XB_SPIN((int)(xb_ld(&bar[GB_GEN(g + 1u)]) - (gen + 1u - lag)) < 0, bar); }
        __builtin_amdgcn_fence(__ATOMIC_ACQUIRE, "agent");
        asm volatile("s_waitcnt vmcnt(0)" ::: "memory");
    }
    __syncthreads();
}


struct Args { const float* in[N_IN]; float* out; unsigned char* ws; };
struct Frame {
    LAS unsigned char* lds;
    int tid, lane, wave, G, gw, ngw;
    const __attribute__((address_space(4))) Args* ap;
    __device__ __forceinline__ const __attribute__((address_space(4))) Args* args() const { const __attribute__((address_space(4))) Args* p = ap; asm volatile("" : "+s"(p)); return p; }
    __device__ __forceinline__ const float* in(int i) const { return args()->in[i]; }
    __device__ __forceinline__ float* out() const { return args()->out; }
    __device__ __forceinline__ unsigned char* ws() const { return args()->ws; }
    __device__ __forceinline__ float* mod() const { return (float*)(ws() + WS_MOD); }
    __device__ __forceinline__ float* shwin() const { return (float*)(ws() + WS_SHW); }
    __device__ __forceinline__ float* shw1() const { return (float*)(ws() + WS_SHW) + (size_t)NLAYER * NSEQ * INC; }
    __device__ __forceinline__ pg8::ssq_t* ssq() const { return (pg8::ssq_t*)(ws() + WS_SSQ); }
};

static_assert(ZC_GA == 4608 && ZC_GB == 6656 && INC == 8704, "EpiZ's gate branch and win_src_col assume this column layout of z");
__device__ __forceinline__ int win_src_col(const int np) { if (np < ZC_GA) return np; const int t = (np - ZC_GA) >> 7, o = (np - ZC_GA) & 127; return ZC_GA + (t & 1) * 2048 + (t >> 1) * 128 + o; }
__device__ __forceinline__ void transpose_item(const float* W, int N, bf16* WT, int ldT, int koff, LAS float* scr, int item, int lane) {
    const int nblk = N / 32, kb = item / nblk, nb = item - kb * nblk, k0 = 64 * kb, n0 = 32 * nb;
    float tv[32];
#pragma unroll
    for (int i = 0; i < 32; ++i) tv[i] = W[(size_t)(k0 + 2 * i + (lane >> 5)) * N + n0 + (lane & 31)];
#pragma unroll
    for (int i = 0; i < 32; ++i) scr[(2 * i + (lane >> 5)) * 33 + (lane & 31)] = tv[i];
    LDS_WAIT(); asm volatile("" ::: "memory");
    const int c = lane & 7;
#pragma unroll
    for (int j = 0; j < 4; ++j) { const int n = (lane >> 3) + 8 * j; const LAS float* s = scr + (8 * c) * 33 + n;
        v4u o; o.x = pk2(s[0 * 33], s[1 * 33]); o.y = pk2(s[2 * 33], s[3 * 33]); o.z = pk2(s[4 * 33], s[5 * 33]); o.w = pk2(s[6 * 33], s[7 * 33]);
        *(GAS v4u*)(WT + (size_t)(n0 + n) * ldT + koff + k0 + 8 * c) = o; }
    LDS_WAIT(); asm volatile("" ::: "memory");
}

__device__ __forceinline__ unsigned pk4_fp8(float a, float b, float c, float d) { int w = 0; w = __builtin_amdgcn_cvt_pk_fp8_f32(a, b, w, false); w = __builtin_amdgcn_cvt_pk_fp8_f32(c, d, w, true); return (unsigned)w; }
template <bool WINPERM = false> __device__ __forceinline__ void transpose_item_fp8(const float* W, int N, unsigned char* WT, int ldT, float scale, LAS float* scr, int item, int lane) {
    const int nblk = N / 32, kb = item / nblk, nb = item - kb * nblk, k0 = 64 * kb, n0 = 32 * nb, ns = WINPERM ? win_src_col(n0) : n0;
    float tv[32];
#pragma unroll
    for (int i = 0; i < 32; ++i) tv[i] = W[(size_t)(k0 + 2 * i + (lane >> 5)) * N + ns + (lane & 31)];
#pragma unroll
    for (int i = 0; i < 32; ++i) scr[(2 * i + (lane >> 5)) * 33 + (lane & 31)] = tv[i];
    LDS_WAIT(); asm volatile("" ::: "memory");
    const int c = lane & 7;
#pragma unroll
    for (int j = 0; j < 4; ++j) { const int n = (lane >> 3) + 8 * j; const LAS float* s = scr + (8 * c) * 33 + n;
        v2u o; o.x = pk4_fp8(s[0 * 33] * scale, s[1 * 33] * scale, s[2 * 33] * scale, s[3 * 33] * scale); o.y = pk4_fp8(s[4 * 33] * scale, s[5 * 33] * scale, s[6 * 33] * scale, s[7 * 33] * scale);
        *(GAS v2u*)(WT + (size_t)(n0 + n) * ldT + k0 + 8 * c) = o; }
    LDS_WAIT(); asm volatile("" ::: "memory");
}
__device__ __forceinline__ void p0_weights(Frame& F) {
    LAS float* scr = (LAS float*)(F.lds + RING_OFF + F.wave * 16384);
    constexpr int I_IN = (D / 64) * (INC / 32), I_BR = (1024 / 64) * (D / 32), I_OUT = (D / 64) * (D / 32), I_1 = (D / 64) * (DFF / 32), I_2 = (DFF / 64) * (D / 32);
    constexpr int PER_LAYER = I_IN + 2 * I_BR + I_OUT + I_1 + I_2;
    for (int it = F.gw; it < NLAYER * PER_LAYER; it += F.ngw) {
        const int l = it / PER_LAYER; int r = it - l * PER_LAYER;
        unsigned char* wl = F.ws() + WS_W + (size_t)l * W_LAYER;
        if (r < I_IN) { transpose_item_fp8<true>(F.in(I_WIN) + (size_t)l * D * INC, INC, wl + WO_IN, D, WIN_SCALE, scr, r, F.lane); continue; } r -= I_IN;
#if G23_FP8
        if (r < I_BR) { transpose_item_fp8(F.in(I_WBRA) + (size_t)l * 1024 * D, D, wl + WO_BR, 2048, WIN_SCALE, scr, r, F.lane); continue; } r -= I_BR;
        if (r < I_BR) { transpose_item_fp8(F.in(I_WBRB) + (size_t)l * 1024 * D, D, wl + WO_BR + 1024, 2048, WIN_SCALE, scr, r, F.lane); continue; } r -= I_BR;
#else
        if (r < I_BR) { transpose_item(F.in(I_WBRA) + (size_t)l * 1024 * D, D, (bf16*)(wl + WO_BR), 2048, 0, scr, r, F.lane); continue; } r -= I_BR;
        if (r < I_BR) { transpose_item(F.in(I_WBRB) + (size_t)l * 1024 * D, D, (bf16*)(wl + WO_BR), 2048, 1024, scr, r, F.lane); continue; } r -= I_BR;
#endif
#if G4_FP8
        if (r < I_OUT) { transpose_item_fp8(F.in(I_WOUT) + (size_t)l * D * D, D, wl + WO_OUT, D, WIN_SCALE, scr, r, F.lane); continue; } r -= I_OUT;
#else
        if (r < I_OUT) { transpose_item(F.in(I_WOUT) + (size_t)l * D * D, D, (bf16*)(wl + WO_OUT), D, 0, scr, r, F.lane); continue; } r -= I_OUT;
#endif
#if G5_FP8
        if (r < I_1) { transpose_item_fp8(F.in(I_W1) + (size_t)l * D * DFF, DFF, wl + WO_1, D, WIN_SCALE, scr, r, F.lane); continue; } r -= I_1;
#else
        if (r < I_1) { transpose_item(F.in(I_W1) + (size_t)l * D * DFF, DFF, (bf16*)(wl + WO_1), D, 0, scr, r, F.lane); continue; } r -= I_1;
#endif
        transpose_item(F.in(I_W2) + (size_t)l * DFF * D, D, (bf16*)(wl + WO_2), DFF, 0, scr, r, F.lane);
    }
}

template <bool SILU, bool WINPERM = false> __device__ __forceinline__ void gemv20_task(Frame& F, const float* W, const int ldw, const int n0, const float* vA, const int vsA, const float* vB, const int vsB,
                                                                 float* out, const int ldo, const float* bias) {
    LAS float* scr = (LAS float*)(F.lds + RING_OFF + F.wave * 2048);
    LAS f32x4* red = (LAS f32x4*)(F.lds + RING_OFF + 16384);
    const float* Wc = W + (WINPERM ? win_src_col(n0 + 4 * F.lane) : n0 + 4 * F.lane);
    f32x4 acc[NSEQ];
#pragma unroll
    for (int b = 0; b < NSEQ; ++b) acc[b] = (f32x4){0.f, 0.f, 0.f, 0.f};
    for (int kc = 0; kc < 16; ++kc) {
        const int k0 = F.wave * 256 + kc * 16;
        if (F.lane < 16) {
#pragma unroll
            for (int b = 0; b < NSEQ; ++b) { const float cv = (b < 16) ? vA[(size_t)b * vsA + k0 + F.lane] : vB[(size_t)(b - 16) * vsB + k0 + F.lane];
                scr[F.lane * NSEQ + b] = SILU ? cv / (1.0f + __expf(-cv)) : cv; }
        }
        f32x4 w[16];
#pragma unroll
        for (int kk = 0; kk < 16; ++kk) w[kk] = *(const f32x4*)(Wc + (size_t)(k0 + kk) * ldw);
        LDS_WAIT(); asm volatile("" ::: "memory");
#pragma unroll
        for (int kk = 0; kk < 16; ++kk) {
#pragma unroll
            for (int b = 0; b < NSEQ; ++b) acc[b] += w[kk] * scr[kk * NSEQ + b]; }
        LDS_WAIT(); asm volatile("" ::: "memory");
    }
#pragma unroll
    for (int hb = 0; hb < 2; ++hb) {
#pragma unroll
        for (int b = 0; b < 10; ++b) red[(F.wave * 10 + b) * 64 + F.lane] = acc[hb * 10 + b];
        __syncthreads();
        for (int idx = F.tid; idx < 10 * 64; idx += NWAVES * 64) { const int b = idx >> 6, ln = idx & 63; f32x4 sum = (f32x4){0.f, 0.f, 0.f, 0.f};
#pragma unroll
            for (int w8 = 0; w8 < NWAVES; ++w8) sum += red[(w8 * 10 + b) * 64 + ln];
            if (bias) sum += *(const f32x4*)(bias + n0 + 4 * ln);
            *(f32x4*)(out + (size_t)(hb * 10 + b) * ldo + n0 + 4 * ln) = sum; }
        __syncthreads();
    }
}
__device__ __forceinline__ void p0_mod(Frame& F) {
    for (int task = blockIdx.x; task < NLAYER * 48; task += F.G) { const int l = task / 48, n0 = (task - l * 48) * 256;
        gemv20_task<true>(F, F.in(I_WADA) + (size_t)l * D * 12288, 12288, n0, F.in(I_CP), D, F.in(I_CS), D, F.mod() + (size_t)l * NSEQ * 12288, 12288, F.in(I_BADA) + l * 12288); }
}
__device__ __forceinline__ void p0_shw(Frame& F) {
    constexpr int T_IN = INC / 256, T_1 = DFF / 256;
    for (int task = blockIdx.x; task < NLAYER * (T_IN + T_1); task += F.G) { const int l = task / (T_IN + T_1), r = task - l * (T_IN + T_1);
        const float* m0 = F.mod() + (size_t)l * NSEQ * 12288;
        if (r < T_IN) gemv20_task<false, true>(F, F.in(I_WIN) + (size_t)l * D * INC, INC, r * 256, m0, 12288, m0 + 16 * 12288, 12288, F.shwin() + (size_t)l * NSEQ * INC, INC, nullptr);
        else gemv20_task<false>(F, F.in(I_W1) + (size_t)l * D * DFF, DFF, (r - T_IN) * 256, m0 + 3 * D, 12288, m0 + 16 * 12288 + 3 * D, 12288, F.shw1() + (size_t)l * NSEQ * DFF, DFF, nullptr); }
}
__device__ __forceinline__ void norm0_phase(Frame& F, const int c0, pg8::ssq_t* ssq) {
    int lane = F.lane; asm volatile("" : "+v"(lane));
    bf16* H = (bf16*)(F.ws() + WS_H);
    const float* lnw = F.in(I_LN1);
    const bool grp = (F.G & 7) == 0; const int ng = F.G >> 3;
    const int t_beg = grp ? ((int)blockIdx.x & 7) * (TC / 8) + ((int)blockIdx.x >> 3) * NWAVES + F.wave : F.gw, t_end = grp ? (((int)blockIdx.x & 7) + 1) * (TC / 8) : TC, t_inc = grp ? ng * NWAVES : F.ngw;
    auto xrow_of = [&](const int tl) -> const GAS f32x4* { const int row = c0 + tl; const float* xrow = row < TP ? F.in(I_XP) + (size_t)row * D : F.in(I_XS) + (size_t)(row - TP) * D; return (const GAS f32x4*)xrow + lane; };
    f32x4 v[8], nv[8];
    if (t_beg < t_end) { const GAS f32x4* xr = xrow_of(t_beg);
#pragma unroll
        for (int j = 0; j < 8; ++j) v[j] = xr[64 * j]; }
    for (int tl = t_beg; tl < t_end; tl += t_inc) {
        const int row = c0 + tl, b = seq_of(row);
        const float* sc = F.mod() + ((size_t)b * 6 + 1) * D;
        if (tl + t_inc < t_end) { const GAS f32x4* xn = xrow_of(tl + t_inc);
#pragma unroll
            for (int j = 0; j < 8; ++j) nv[j] = xn[64 * j]; }
        asm volatile("" ::: "memory");
        float ss = 0.f;
#pragma unroll
        for (int j = 0; j < 8; ++j) ss += (v[j].x * v[j].x + v[j].y * v[j].y) + (v[j].z * v[j].z + v[j].w * v[j].w);
        ss = wave_sum(ss);
        if (lane == 0) ssq[tl] = pg8::ssq_fix(ss);
        GAS unsigned* o4 = (GAS unsigned*)((unsigned char*)H + (size_t)tl * (2 * D)) + lane;
#pragma unroll
        for (int j = 0; j < 8; ++j) { const int col = 4 * lane + 256 * j;
            const f32x4 y = v[j] * (*(const f32x4*)(lnw + col)) * (*(const f32x4*)(sc + col) + 1.0f);
            o4[64 * j] = pk4_fp8(y.x, y.y, y.z, y.w); }
        asm volatile("" ::: "memory");
#pragma unroll
        for (int j = 0; j < 8; ++j) v[j] = nv[j];
    }
}

namespace att {
typedef short bf16x8 __attribute__((ext_vector_type(8)));
typedef short s16x4 __attribute__((ext_vector_type(4)));
typedef float f32x16 __attribute__((ext_vector_type(16)));
typedef float f32x4 __attribute__((ext_vector_type(4)));
typedef unsigned u32x4 __attribute__((ext_vector_type(4)));
constexpr int SHM_V = 64 * 128 * 2, SHM_K = 64 * 128 * 2;
constexpr int OFF_V = 0, OFF_K = 2 * SHM_V, OFF_WS = 2 * SHM_V + 2 * SHM_K, ATT_LDS = OFF_WS + 8 * 64 * 4;
constexpr float THR_L2 = 11.5f;
#define ATT_KSWZ(row, colB) ((row) * 256 + ((colB) ^ (((row) & 7) << 4)))
#define ATT_SBAR() __builtin_amdgcn_sched_barrier(0)
__device__ __forceinline__ int crow(int r, int hi) { return (r & 3) + 8 * (r >> 2) + 4 * hi; }
__device__ __forceinline__ unsigned cvtpk(float lo, float hi) { unsigned r; asm volatile("v_cvt_pk_bf16_f32 %0, %1, %2" : "=v"(r) : "v"(lo), "v"(hi)); return r; }
__device__ __forceinline__ void qkt(f32x16& p0, f32x16& p1, const LAS unsigned char* Ks, const bf16x8 (&qr)[8], int r32, int hi) {
#pragma unroll
    for (int d0 = 0; d0 < 8; ++d0) { const int cb = (d0 * 16 + hi * 8) * 2;
        const bf16x8 b0 = *(const LAS bf16x8*)(Ks + ATT_KSWZ(r32, cb));
        const bf16x8 b1 = *(const LAS bf16x8*)(Ks + ATT_KSWZ(32 + r32, cb));
        p0 = __builtin_amdgcn_mfma_f32_32x32x16_bf16(b0, qr[d0], p0, 0, 0, 0);
        p1 = __builtin_amdgcn_mfma_f32_32x32x16_bf16(b1, qr[d0], p1, 0, 0, 0); }
}
__device__ __forceinline__ int v_st(int k, int c) { const int kk = (k & ~0xC) | ((k & 4) << 1) | ((k & 8) >> 1); return ((kk >> 3) * 4 + (c >> 5)) * 512 + ((kk & 7) * 32 + (c & 31)) * 2; }
__device__ __forceinline__ int v_rd_base(int lane) { return ((lane & 3) << 3) | (((lane >> 2) & 3) << 6) | (((lane >> 4) & 1) << 5) | (((lane >> 5) & 1) << 8); }
constexpr int v_rd_off(int d0, int ks, int half) { return d0 * 512 + ks * 4096 + half * 2048; }
template <int OFF> __device__ __forceinline__ s16x4 tr_read(int vb) { s16x4 r; asm volatile("ds_read_b64_tr_b16 %0, %1 offset:%2" : "=&v"(r) : "v"(vb), "i"(OFF) : "memory"); return r; }
template <int D0> __device__ __forceinline__ void pv_one(f32x16& od, int vb, bf16x8 pa0, bf16x8 pa1, bf16x8 pa2, bf16x8 pa3) {
    const s16x4 l0 = tr_read<v_rd_off(D0, 0, 0)>(vb), h0 = tr_read<v_rd_off(D0, 0, 1)>(vb), l1 = tr_read<v_rd_off(D0, 1, 0)>(vb), h1 = tr_read<v_rd_off(D0, 1, 1)>(vb);
    const s16x4 l2 = tr_read<v_rd_off(D0, 2, 0)>(vb), h2 = tr_read<v_rd_off(D0, 2, 1)>(vb), l3 = tr_read<v_rd_off(D0, 3, 0)>(vb), h3 = tr_read<v_rd_off(D0, 3, 1)>(vb);
    asm volatile("s_waitcnt lgkmcnt(0)" ::: "memory"); ATT_SBAR();
#define ATT_PK(L, H) (bf16x8){L[0], L[1], L[2], L[3], H[0], H[1], H[2], H[3]}
    od = __builtin_amdgcn_mfma_f32_32x32x16_bf16(pa0, ATT_PK(l0, h0), od, 0, 0, 0);
    od = __builtin_amdgcn_mfma_f32_32x32x16_bf16(pa1, ATT_PK(l1, h1), od, 0, 0, 0);
    od = __builtin_amdgcn_mfma_f32_32x32x16_bf16(pa2, ATT_PK(l2, h2), od, 0, 0, 0);
    od = __builtin_amdgcn_mfma_f32_32x32x16_bf16(pa3, ATT_PK(l3, h3), od, 0, 0, 0);
#undef ATT_PK
}
__device__ __forceinline__ void pv_d0(f32x16 (&o)[4], int vb, bf16x8 pa0, bf16x8 pa1, bf16x8 pa2, bf16x8 pa3) {
    pv_one<0>(o[0], vb, pa0, pa1, pa2, pa3); pv_one<1>(o[1], vb, pa0, pa1, pa2, pa3); pv_one<2>(o[2], vb, pa0, pa1, pa2, pa3); pv_one<3>(o[3], vb, pa0, pa1, pa2, pa3);
}
__device__ __forceinline__ float swap_max(float v) { auto rr = __builtin_amdgcn_permlane32_swap(__float_as_uint(v), __float_as_uint(v), false, false); return fmaxf(__uint_as_float(rr[0]), __uint_as_float(rr[1])); }
__device__ __forceinline__ float swap_add(float v) { auto rr = __builtin_amdgcn_permlane32_swap(__float_as_uint(v), __float_as_uint(v), false, false); return __uint_as_float(rr[0]) + __uint_as_float(rr[1]); }
__device__ __forceinline__ bf16x8 knorm8(bf16x8 raw, const float (&g)[8]) {
    const u32x4 w = __builtin_bit_cast(u32x4, raw);
    float f[8] = {__uint_as_float(w.x << 16), __uint_as_float(w.x & 0xffff0000u), __uint_as_float(w.y << 16), __uint_as_float(w.y & 0xffff0000u),
                  __uint_as_float(w.z << 16), __uint_as_float(w.z & 0xffff0000u), __uint_as_float(w.w << 16), __uint_as_float(w.w & 0xffff0000u)};
    float ss = 0.f;
#pragma unroll
    for (int i = 0; i < 8; ++i) ss = fmaf(f[i], f[i], ss);
    ss += __shfl_xor(ss, 1); ss += __shfl_xor(ss, 2); ss += __shfl_xor(ss, 4); ss += __shfl_xor(ss, 8);
    const float rs = rsqrtf(ss * (1.f / 128.f) + 1e-6f);
    u32x4 o; o.x = cvtpk(f[0] * rs * g[0], f[1] * rs * g[1]); o.y = cvtpk(f[2] * rs * g[2], f[3] * rs * g[3]); o.z = cvtpk(f[4] * rs * g[4], f[5] * rs * g[5]); o.w = cvtpk(f[6] * rs * g[6], f[7] * rs * g[7]);
    return __builtin_bit_cast(bf16x8, o);
}

constexpr int OFF_T = 2 * SHM_V + 2 * SHM_K, OFF_WS2 = OFF_T + 8 * 8192, ATT_LDS2 = OFF_WS2 + 8 * 256;
__device__ __forceinline__ void glds16(const void* g, LAS unsigned char* l) { __builtin_amdgcn_global_load_lds((const unsigned*)g, (LAS unsigned*)l, 16, 0, 0); }
template <int LDZ, int LDO, class TblFn>
__device__ __forceinline__ void attn_unit(const bf16* __restrict__ Zq, const bf16* __restrict__ Zk, const bf16* __restrict__ Zv, bf16* __restrict__ Ob, const int NT,
                                          const TblFn& tbl, const float sink_l2, LAS unsigned char* lds, const int tid_in) {
    int tid = tid_in; asm volatile("" : "+v"(tid));
    const int wid = __builtin_amdgcn_readfirstlane(tid >> 6), lane = tid & 63, r32 = lane & 31, hi = lane >> 5;
    LAS unsigned char* V_lds = lds + OFF_V; LAS unsigned char* K_lds = lds + OFF_K; LAS unsigned char* T_lds = lds + OFF_T + wid * 8192;
    LAS float* wsf = (LAS float*)(lds + OFF_WS2) + wid * 64; LAS float* li_l = wsf; LAS float* al_l = wsf + 32;
    const LAS float* li_h = li_l + 4 * hi; const LAS float* al_h = al_l + 4 * hi;
    constexpr float C = 0.08838834764831845f * 1.4426950408889634f;
    float m_reg = -1e30f, l_reg = 0.f; f32x16 o[4] = {}; bf16x8 qr[8];
    { const bf16* Qw = Zq + (size_t)r32 * LDZ + hi * 8;
#pragma unroll
      for (int d0 = 0; d0 < 8; ++d0) qr[d0] = *(const bf16x8*)(Qw + d0 * 16); }
    unsigned kof[2], vof[2];
#pragma unroll
    for (int i = 0; i < 2; ++i) { const int p = (wid * 2 + i) * 64 + lane;
        { const int row = p >> 4, ch = (p & 15) ^ (row & 7); kof[i] = (unsigned)(row * LDZ + ch * 8); }
        { const int sub = p >> 5, g = p & 31, kk = (sub >> 2) * 8 + (g >> 2), c = (sub & 3) * 32 + (g & 3) * 8, k = (kk & ~0xC) | ((kk & 4) << 1) | ((kk & 8) >> 1);
          vof[i] = (unsigned)(k * LDZ + c); } }
    const int vb0 = (int)(unsigned)(uintptr_t)V_lds + v_rd_base(lane);
#define ATT_STAGE(t, b) do { const bf16* _k = Zk + (size_t)(t) * 64 * LDZ; const bf16* _v = Zv + (size_t)(t) * 64 * LDZ; \
        glds16(_k + kof[0], K_lds + (b) * SHM_K + (wid * 2) * 1024); glds16(_k + kof[1], K_lds + (b) * SHM_K + (wid * 2 + 1) * 1024); \
        glds16(_v + vof[0], V_lds + (b) * SHM_V + (wid * 2) * 1024); glds16(_v + vof[1], V_lds + (b) * SHM_V + (wid * 2 + 1) * 1024); } while (0)
#define ATT_TSTAGE(tp_) do { _Pragma("unroll") for (int i = 0; i < 8; ++i) glds16((tp_) + (i * 64 + lane) * 4, T_lds + i * 1024); } while (0)
    const float* tp = tbl(0);
    ATT_STAGE(0, 0); if (tp != nullptr) ATT_TSTAGE(tp);
    asm volatile("s_waitcnt vmcnt(0)" ::: "memory"); __syncthreads();
    for (int j = 0; j < NT; ++j) {
        const int b = j & 1;
        if (j + 1 < NT) ATT_STAGE(j + 1, b ^ 1);
        const float* tpn = (j + 1 < NT) ? tbl(j + 1) : nullptr;
        if (tp != nullptr) {
            f32x16 p0, p1;
#pragma unroll
            for (int i = 0; i < 4; ++i) { const f32x4 a = *(const LAS f32x4*)(T_lds + (i * 64 + lane) * 16), c4 = *(const LAS f32x4*)(T_lds + ((4 + i) * 64 + lane) * 16);
                p0[4 * i + 0] = a.x; p0[4 * i + 1] = a.y; p0[4 * i + 2] = a.z; p0[4 * i + 3] = a.w; p1[4 * i + 0] = c4.x; p1[4 * i + 1] = c4.y; p1[4 * i + 2] = c4.z; p1[4 * i + 3] = c4.w; }
            asm volatile("s_waitcnt lgkmcnt(0)" ::: "memory");
            if (tpn != nullptr) ATT_TSTAGE(tpn);
            qkt(p0, p1, K_lds + b * SHM_K, qr, r32, hi);
            float pmax = p0[0];
#pragma unroll
            for (int r = 1; r < 16; ++r) pmax = fmaxf(pmax, p0[r]);
#pragma unroll
            for (int r = 0; r < 16; ++r) pmax = fmaxf(pmax, p1[r]);
            pmax = swap_max(pmax) * C;
            if (!__all(pmax - m_reg <= THR_L2)) {
                const float mn = fmaxf(m_reg, pmax), alpha = __builtin_amdgcn_exp2f(m_reg - mn); m_reg = mn; l_reg *= alpha;
                if (hi == 0) al_l[r32] = alpha;
                asm volatile("s_waitcnt lgkmcnt(0)" ::: "memory");
#pragma unroll
                for (int d = 0; d < 4; ++d)
#pragma unroll
                    for (int r = 0; r < 16; ++r) o[d][r] *= al_h[(r & 3) + 8 * (r >> 2)];
            }
            float ps = 0.f; const float nm = -m_reg;
#pragma unroll
            for (int r = 0; r < 16; ++r) { p0[r] = __builtin_amdgcn_exp2f(fmaf(p0[r], C, nm)); p1[r] = __builtin_amdgcn_exp2f(fmaf(p1[r], C, nm)); ps += p0[r] + p1[r]; }
            l_reg += swap_add(ps);
            bf16x8 pa0, pa1, pa2, pa3;
#define ATT_PK4(P, BASE, OUT) do { const unsigned a0 = cvtpk(P[BASE + 0], P[BASE + 1]), a1 = cvtpk(P[BASE + 2], P[BASE + 3]); \
            const unsigned b0 = cvtpk(P[BASE + 4], P[BASE + 5]), b1 = cvtpk(P[BASE + 6], P[BASE + 7]); \
            auto r0 = __builtin_amdgcn_permlane32_swap(a0, b0, false, false); auto r1 = __builtin_amdgcn_permlane32_swap(a1, b1, false, false); \
            u32x4 w = {r0[0], r1[0], r0[1], r1[1]}; OUT = __builtin_bit_cast(bf16x8, w); } while (0)
            ATT_PK4(p0, 0, pa0); ATT_PK4(p0, 8, pa1); ATT_PK4(p1, 0, pa2); ATT_PK4(p1, 8, pa3);
#undef ATT_PK4
            pv_d0(o, vb0 + b * SHM_V, pa0, pa1, pa2, pa3);
        } else if (tpn != nullptr) ATT_TSTAGE(tpn);
        tp = tpn;
        asm volatile("s_waitcnt vmcnt(0)" ::: "memory"); __syncthreads();
    }
#undef ATT_STAGE
#undef ATT_TSTAGE
    l_reg += __builtin_amdgcn_exp2f(sink_l2 - m_reg);
    if (hi == 0) li_l[r32] = l_reg;
    asm volatile("s_waitcnt lgkmcnt(0)" ::: "memory");
#if G23_FP8
    { LAS unsigned char* St = (LAS unsigned char*)T_lds + hi * (4 * 128) + r32;
#pragma unroll
      for (int r = 0; r < 16; ++r) { const float rl = __builtin_amdgcn_rcpf(li_h[(r & 3) + 8 * (r >> 2)]);
#pragma unroll
          for (int d0 = 0; d0 < 4; ++d0) { const float v = o[d0][r] * rl; St[((r & 3) + 8 * (r >> 2)) * 128 + d0 * 32] = (unsigned char)(__builtin_amdgcn_cvt_pk_fp8_f32(v, v, 0, false) & 0xff); } }
      asm volatile("s_waitcnt lgkmcnt(0)" ::: "memory");
      unsigned char* Ow = (unsigned char*)Ob + (size_t)(lane >> 3) * LDO + (lane & 7) * 16;
#pragma unroll
      for (int i = 0; i < 4; ++i) { const u32x4 w = *(const LAS u32x4*)(T_lds + i * 1024 + lane * 16); *(u32x4*)(Ow + (size_t)(i * 8) * LDO) = w; }
      asm volatile("s_waitcnt lgkmcnt(0)" ::: "memory"); }
#else
    { LAS unsigned short* St = (LAS unsigned short*)T_lds + hi * (4 * 128) + r32;
#pragma unroll
      for (int r = 0; r < 16; ++r) { const float rl = __builtin_amdgcn_rcpf(li_h[(r & 3) + 8 * (r >> 2)]);
#pragma unroll
          for (int d0 = 0; d0 < 4; ++d0) { const float v = o[d0][r] * rl; St[((r & 3) + 8 * (r >> 2)) * 128 + d0 * 32] = (unsigned short)(cvtpk(v, v) & 0xffffu); } }
      asm volatile("s_waitcnt lgkmcnt(0)" ::: "memory");
      bf16* Ow = Ob + (size_t)(lane >> 4) * LDO + (lane & 15) * 8;
#pragma unroll
      for (int i = 0; i < 8; ++i) { const u32x4 w = *(const LAS u32x4*)(T_lds + i * 1024 + lane * 16); *(u32x4*)(Ow + (size_t)(i * 4) * LDO) = w; }
      asm volatile("s_waitcnt lgkmcnt(0)" ::: "memory"); }
#endif
}

struct B2Tile { const float* tp; bool va, vb; };
template <int LDZ, int LDO, class InfoFn>
__device__ __forceinline__ void attn_unit_b2(const bf16* __restrict__ Zq, const bf16* __restrict__ Zk, const bf16* __restrict__ Zv, bf16* __restrict__ Ob, const int NT,
                                             const InfoFn& tinfo, LAS unsigned char* lds, const int tid_in) {
    int tid = tid_in; asm volatile("" : "+v"(tid));
    const int wid = __builtin_amdgcn_readfirstlane(tid >> 6), lane = tid & 63, r32 = lane & 31, hi = lane >> 5;
    const int rp = wid >> 2, cb = wid & 3, w0 = cb == 0 ? 0 : (cb == 1 ? 8 : (cb == 2 ? 24 : 32));
    const int qtok = (2 * rp + (r32 >> 4)) * 64 + 16 * cb + (r32 & 15);
    LAS unsigned char* V_lds = lds + OFF_V; LAS unsigned char* K_lds = lds + OFF_K; LAS unsigned char* T_lds = lds + OFF_T + wid * 8192;
    LAS float* wsf = (LAS float*)(lds + OFF_WS2) + wid * 64; LAS float* li_l = wsf; LAS float* al_l = wsf + 32;
    const LAS float* li_h = li_l + 4 * hi; const LAS float* al_h = al_l + 4 * hi;
    constexpr float C = 0.08838834764831845f * 1.4426950408889634f;
    float m_reg = -1e30f, l_reg = 0.f; f32x16 o[4] = {}; bf16x8 qr[8];
    { const bf16* Qw = Zq + (size_t)qtok * LDZ + hi * 8;
#pragma unroll
      for (int d0 = 0; d0 < 8; ++d0) qr[d0] = *(const bf16x8*)(Qw + d0 * 16); }
    unsigned kof[2], vof[2];
#pragma unroll
    for (int i = 0; i < 2; ++i) { const int p = (wid * 2 + i) * 64 + lane;
        { const int row = p >> 4, ch = (p & 15) ^ (row & 7); kof[i] = (unsigned)(row * LDZ + ch * 8); }
        { const int sub = p >> 5, g = p & 31, kk = (sub >> 2) * 8 + (g >> 2), c = (sub & 3) * 32 + (g & 3) * 8, k = (kk & ~0xC) | ((kk & 4) << 1) | ((kk & 8) >> 1);
          vof[i] = (unsigned)(k * LDZ + c); } }
    const bool shifted = (cb == 1) || (cb == 2);
    const int vbw = (int)(unsigned)(uintptr_t)V_lds + (shifted ? (v_rd_base(lane & 31) + (hi ? 4096 : 256) + ((w0 - 8) >> 4) * 4096) : (v_rd_base(lane) + (w0 >> 4) * 4096));
    const int krow = w0 + r32;
#define ATT_STAGE(t, b) do { const bf16* _k = Zk + (size_t)(t) * 64 * LDZ; const bf16* _v = Zv + (size_t)(t) * 64 * LDZ; \
        glds16(_k + kof[0], K_lds + (b) * SHM_K + (wid * 2) * 1024); glds16(_k + kof[1], K_lds + (b) * SHM_K + (wid * 2 + 1) * 1024); \
        glds16(_v + vof[0], V_lds + (b) * SHM_V + (wid * 2) * 1024); glds16(_v + vof[1], V_lds + (b) * SHM_V + (wid * 2 + 1) * 1024); } while (0)
#define ATT_TSTAGE(tp_) do { _Pragma("unroll") for (int i = 0; i < 4; ++i) glds16((tp_) + (i * 64 + lane) * 4, T_lds + i * 1024); } while (0)
    B2Tile ti = tinfo(0);
    ATT_STAGE(0, 0); if (ti.tp != nullptr) ATT_TSTAGE(ti.tp);
    asm volatile("s_waitcnt vmcnt(0)" ::: "memory"); __syncthreads();
    for (int j = 0; j < NT; ++j) {
        const int b = j & 1;
        if (j + 1 < NT) ATT_STAGE(j + 1, b ^ 1);
        B2Tile tn; tn.tp = nullptr; tn.va = false; tn.vb = false; if (j + 1 < NT) tn = tinfo(j + 1);
        if (ti.tp != nullptr) {
            f32x16 p0;
#pragma unroll
            for (int i = 0; i < 4; ++i) { const f32x4 t4 = *(const LAS f32x4*)(T_lds + (i * 64 + lane) * 16); p0[4 * i + 0] = t4.x; p0[4 * i + 1] = t4.y; p0[4 * i + 2] = t4.z; p0[4 * i + 3] = t4.w; }
            asm volatile("s_waitcnt lgkmcnt(0)" ::: "memory");
            if (tn.tp != nullptr) ATT_TSTAGE(tn.tp);
            { const LAS unsigned char* Ks = K_lds + b * SHM_K;
#pragma unroll
              for (int d0 = 0; d0 < 8; ++d0) { const int cbb = (d0 * 16 + hi * 8) * 2;
                  const bf16x8 kf = *(const LAS bf16x8*)(Ks + ATT_KSWZ(krow, cbb));
                  p0 = __builtin_amdgcn_mfma_f32_32x32x16_bf16(kf, qr[d0], p0, 0, 0, 0); } }
            if (!(ti.va && ti.vb)) {
                const bool ok = (r32 >> 4) ? ti.vb : ti.va;
#pragma unroll
                for (int r = 0; r < 16; ++r) p0[r] = ok ? p0[r] : -__builtin_inff(); }
            float pmax = p0[0];
#pragma unroll
            for (int r = 1; r < 16; ++r) pmax = fmaxf(pmax, p0[r]);
            pmax = swap_max(pmax) * C;
            if (!__all(pmax - m_reg <= THR_L2)) {
                const float mn = fmaxf(m_reg, pmax), alpha = __builtin_amdgcn_exp2f(m_reg - mn); m_reg = mn; l_reg *= alpha;
                if (hi == 0) al_l[r32] = alpha;
                asm volatile("s_waitcnt lgkmcnt(0)" ::: "memory");
#pragma unroll
                for (int d = 0; d < 4; ++d)
#pragma unroll
                    for (int r = 0; r < 16; ++r) o[d][r] *= al_h[(r & 3) + 8 * (r >> 2)];
            }
            float ps = 0.f; const float nm = -m_reg;
#pragma unroll
            for (int r = 0; r < 16; ++r) { p0[r] = __builtin_amdgcn_exp2f(fmaf(p0[r], C, nm)); ps += p0[r]; }
            l_reg += swap_add(ps);
            bf16x8 pa0, pa1;
#define ATT_PK4(P, BASE, OUT) do { const unsigned a0 = cvtpk(P[BASE + 0], P[BASE + 1]), a1 = cvtpk(P[BASE + 2], P[BASE + 3]); \
            const unsigned b0 = cvtpk(P[BASE + 4], P[BASE + 5]), b1 = cvtpk(P[BASE + 6], P[BASE + 7]); \
            auto r0 = __builtin_amdgcn_permlane32_swap(a0, b0, false, false); auto r1 = __builtin_amdgcn_permlane32_swap(a1, b1, false, false); \
            u32x4 w = {r0[0], r1[0], r0[1], r1[1]}; OUT = __builtin_bit_cast(bf16x8, w); } while (0)
            ATT_PK4(p0, 0, pa0); ATT_PK4(p0, 8, pa1);
#undef ATT_PK4
            { const int vb = vbw + b * SHM_V;
#define ATT_PK(L, H) (bf16x8){L[0], L[1], L[2], L[3], H[0], H[1], H[2], H[3]}
#define ATT_PV2(D0) do { const s16x4 l0 = tr_read<v_rd_off(D0, 0, 0)>(vb), h0 = tr_read<v_rd_off(D0, 0, 1)>(vb), l1 = tr_read<v_rd_off(D0, 1, 0)>(vb), h1 = tr_read<v_rd_off(D0, 1, 1)>(vb); \
              asm volatile("s_waitcnt lgkmcnt(0)" ::: "memory"); ATT_SBAR(); \
              o[D0] = __builtin_amdgcn_mfma_f32_32x32x16_bf16(pa0, ATT_PK(l0, h0), o[D0], 0, 0, 0); o[D0] = __builtin_amdgcn_mfma_f32_32x32x16_bf16(pa1, ATT_PK(l1, h1), o[D0], 0, 0, 0); } while (0)
              ATT_PV2(0); ATT_PV2(1); ATT_PV2(2); ATT_PV2(3);
#undef ATT_PV2
#undef ATT_PK
            }
        } else if (tn.tp != nullptr) ATT_TSTAGE(tn.tp);
        ti = tn;
        asm volatile("s_waitcnt vmcnt(0)" ::: "memory"); __syncthreads();
    }
#undef ATT_STAGE
#undef ATT_TSTAGE
    if (hi == 0) li_l[r32] = l_reg;
    asm volatile("s_waitcnt lgkmcnt(0)" ::: "memory");
#if G23_FP8
    { LAS unsigned char* St = (LAS unsigned char*)T_lds + hi * (4 * 128) + r32;
#pragma unroll
      for (int r = 0; r < 16; ++r) { const float rl = __builtin_amdgcn_rcpf(li_h[(r & 3) + 8 * (r >> 2)]);
#pragma unroll
          for (int d0 = 0; d0 < 4; ++d0) { const float v = o[d0][r] * rl; St[((r & 3) + 8 * (r >> 2)) * 128 + d0 * 32] = (unsigned char)(__builtin_amdgcn_cvt_pk_fp8_f32(v, v, 0, false) & 0xff); } }
      asm volatile("s_waitcnt lgkmcnt(0)" ::: "memory");
#pragma unroll
      for (int i = 0; i < 4; ++i) { const int ri = i * 8 + (lane >> 3), tok = (2 * rp + (ri >> 4)) * 64 + 16 * cb + (ri & 15);
          const u32x4 w = *(const LAS u32x4*)(T_lds + i * 1024 + lane * 16); *(u32x4*)((unsigned char*)Ob + (size_t)tok * LDO + (lane & 7) * 16) = w; }
      asm volatile("s_waitcnt lgkmcnt(0)" ::: "memory"); }
#else
    { LAS unsigned short* St = (LAS unsigned short*)T_lds + hi * (4 * 128) + r32;
#pragma unroll
      for (int r = 0; r < 16; ++r) { const float rl = __builtin_amdgcn_rcpf(li_h[(r & 3) + 8 * (r >> 2)]);
#pragma unroll
          for (int d0 = 0; d0 < 4; ++d0) { const float v = o[d0][r] * rl; St[((r & 3) + 8 * (r >> 2)) * 128 + d0 * 32] = (unsigned short)(cvtpk(v, v) & 0xffffu); } }
      asm volatile("s_waitcnt lgkmcnt(0)" ::: "memory");
#pragma unroll
      for (int i = 0; i < 8; ++i) { const int ri = i * 4 + (lane >> 4), tok = (2 * rp + (ri >> 4)) * 64 + 16 * cb + (ri & 15);
          const u32x4 w = *(const LAS u32x4*)(T_lds + i * 1024 + lane * 16); *(u32x4*)(Ob + (size_t)tok * LDO + (lane & 15) * 8) = w; }
      asm volatile("s_waitcnt lgkmcnt(0)" ::: "memory"); }
#endif
}
}

__device__ __forceinline__ void p0_tables(Frame& F) {
    float* tA = (float*)(F.ws() + WS_TBLA); float* tB = (float*)(F.ws() + WS_TBLB);
    const float ninf = -__builtin_inff();
    const int gt = blockIdx.x * (NWAVES * 64) + F.tid, ngt = F.G * NWAVES * 64;
    for (int e = gt; e < 8 * 10 * 2048; e += ngt) {
        const int h = e / 20480, rem = e - h * 20480, idx = rem >> 11, w_ = rem & 2047, i = w_ >> 8, lane = (w_ >> 2) & 63, ee = w_ & 3;
        const int r = 4 * (i & 3) + ee, hi = lane >> 5, q = lane & 31, key = ((i >> 2) << 5) + att::crow(r, hi);
        const int d = 32 * idx - 128 + q - key, ad = d < 0 ? -d : d;
        tA[e] = ad <= 128 ? -exp2f(-(float)(h + 1)) * (float)ad * (1.0f / ATT_SCALE) : ninf;
    }
    for (int e = gt; e < NLAYER * 8 * 16 * 4 * 1024; e += ngt) {
        const int w_ = e & 1023, t = e >> 10, cb = t & 3, t2 = t >> 2, d = t2 & 15, t3 = t2 >> 4, h = t3 & 7, l = t3 >> 3;
        const int i = w_ >> 8, lane = (w_ >> 2) & 63, ee = w_ & 3, r = 4 * i + ee, hi = lane >> 5, q = lane & 31, kw = att::crow(r, hi);
        const int w0 = cb == 0 ? 0 : (cb == 1 ? 8 : (cb == 2 ? 24 : 32)), kc = w0 + kw, c = 16 * cb + (q & 15), dr = d - (q >> 4);
        const int cc0 = c - 8 < 0 ? 0 : (c - 8 > 48 ? 48 : c - 8);
        int dcv = kc - c; dcv = dcv < -15 ? -15 : (dcv > 15 ? 15 : dcv);
        const bool ok = dr >= 0 && dr <= 14 && kc >= cc0 && kc < cc0 + 16;
        tB[e] = ok ? F.in(I_RPB)[((l * 8 + h) * 15 + dr) * 31 + dcv + 15] * (1.0f / ATT_SCALE) : ninf;
    }
}


__device__ __forceinline__ void qk_norm_phase(Frame& F, const int l) {
    bf16* Z = (bf16*)(F.ws() + WS_Z);
    const int sub = F.lane >> 4, li = F.lane & 15;
    for (int tl = F.gw; tl < TC; tl += F.ngw) {
        bf16* zr = Z + (size_t)tl * INC;
#pragma unroll
        for (int it = 0; it < 7; ++it) { const int hh = it * 4 + sub;
            if (hh < 26) {
                const int col = (hh < 10 ? hh * HD : 1536 + (hh - 10) * HD) + li * 8;
                const float* g = F.in(hh < 8 ? I_QNA : (hh < 10 ? I_KNA : (hh < 18 ? I_QNB : I_KNB))) + l * HD + li * 8;
                const v4u w = *(const v4u*)(zr + col);
                float f[8] = {bflo(w.x), bfhi(w.x), bflo(w.y), bfhi(w.y), bflo(w.z), bfhi(w.z), bflo(w.w), bfhi(w.w)};
                float ss = 0.f;
#pragma unroll
                for (int i = 0; i < 8; ++i) ss = fmaf(f[i], f[i], ss);
                ss += __shfl_xor(ss, 1); ss += __shfl_xor(ss, 2); ss += __shfl_xor(ss, 4); ss += __shfl_xor(ss, 8);
                const float rs = rsqrtf(ss * (1.f / HD) + RMS_EPS);
                const f32x4 g0 = *(const f32x4*)g, g1 = *(const f32x4*)(g + 4);
                v4u o; o.x = pk2(f[0] * rs * g0.x, f[1] * rs * g0.y); o.y = pk2(f[2] * rs * g0.z, f[3] * rs * g0.w); o.z = pk2(f[4] * rs * g1.x, f[5] * rs * g1.y); o.w = pk2(f[6] * rs * g1.z, f[7] * rs * g1.w);
                *(v4u*)(zr + col) = o;
            } }
    }
}

template <int MIXER> __device__ __forceinline__ void attn_fast(Frame& F, const int l, const int c0) {
    const bf16* Z = (const bf16*)(F.ws() + WS_Z); bf16* O = (bf16*)(F.ws() + WS_O);
    const float* tblA = (const float*)(F.ws() + WS_TBLA); const float* tblB = (const float*)(F.ws() + WS_TBLB) + (size_t)l * (8 * 16 * 4 * 1024);
    constexpr int OB = G23_FP8 ? 1 : 2;
    if (MIXER == 0) {
        const bool grp = (F.G & 7) == 0; constexpr int UPG = (TC / 64) * 2 / 8;
        for (int ui = grp ? ((int)blockIdx.x & 7) * UPG + ((int)blockIdx.x >> 3) : (int)blockIdx.x; ui < (grp ? (((int)blockIdx.x & 7) + 1) * UPG : (TC / 64) * 2); ui += grp ? (F.G >> 3) : F.G) {
            const int qb = ui >> 1, kvh = ui & 1, row0 = c0 + qb * 64, lq = qb * 64;
            const int S = row0 < TP ? 2048 : 4096, pos0 = row0 < TP ? (row0 & 2047) : ((row0 - TP) & 4095);
            const int jlo = pos0 >= 128 ? 0 : (128 - pos0) >> 6, jr = (S + 64 - pos0) >> 6, jhi = jr > 4 ? 4 : jr, NT = jhi - jlo + 1;
            const int lk = lq - 128 + 64 * jlo, g = F.wave >> 1, half = F.wave & 1, h = kvh * 4 + g, lqw = lq + 32 * half;
            const float* tb = tblA + (size_t)h * (10 * 2048);
            auto tfn = [=](int j) -> const float* { return tb + (half + 8 - 2 * (jlo + j)) * 2048; };
            att::attn_unit<INC, D>(Z + (size_t)lqw * INC + ZC_QA + h * HD, Z + (size_t)lk * INC + ZC_KA + kvh * HD, Z + (size_t)lk * INC + ZC_VA + kvh * HD,
                                   (bf16*)((unsigned char*)O + ((size_t)lqw * D + h * HD) * OB), NT, tfn, F.in(I_SINK)[l * 8 + h] * LOG2E, F.lds + RING_OFF, F.tid);
        }
    } else {
        const bool grp = (F.G & 7) == 0; constexpr int UPG = (TC / 256) * 8 / 8;
        for (int ui = grp ? ((int)blockIdx.x & 7) * UPG + ((int)blockIdx.x >> 3) : (int)blockIdx.x; ui < (grp ? (((int)blockIdx.x & 7) + 1) * UPG : (TC / 256) * 8); ui += grp ? (F.G >> 3) : F.G) {
            const int qb = ui >> 3, h = ui & 7, row0 = c0 + qb * 256;
            const int S = row0 < TP ? 2048 : 4096, pos0 = row0 < TP ? (row0 & 2047) : ((row0 - TP) & 4095);
            const int lq = qb * 256;
            const int rows = S >> 6, u4 = pos0 >> 6;
            const int lo_ = u4 - 4 < 0 ? 0 : (u4 - 4 > rows - 8 ? rows - 8 : u4 - 4), hiq = u4 + 3 - 4 < 0 ? 0 : (u4 - 1 > rows - 8 ? rows - 8 : u4 - 1);
            const int NT = hiq + 7 - lo_ + 1, lk = lq - pos0 + 64 * lo_;
            const int ra = u4 + 2 * (F.wave >> 2), rb_ = ra + 1;
            const int r0a = ra - 4 < 0 ? 0 : (ra - 4 > rows - 8 ? rows - 8 : ra - 4), r0b = rb_ - 4 < 0 ? 0 : (rb_ - 4 > rows - 8 ? rows - 8 : rb_ - 4);
            const float* tb = tblB + (size_t)(h * 16 * 4 + (F.wave & 3)) * 1024;
            auto tfn = [=](int j) -> att::B2Tile { const int kr = lo_ + j; att::B2Tile t; t.va = kr >= r0a && kr <= r0a + 7; t.vb = kr >= r0b && kr <= r0b + 7;
                t.tp = (t.va || t.vb) ? tb + (size_t)(kr - ra + 7) * (4 * 1024) : nullptr; return t; };
            att::attn_unit_b2<INC, D>(Z + (size_t)lq * INC + ZC_QB + h * HD, Z + (size_t)lk * INC + ZC_KB + h * HD, Z + (size_t)lk * INC + ZC_VB + h * HD,
                                      (bf16*)((unsigned char*)O + ((size_t)lq * D + 1024 + h * HD) * OB), NT, tfn, F.lds + RING_OFF, F.tid);
        }
    }
}

#ifndef SITE_MASK
#define SITE_MASK 0xffff
#endif
#define SITE(k) ((SITE_MASK >> (k)) & 1)
#ifndef STAGGER_TICKS
#define STAGGER_TICKS 0u
#endif
#ifndef PROBE_REP
#define PROBE_REP 0
#endif
constexpr int N_BAR_TOTAL = 2 + 2 * (8 + 7);
static_assert((TC / 256) % (8 * pg8::WGM) == 0, "group seams: every eighth of the tile list must hold whole tile groups");
__device__ __forceinline__ void seam_barrier(Frame& F, const XcdBarrier& bar) {
    if ((F.G & 7) == 0) grp_barrier(bar, (unsigned)blockIdx.x & 7u); else xcd_barrier(bar);
}
__device__ __forceinline__ void halo_barrier(Frame& F, const XcdBarrier& bar) {
    if ((F.G & 7) == 0) grp_barrier(bar, (unsigned)blockIdx.x & 7u, true); else xcd_barrier(bar);
}
__device__ __forceinline__ void hid_barrier(Frame& F, const XcdBarrier& bar) {
    if ((F.G & 7) == 0) grp_barrier(bar, (unsigned)blockIdx.x & 7u, true, 2u); else xcd_barrier(bar);
}
template <int l, int c, bool LAST> __device__ __forceinline__ void layer_chunk(Frame& F, const XcdBarrier& bar) {
    unsigned char* wl = F.ws() + WS_W + (size_t)l * W_LAYER;
    const pg8::bf16_t* WinT = (const pg8::bf16_t*)(wl + WO_IN); const pg8::bf16_t* WbrT = (const pg8::bf16_t*)(wl + WO_BR); const pg8::bf16_t* WoutT = (const pg8::bf16_t*)(wl + WO_OUT);
    const pg8::bf16_t* W1T = (const pg8::bf16_t*)(wl + WO_1); const pg8::bf16_t* W2T = (const pg8::bf16_t*)(wl + WO_2);
    pg8::bf16_t* Hb = (pg8::bf16_t*)(F.ws() + WS_H); pg8::bf16_t* Zb = (pg8::bf16_t*)(F.ws() + WS_Z); pg8::bf16_t* Ob = (pg8::bf16_t*)(F.ws() + WS_O); pg8::bf16_t* Mb = (pg8::bf16_t*)(F.ws() + WS_MB); pg8::bf16_t* Xb = (pg8::bf16_t*)(F.ws() + WS_XB);
    constexpr int c0 = c * TC;
    pg8::ssq_t* ssq1 = F.ssq() + (size_t)((0 * NCH + c) * NLAYER + l) * TC;
    pg8::ssq_t* ssq2 = F.ssq() + (size_t)((1 * NCH + c) * NLAYER + l) * TC;
    const float* modl = F.mod() + (size_t)l * NSEQ * 6 * D;
    if (l == 0) { norm0_phase(F, c0, ssq1); seam_barrier(F, bar); }
    if (SITE(1)) { pg8::Gemm g{Hb, WinT, TC, INC, D / 2, D, D / 2}; pg8::PrefetchOrder S; S.init(TC, INC, F.G, (int)blockIdx.x); S.rev = true;
      S.ssq = ssq1; S.shw = F.shwin() + (size_t)l * NSEQ * INC; S.ldw = INC; S.row_off = c0; S.buf = F.lds + PFB_OFF; S.cnt = 0;
      pg8::EpiZ E{Zb, INC, F.in(I_QNA) + l * HD, F.in(I_KNA) + l * HD, F.in(I_QNB) + l * HD, F.in(I_KNB) + l * HD, (PG8_LAS float*)(F.lds + PART_OFF), F.lds + PFB_OFF, 0};
      pg8::gemm_phase<pg8::EpiZ, pg8::PrefetchOrder, true, PG8_SP2, true>(F.lds + RING_OFF, g, S, E); halo_barrier(F, bar); }
#if PROBE_REP & 2
    if (SITE(1)) { pg8::Gemm g{Hb, WinT, TC, INC, D / 2, D, D / 2}; pg8::PrefetchOrder S; S.init(TC, INC, F.G, (int)blockIdx.x);
      S.ssq = ssq1; S.shw = F.shwin() + (size_t)l * NSEQ * INC; S.ldw = INC; S.row_off = c0; S.buf = F.lds + PFB_OFF; S.cnt = 0;
      pg8::EpiZ E{Zb, INC, F.in(I_QNA) + l * HD, F.in(I_KNA) + l * HD, F.in(I_QNB) + l * HD, F.in(I_KNB) + l * HD, (PG8_LAS float*)(F.lds + PART_OFF), F.lds + PFB_OFF, 0};
      pg8::gemm_phase<pg8::EpiZ, pg8::PrefetchOrder, true, PG8_SP2, true>(F.lds + RING_OFF, g, S, E); xcd_barrier(bar); }
#endif
    if (SITE(2)) { attn_fast<0>(F, l, c0); attn_fast<1>(F, l, c0); seam_barrier(F, bar); }
#if PROBE_REP & 4
    if (SITE(2)) { attn_fast<0>(F, l, c0); attn_fast<1>(F, l, c0); xcd_barrier(bar); }
#endif
    if (SITE(3)) { pg8::Gemm g{Ob, WbrT, TC, D, G23_FP8 ? D / 2 : D, G23_FP8 ? D / 2 : D, G23_FP8 ? D / 2 : D}; pg8::StaticOrder S; S.init(TC, D, F.G, (int)blockIdx.x);
      pg8::EpiGateMid<INC, D, G4_FP8 != 0, G23_FP8 != 0> E{Zb + ZC_GA, Zb + ZC_GB, Mb};
      pg8::gemm_phase<pg8::EpiGateMid<INC, D, G4_FP8 != 0, G23_FP8 != 0>, pg8::StaticOrder, PG8_ALIGN, PG8_SP2, G23_FP8 != 0>(F.lds + RING_OFF, g, S, E); seam_barrier(F, bar); }
#if PROBE_REP & 64
    if (SITE(3)) { pg8::Gemm g{Ob, WbrT, TC, D, G23_FP8 ? D / 2 : D, G23_FP8 ? D / 2 : D, G23_FP8 ? D / 2 : D}; pg8::StaticOrder S; S.init(TC, D, F.G, (int)blockIdx.x);
      pg8::EpiGateMid<INC, D, G4_FP8 != 0, G23_FP8 != 0> E{Zb + ZC_GA, Zb + ZC_GB, Mb};
      pg8::gemm_phase<pg8::EpiGateMid<INC, D, G4_FP8 != 0, G23_FP8 != 0>, pg8::StaticOrder, PG8_ALIGN, PG8_SP2, G23_FP8 != 0>(F.lds + RING_OFF, g, S, E); xcd_barrier(bar); }
#endif
#if G4_FP8
    if (SITE(5)) { pg8::Gemm g{Mb, WoutT, TC, D, D / 2, D / 2, D / 2}; pg8::StaticOrder S; S.init(TC, D, F.G, (int)blockIdx.x);
      pg8::EpiResid<(l == 0 ? 0 : 1), 1, (G5_FP8 ? 2 : 1), true> E{F.in(I_XP), F.in(I_XS), Xb, F.out(), modl + 2 * D, c0, F.in(I_LN2) + l * D, modl + 4 * D, (void*)Hb, ssq2, (PG8_LAS float*)(F.lds + PART_OFF)};
      pg8::gemm_phase<pg8::EpiResid<(l == 0 ? 0 : 1), 1, (G5_FP8 ? 2 : 1), true>, pg8::StaticOrder, PG8_ALIGN, PG8_SP2, true>(F.lds + RING_OFF, g, S, E); hid_barrier(F, bar); }
#else
    if (SITE(5)) { pg8::Gemm g{Mb, WoutT, TC, D, D, D, D}; pg8::StaticOrder S; S.init(TC, D, F.G, (int)blockIdx.x);
      pg8::EpiResid<(l == 0 ? 0 : 1), 1, 1> E{F.in(I_XP), F.in(I_XS), Xb, F.out(), modl + 2 * D, c0, F.in(I_LN2) + l * D, modl + 4 * D, (void*)Hb, ssq2, (PG8_LAS float*)(F.lds + PART_OFF)};
      pg8::gemm_phase<pg8::EpiResid<(l == 0 ? 0 : 1), 1, 1>, pg8::StaticOrder, PG8_ALIGN, PG8_SP2>(F.lds + RING_OFF, g, S, E); hid_barrier(F, bar); }
#endif
#ifdef PROBE_CLOCK
    if (LAST && blockIdx.x == 0 && F.tid == 0) { volatile LAS unsigned long long* st = (volatile LAS unsigned long long*)(F.lds + MISC_OFF + 64); st[0] = clock64(); st[1] = wall_clock64(); }
#endif
    if (SITE(6)) { pg8::Gemm g{Hb, W1T, TC, DFF, G5_FP8 ? D / 2 : D, D, G5_FP8 ? D / 2 : D}; pg8::PrefetchOrder S; S.init(TC, DFF, F.G, (int)blockIdx.x);
      S.ssq = ssq2; S.shw = F.shw1() + (size_t)l * NSEQ * DFF; S.ldw = DFF; S.row_off = c0; S.buf = F.lds + PFB_OFF; S.cnt = 0;
      pg8::EpiMlp1<G5_FP8 != 0> E{Zb, INC, F.lds + PFB_OFF, 0};
      pg8::gemm_phase<pg8::EpiMlp1<G5_FP8 != 0>, pg8::PrefetchOrder, PG8_ALIGN, PG8_SP2, G5_FP8 != 0>(F.lds + RING_OFF, g, S, E);
#ifdef PROBE_CLOCK
      if (LAST && blockIdx.x == 0 && F.tid == 0) { volatile LAS unsigned long long* st = (volatile LAS unsigned long long*)(F.lds + MISC_OFF + 64); st[2] = clock64(); st[3] = wall_clock64(); }
#endif
      seam_barrier(F, bar); }
#if PROBE_REP & 8
    if (SITE(6)) { pg8::Gemm g{Hb, W1T, TC, DFF, G5_FP8 ? D / 2 : D, D, G5_FP8 ? D / 2 : D}; pg8::PrefetchOrder S; S.init(TC, DFF, F.G, (int)blockIdx.x);
      S.ssq = ssq2; S.shw = F.shw1() + (size_t)l * NSEQ * DFF; S.ldw = DFF; S.row_off = c0; S.buf = F.lds + PFB_OFF; S.cnt = 0;
      pg8::EpiMlp1<G5_FP8 != 0> E{Zb, INC, F.lds + PFB_OFF, 0};
      pg8::gemm_phase<pg8::EpiMlp1<G5_FP8 != 0>, pg8::PrefetchOrder, PG8_ALIGN, PG8_SP2, G5_FP8 != 0>(F.lds + RING_OFF, g, S, E); xcd_barrier(bar); }
#endif
    if (SITE(7)) { pg8::Gemm g{Zb, W2T, TC, D, DFF, INC, DFF}; pg8::StaticOrder S; S.init(TC, D, F.G, (int)blockIdx.x); S.revm = true;
      if (l + 1 < NLAYER) {
          pg8::EpiResid<1, 1, 2> E{F.in(I_XP), F.in(I_XS), Xb, F.out(), modl + 5 * D, c0, F.in(I_LN1) + (l + 1) * D, F.mod() + ((size_t)(l + 1) * NSEQ * 6 + 1) * D, (void*)Hb, F.ssq() + (size_t)((0 * NCH + c) * NLAYER + (l + 1)) * TC, (PG8_LAS float*)(F.lds + PART_OFF)};
          pg8::gemm_phase<pg8::EpiResid<1, 1, 2>, pg8::StaticOrder, PG8_ALIGN, PG8_SP2>(F.lds + RING_OFF, g, S, E);
      } else {
          pg8::EpiResid<1, 0, 0> E{F.in(I_XP), F.in(I_XS), Xb, F.out(), modl + 5 * D, c0, nullptr, nullptr, nullptr, nullptr, nullptr};
          pg8::gemm_phase<pg8::EpiResid<1, 0, 0>, pg8::StaticOrder, PG8_ALIGN, PG8_SP2>(F.lds + RING_OFF, g, S, E);
      }
      if (!LAST) { if (l + 1 < NLAYER) seam_barrier(F, bar); else if ((F.G & 7) != 0) xcd_barrier(bar); } }
}

__global__ void __launch_bounds__(NWAVES * 64, 2) enc_fwd(Args a) {
    extern __shared__ __attribute__((aligned(16))) unsigned char lds_raw[];
    Frame F;
    F.lds = (LAS unsigned char*)lds_raw;
    F.tid = threadIdx.x; F.lane = F.tid & 63; F.wave = __builtin_amdgcn_readfirstlane(F.tid >> 6);
    F.G = gridDim.x; F.gw = blockIdx.x * NWAVES + F.wave; F.ngw = F.G * NWAVES;
    F.ap = (const __attribute__((address_space(4))) Args*)__builtin_amdgcn_kernarg_segment_ptr();
    const unsigned char* a_ws = F.ws();
    gu32* ctl = (gu32*)(a_ws + WS_CTL);
    for (int u = F.tid; u < (LDS_BYTES - LDSCTL_OFF) / 4; u += NWAVES * 64) ((LAS unsigned*)(F.lds + LDSCTL_OFF))[u] = 0u;
    __syncthreads();
    volatile LAS unsigned* MISC = (volatile LAS unsigned*)(F.lds + MISC_OFF);
    XcdBarrier bar = xcd_barrier_post((unsigned*)(ctl + CW_BAR), MISC + 8);

    { p0_mod(F); p0_tables(F);
      for (int i = blockIdx.x * (NWAVES * 64) + F.tid; i < 2 * NCH * NLAYER * TC; i += F.G * NWAVES * 64) F.ssq()[i] = 0ull;
      xcd_barrier(bar); }
    { p0_shw(F); p0_weights(F); xcd_barrier(bar); }
#if PROBE_REP & 1
    { p0_mod(F); p0_tables(F); xcd_barrier(bar); p0_shw(F); p0_weights(F); xcd_barrier(bar); }
#endif

    layer_chunk<0, 0, false>(F, bar); layer_chunk<1, 0, false>(F, bar); layer_chunk<0, 1, false>(F, bar); layer_chunk<1, 1, true>(F, bar);

#ifdef PROBE_CLOCK
    if (blockIdx.x == 0 && F.tid == 0) { volatile LAS unsigned long long* st = (volatile LAS unsigned long long*)(F.lds + MISC_OFF + 64);
        const unsigned long long dc = st[2] - st[0], dt = st[3] - st[1]; const unsigned long long spin = dc * 5000ull / (dt ? dt : 1ull);
        const unsigned long long t0 = wall_clock64(); while (wall_clock64() - t0 < spin) __builtin_amdgcn_s_sleep(16); }
#endif
    if (blockIdx.x == 0 && F.tid == 0) { if (__hip_atomic_load(ctl + CW_BAR + XB_TMO, RLX_AGENT) != 0u) F.out()[0] = __builtin_nanf(""); }
}

extern "C" void kernel_launch(void* const* d_in, const int* in_sizes, int n_in, void* d_out, int out_size, void* d_ws, size_t ws_size, hipStream_t stream) {
    static int grid = 0;
    if (grid == 0) {
        if (n_in != N_IN || out_size != TTOK * D || ws_size < WS_END) { fprintf(stderr, "kernel_launch: shape/workspace mismatch (n_in %d, out %d, ws %zu, need %zu); nothing launched\n", n_in, out_size, ws_size, (size_t)WS_END); grid = -1; return; }
        int dev = 0, cus = 0;
        if (hipGetDevice(&dev) != hipSuccess || hipDeviceGetAttribute(&cus, hipDeviceAttributeMultiprocessorCount, dev) != hipSuccess) { grid = -1; return; }
        if (hipFuncSetAttribute((const void*)enc_fwd, hipFuncAttributeMaxDynamicSharedMemorySize, LDS_BYTES) != hipSuccess) { fprintf(stderr, "kernel_launch: hipFuncSetAttribute failed\n"); grid = -1; return; }
        int per_cu = 0;
        if (hipOccupancyMaxActiveBlocksPerMultiprocessor(&per_cu, (const void*)enc_fwd, NWAVES * 64, LDS_BYTES) != hipSuccess || per_cu < 1) { fprintf(stderr, "kernel_launch: occupancy query says %d blocks per CU\n", per_cu); }
        (void)hipGetLastError();
        grid = cus;
    }
    if (grid < 0) return;
    if (hipMemsetAsync((char*)d_ws + WS_CTL, 0, CTL_ZERO_BYTES, stream) != hipSuccess) return;
    Args a{};
    for (int i = 0; i < N_IN; ++i) a.in[i] = (const float*)d_in[i];
    a.out = (float*)d_out; a.ws = (unsigned char*)d_ws;
    hipLaunchKernelGGL(enc_fwd, dim3(grid), dim3(NWAVES * 64), LDS_BYTES, stream, a);
    const hipError_t le = hipPeekAtLastError();
    if (le != hipSuccess) fprintf(stderr, "kernel_launch: launch failed: %s\n", hipGetErrorName(le));
}
```

```cpp
#include <hip/hip_runtime.h>
#include <cstdio>
#include <cstdint>
namespace pg8 {
#define PG8_LAS __attribute__((address_space(3)))
typedef unsigned short bf16_t;
typedef short bf16x8 __attribute__((ext_vector_type(8)));
typedef float f32x4 __attribute__((ext_vector_type(4)));
typedef unsigned u32x4 __attribute__((ext_vector_type(4)));
typedef int pg8_i32x4 __attribute__((ext_vector_type(4)));
typedef int pg8_i32x8 __attribute__((ext_vector_type(8)));
constexpr int BM = 256, BK = 64, HALF = 128, HTB = HALF * BK * 2  , STAGE_BYTES = 8 * HTB, NXCD = 8, WGM = 4;

__host__ __device__ __forceinline__ int lds_byte(int r, int c) { const int st = (r >> 4) * 2 + (c >> 5), rr = r & 15, cc = c & 31, ob = rr * 64 + cc * 2; return st * 1024 + (ob ^ (((ob >> 9) & 1) << 5)); }
__host__ __device__ __forceinline__ void stage_rc(int b, int& R, int& C) { const int st = b / 1024, sb = b % 1024, swz = sb ^ (((sb >> 9) & 1) << 5); R = (st >> 1) * 16 + swz / 64; C = (st & 1) * 32 + (swz % 64) / 2; }
__host__ __device__ __forceinline__ int perm32(int rho) { const int n = rho >> 4, i = rho & 15; return 8 * (i >> 2) + 4 * n + (i & 3); }

struct Unit { int pm, pn; };
struct Gemm { const bf16_t* A; const bf16_t* Bt; int M, N, K, lda, ldb; };

struct StaticOrder {
    int nM, nN, nwg, G, c; bool revm = false;
    bool rev = false;
    __host__ __device__ void init(int M, int N, int G_, int c_) { nM = M / BM; nN = N / BM; nwg = nM * nN; G = G_; c = c_; }
    __host__ __device__ bool next(int i, Unit& u) const {
        const long L = (long)i * G + c; if (L >= nwg) return false;
        int wgid = (int)L; { const int q = nwg / NXCD, r = nwg % NXCD, xcd = wgid % NXCD, off = wgid / NXCD; wgid = (xcd < r ? xcd * (q + 1) : r * (q + 1) + (xcd - r) * q) + off; }
        const int nig = WGM * nN; int gid = wgid / nig;
        if (revm) { const int q = nwg / NXCD; if (nwg % NXCD == 0 && q % nig == 0) { const int ngc = q / nig, x = gid / ngc; gid = x * ngc + (ngc - 1 - (gid - x * ngc)); } }
        const int fm = gid * WGM, gsz = (nM - fm) < WGM ? (nM - fm) : WGM;
        u.pm = fm + ((wgid % nig) % gsz); u.pn = (wgid % nig) / gsz; if (rev) u.pn = nN - 1 - u.pn; return true;
    }
    __device__ __forceinline__ void a_ready(const Unit&) const {}
    __device__ __forceinline__ void done(const Unit&) const {}
};
__device__ __forceinline__ unsigned cvt_pk_bf16(float lo, float hi) { unsigned r; asm volatile("v_cvt_pk_bf16_f32 %0, %1, %2" : "=v"(r) : "v"(lo), "v"(hi)); return r; }
typedef float f32x2 __attribute__((ext_vector_type(2)));
template <class Epi, class Sched, bool ALIGN_EPI = false, bool SP2 = false, bool FP8 = false>
__device__ __forceinline__ void gemm_phase(PG8_LAS unsigned char* lds, const Gemm g, const Sched& S, const Epi& E, const unsigned delay_ticks = 0u) {
    int tid_ = threadIdx.x; asm volatile("" : "+v"(tid_));
    const int tid = tid_, wid = __builtin_amdgcn_readfirstlane(tid >> 6), lane = tid & 63, wr = wid >> 2, wc = wid & 3, fr = lane & 15, fq = lane >> 4;
    const int K = g.K, nt = K / BK;
    unsigned voffA[2], voffB[2];
#pragma unroll
    for (int i = 0; i < 2; ++i) { int R, C; stage_rc(tid * 16 + i * 8192, R, C); const int Rb = Epi::PERM ? ((R & ~31) + perm32(R & 31)) : R;
        voffA[i] = (unsigned)(R * g.lda + C) * 2u; voffB[i] = (unsigned)(Rb * g.ldb + C) * 2u; }
    const size_t kstep = (size_t)(BK * 2);
    const size_t hstepA = (size_t)HALF * g.lda * 2, hstepB = (size_t)HALF * g.ldb * 2;
    const size_t tstepA = 2 * hstepA, tstepB = 2 * hstepB;
    const unsigned ldsw = (unsigned)wid * 1024u;
    const int aoff = lds_byte(wr * 64 + fr, fq * 8), boff = lds_byte(wc * 32 + fr, fq * 8);
#define PG8_SA(b, h) (((b) * 2 + (h)) * HTB)
#define PG8_SB(b, h) ((4 + (b) * 2 + (h)) * HTB)
#define PG8_STAGE(bufoff, gbase, voff) do { _Pragma("unroll") for (int _i = 0; _i < 2; ++_i) \
        __builtin_amdgcn_global_load_lds((const unsigned*)((const char*)(gbase) + (voff)[_i]), (PG8_LAS unsigned*)(lds + (bufoff) + ldsw + _i * 8192), 16, 0, 0); } while (0)
#define PG8_LDA(dst, b, h) do { if constexpr (FP8) { _Pragma("unroll") for (int m = 0; m < 4; ++m) dst##8[m] = __builtin_shufflevector(*(const PG8_LAS pg8_i32x4*)(lds + PG8_SA(b, h) + aoff + m * 2048), *(const PG8_LAS pg8_i32x4*)(lds + PG8_SA(b, h) + aoff + m * 2048 + 1024), 0, 1, 2, 3, 4, 5, 6, 7); } \
        else { _Pragma("unroll") for (int m = 0; m < 4; ++m) _Pragma("unroll") for (int k = 0; k < 2; ++k) dst[m][k] = *(const PG8_LAS bf16x8*)(lds + PG8_SA(b, h) + aoff + m * 2048 + k * 1024); } } while (0)
#define PG8_LDB(dst, b, h) do { if constexpr (FP8) { _Pragma("unroll") for (int n = 0; n < 2; ++n) dst##8[n] = __builtin_shufflevector(*(const PG8_LAS pg8_i32x4*)(lds + PG8_SB(b, h) + boff + n * 2048), *(const PG8_LAS pg8_i32x4*)(lds + PG8_SB(b, h) + boff + n * 2048 + 1024), 0, 1, 2, 3, 4, 5, 6, 7); } \
        else { _Pragma("unroll") for (int n = 0; n < 2; ++n) _Pragma("unroll") for (int k = 0; k < 2; ++k) dst[n][k] = *(const PG8_LAS bf16x8*)(lds + PG8_SB(b, h) + boff + n * 2048 + k * 1024); } } while (0)
#define PG8_CAT8(lo, hi) __builtin_shufflevector(__builtin_bit_cast(pg8_i32x4, lo), __builtin_bit_cast(pg8_i32x4, hi), 0, 1, 2, 3, 4, 5, 6, 7)
#define PG8_MMA(ai, bj, At, Bt) do { __builtin_amdgcn_s_setprio(1); \
        if constexpr (FP8) { _Pragma("unroll") for (int m = 0; m < 4; ++m) _Pragma("unroll") for (int n = 0; n < 2; ++n) \
            asm volatile("v_mfma_scale_f32_16x16x128_f8f6f4 %0, %1, %2, %0, %3, %3 op_sel_hi:[0,0,0]" : "+v"(acc[ai][bj][m][n]) : "v"(Bt##8[n]), "v"(At##8[m]), "v"(one_e8m0)); } \
        else { _Pragma("unroll") for (int m = 0; m < 4; ++m) _Pragma("unroll") for (int n = 0; n < 2; ++n) _Pragma("unroll") for (int k = 0; k < 2; ++k) \
            acc[ai][bj][m][n] = __builtin_amdgcn_mfma_f32_16x16x32_bf16(Bt[n][k], At[m][k], acc[ai][bj][m][n], 0, 0, 0); } \
        __builtin_amdgcn_s_setprio(0); } while (0)
#define PG8_WAIT_V(n) asm volatile("s_waitcnt vmcnt(" #n ")" ::: "memory")
#define PG8_WAIT_L(n) asm volatile("s_waitcnt lgkmcnt(" #n ")" ::: "memory")
#define PG8_BAR __builtin_amdgcn_s_barrier()
#define PG8_SCHED __builtin_amdgcn_sched_barrier(0)
    if (delay_ticks) { const unsigned long long t0 = __builtin_amdgcn_s_memrealtime(); while (__builtin_amdgcn_s_memrealtime() - t0 < (unsigned long long)delay_ticks) __builtin_amdgcn_s_sleep(8); }
    Unit cur, nxt; int ui = 0;
    if (!S.next(0, cur)) return;
    f32x4 acc[2][2][4][2];
#pragma unroll
    for (int a = 0; a < 2; ++a)
#pragma unroll
        for (int b = 0; b < 2; ++b)
#pragma unroll
            for (int m = 0; m < 4; ++m)
#pragma unroll
                for (int n = 0; n < 2; ++n) acc[a][b][m][n] = (f32x4){0.f, 0.f, 0.f, 0.f};
    bf16x8 At[4][2], B0[2][2], B1[2][2];
    const int one_e8m0 = 127;
    pg8_i32x8 At8[4], B08[2], B18[2];
    const char* cA = (const char*)g.A + (size_t)cur.pm * tstepA; const char* cB = (const char*)g.Bt + (size_t)cur.pn * tstepB;
    S.a_ready(cur);
    if constexpr (SP2) {
        PG8_STAGE(PG8_SB(0, 0), cB, voffB); PG8_STAGE(PG8_SB(0, 1), cB + hstepB, voffB); PG8_STAGE(PG8_SA(0, 0), cA, voffA); PG8_STAGE(PG8_SA(0, 1), cA + hstepA, voffA);
        if (wr == 1) PG8_BAR;
        PG8_WAIT_V(2); PG8_BAR;
        PG8_STAGE(PG8_SB(1, 0), cB + kstep, voffB); PG8_STAGE(PG8_SA(1, 0), cA + kstep, voffA); PG8_STAGE(PG8_SB(1, 1), cB + hstepB + kstep, voffB);
        PG8_WAIT_V(6); PG8_BAR;
    } else {
        PG8_STAGE(PG8_SB(0, 0), cB, voffB); PG8_STAGE(PG8_SA(0, 0), cA, voffA); PG8_STAGE(PG8_SB(0, 1), cB + hstepB, voffB); PG8_STAGE(PG8_SA(0, 1), cA + hstepA, voffA);
        if (wr == 1) PG8_BAR;
        PG8_WAIT_V(4); PG8_BAR;
        PG8_STAGE(PG8_SB(1, 0), cB + kstep, voffB); PG8_STAGE(PG8_SA(1, 0), cA + kstep, voffA); PG8_STAGE(PG8_SB(1, 1), cB + hstepB + kstep, voffB);
        PG8_WAIT_V(6); PG8_BAR;
    }
    for (;;) {
        const bool has_next = S.next(ui + 1, nxt);
        const char* nA = has_next ? (const char*)g.A + (size_t)nxt.pm * tstepA : cA; const char* nB = has_next ? (const char*)g.Bt + (size_t)nxt.pn * tstepB : cB;
        auto kloop = [&](const int tb, const int te) __attribute__((always_inline)) {
        for (int t = tb; t < te; t += 2) {
            const bool last = (t == nt - 2);
            const char* a1 = cA + (size_t)(t + 1) * kstep;
            const char* a2 = last ? nA : cA + (size_t)(t + 2) * kstep; const char* b2 = last ? nB : cB + (size_t)(t + 2) * kstep;
            const char* a3 = a2 + kstep; const char* b3 = b2 + kstep;
            if (last && has_next) S.a_ready(nxt);
            if constexpr (SP2) {
            PG8_LDB(B0, 0, 0); PG8_LDB(B1, 0, 1); PG8_SCHED; PG8_LDA(At, 0, 0); PG8_STAGE(PG8_SA(1, 1), a1 + hstepA, voffA);
            PG8_WAIT_V(8); PG8_WAIT_L(0); PG8_BAR; PG8_MMA(0, 0, At, B0); PG8_MMA(0, 1, At, B1); PG8_BAR; PG8_SCHED;
            PG8_LDA(At, 0, 1); PG8_STAGE(PG8_SB(0, 0), b2, voffB); PG8_STAGE(PG8_SB(0, 1), b2 + hstepB, voffB); PG8_STAGE(PG8_SA(0, 0), a2, voffA);
            PG8_WAIT_V(8); PG8_WAIT_L(0); PG8_BAR; PG8_MMA(1, 0, At, B0); PG8_MMA(1, 1, At, B1); PG8_BAR; PG8_SCHED;
            PG8_LDB(B0, 1, 0); PG8_LDB(B1, 1, 1); PG8_SCHED; PG8_LDA(At, 1, 0); PG8_STAGE(PG8_SA(0, 1), a2 + hstepA, voffA);
            PG8_WAIT_V(8); PG8_WAIT_L(0); PG8_BAR; PG8_MMA(0, 0, At, B0); PG8_MMA(0, 1, At, B1); PG8_BAR; PG8_SCHED;
            PG8_LDA(At, 1, 1); PG8_STAGE(PG8_SB(1, 0), b3, voffB); PG8_STAGE(PG8_SB(1, 1), b3 + hstepB, voffB); PG8_STAGE(PG8_SA(1, 0), a3, voffA);
            PG8_WAIT_V(8); PG8_WAIT_L(0); PG8_BAR; PG8_MMA(1, 0, At, B0); PG8_MMA(1, 1, At, B1); PG8_BAR; PG8_SCHED;
            } else {
            PG8_LDB(B0, 0, 0); PG8_SCHED; PG8_LDA(At, 0, 0); PG8_STAGE(PG8_SA(1, 1), a1 + hstepA, voffA);
            PG8_WAIT_L(8); PG8_BAR; PG8_WAIT_L(0); PG8_MMA(0, 0, At, B0); PG8_BAR; PG8_SCHED;
            PG8_LDB(B1, 0, 1); PG8_STAGE(PG8_SB(0, 0), b2, voffB);
            PG8_BAR; PG8_WAIT_L(0); PG8_MMA(0, 1, At, B1); PG8_BAR;
            PG8_LDA(At, 0, 1); PG8_STAGE(PG8_SA(0, 0), a2, voffA);
            PG8_BAR; PG8_WAIT_L(0); PG8_MMA(1, 0, At, B0); PG8_BAR; PG8_SCHED;
            PG8_STAGE(PG8_SB(0, 1), b2 + hstepB, voffB);
            PG8_WAIT_V(6); PG8_BAR; PG8_MMA(1, 1, At, B1); PG8_BAR;
            PG8_LDB(B0, 1, 0); PG8_SCHED; PG8_LDA(At, 1, 0); PG8_STAGE(PG8_SA(0, 1), a2 + hstepA, voffA);
            PG8_WAIT_L(8); PG8_BAR; PG8_WAIT_L(0); PG8_MMA(0, 0, At, B0); PG8_BAR; PG8_SCHED;
            PG8_LDB(B1, 1, 1); PG8_STAGE(PG8_SB(1, 0), b3, voffB);
            PG8_BAR; PG8_WAIT_L(0); PG8_MMA(0, 1, At, B1); PG8_BAR;
            PG8_LDA(At, 1, 1); PG8_STAGE(PG8_SA(1, 0), a3, voffA);
            PG8_BAR; PG8_WAIT_L(0); PG8_MMA(1, 0, At, B0); PG8_BAR; PG8_SCHED;
            PG8_STAGE(PG8_SB(1, 1), b3 + hstepB, voffB);
            PG8_WAIT_V(6); PG8_BAR; PG8_MMA(1, 1, At, B1); PG8_BAR;
            }
        }
        };
        if constexpr (Epi::HAS_MID) { kloop(0, nt / 2); { int fr_m = fr, fq_m = fq; asm volatile("" : "+v"(fr_m), "+v"(fq_m)); E.mid(acc, cur, wr, wc, fr_m, fq_m); } kloop(nt / 2, nt); }
        else kloop(0, nt);
        if constexpr (FP8) asm volatile("s_nop 7\n\ts_nop 7\n\ts_nop 7" ::: "memory");
        if constexpr (ALIGN_EPI) { if (wr == 0) PG8_BAR; }
        if constexpr (!Epi::AFTER_DRAIN) { int fr_e = fr, fq_e = fq; asm volatile("" : "+v"(fr_e), "+v"(fq_e));
            E(acc, cur, wr, wc, fr_e, fq_e); S.done(cur); }
        if (!has_next) break;
#pragma unroll
        for (int a = 0; a < 2; ++a)
#pragma unroll
            for (int b = 0; b < 2; ++b)
#pragma unroll
                for (int m = 0; m < 4; ++m)
#pragma unroll
                    for (int n = 0; n < 2; ++n) acc[a][b][m][n] = (f32x4){0.f, 0.f, 0.f, 0.f};
        cur = nxt; cA = nA; cB = nB; ++ui;
        if constexpr (ALIGN_EPI) { if (wr == 1) PG8_BAR; }
    }
    PG8_WAIT_V(0);
    if constexpr (!ALIGN_EPI) { if (wr == 0) PG8_BAR; }
    PG8_BAR;
    if constexpr (Epi::AFTER_DRAIN) { E.fused(acc, cur, wr, wc, fr, fq, lds, wid, lane); S.done(cur); }
#undef PG8_SA
#undef PG8_SB
#undef PG8_STAGE
#undef PG8_LDA
#undef PG8_LDB
#undef PG8_MMA
#undef PG8_CAT8
#undef PG8_WAIT_V
#undef PG8_WAIT_L
#undef PG8_BAR
#undef PG8_SCHED
}
}

namespace pg8 {
__device__ __forceinline__ float bf_lo(unsigned w) { return __uint_as_float(w << 16); }
__device__ __forceinline__ float bf_hi(unsigned w) { return __uint_as_float(w & 0xffff0000u); }
__device__ __forceinline__ float sigmoidf_fast(float g) { return __builtin_amdgcn_rcpf(1.0f + __builtin_amdgcn_exp2f(-1.4426950408889634f * g)); }

template <int ACT  > struct EpiStore {
    static constexpr bool PERM = true, AFTER_DRAIN = false, HAS_MID = false;
    bf16_t* O; int ldc;
    __device__ __forceinline__ void operator()(const f32x4 (&acc)[2][2][4][2], const Unit& u, int wr, int wc, int fr, int fq) const {
        const int row0 = u.pm * BM + wr * 64 + fr, col0 = u.pn * BM + wc * 32 + 8 * fq;
#pragma unroll
        for (int ai = 0; ai < 2; ++ai)
#pragma unroll
            for (int m = 0; m < 4; ++m) { bf16_t* rowp = O + (size_t)(row0 + ai * HALF + m * 16) * ldc + col0;
#pragma unroll
                for (int bj = 0; bj < 2; ++bj) { f32x4 v0 = acc[ai][bj][m][0], v1 = acc[ai][bj][m][1];
                    if (ACT == 1) { const f32x4 z = (f32x4){0.f, 0.f, 0.f, 0.f}; v0 = __builtin_elementwise_max(v0, z); v1 = __builtin_elementwise_max(v1, z); v0 = v0 * v0; v1 = v1 * v1; }
                    u32x4 w; w.x = cvt_pk_bf16(v0[0], v0[1]); w.y = cvt_pk_bf16(v0[2], v0[3]); w.z = cvt_pk_bf16(v1[0], v1[1]); w.w = cvt_pk_bf16(v1[2], v1[3]);
                    *(u32x4*)(rowp + bj * HALF) = w; } }
    }
};
typedef unsigned long long ssq_t;
__device__ __forceinline__ ssq_t ssq_fix(float t) { return (ssq_t)(t * 16777216.0f); }
__device__ __forceinline__ float ssq_flt(ssq_t v) { return fmaf((float)(unsigned)(v >> 32), 4294967296.0f, (float)(unsigned)v) * (1.0f / 16777216.0f); }
constexpr int PFB_PAR = 3072;
struct PrefetchOrder : StaticOrder {
    const ssq_t* ssq; const float* shw; int ldw; int row_off; PG8_LAS unsigned char* buf; mutable int cnt;
    __device__ __forceinline__ void a_ready(const Unit& u) const {
        const int par = cnt & 1; ++cnt;
        const int tid = threadIdx.x, wave = __builtin_amdgcn_readfirstlane(tid >> 6), lane = tid & 63;
        if (wave == 0) { __builtin_amdgcn_global_load_lds((const unsigned*)(ssq + u.pm * BM + lane * 2), (PG8_LAS unsigned*)(buf + par * PFB_PAR), 16, 0, 0);
            __builtin_amdgcn_global_load_lds((const unsigned*)(ssq + u.pm * BM + 128 + lane * 2), (PG8_LAS unsigned*)(buf + par * PFB_PAR + 1024), 16, 0, 0); }
        else if (wave == 1) { const int rowg = row_off + u.pm * BM, b = rowg < 32768 ? (rowg >> 11) : 16 + ((rowg - 32768) >> 12);
            __builtin_amdgcn_global_load_lds((const unsigned*)(shw + (size_t)b * ldw + u.pn * BM + lane * 4), (PG8_LAS unsigned*)(buf + par * PFB_PAR + 2048), 16, 0, 0); }
    }
};
struct EpiZ {
    static constexpr bool PERM = true, AFTER_DRAIN = false, HAS_MID = false;
    bf16_t* O; int ldc; const float* qna; const float* kna; const float* qnb; const float* knb; PG8_LAS float* part;
    PG8_LAS unsigned char* buf; mutable int cnt;
    __device__ __forceinline__ void operator()(const f32x4 (&acc)[2][2][4][2], const Unit& u, int wr, int wc, int fr, int fq) const {
        const int row0 = u.pm * BM + wr * 64 + fr, col0 = u.pn * BM + wc * 32 + 8 * fq;
        const float* gain = u.pn < 4 ? qna : (u.pn == 4 ? kna : (u.pn == 5 ? nullptr : (u.pn < 10 ? qnb : (u.pn < 14 ? knb : nullptr))));
        const PG8_LAS ssq_t* pq = (const PG8_LAS ssq_t*)(buf + (cnt & 1) * PFB_PAR); const PG8_LAS float* pv = (const PG8_LAS float*)(buf + (cnt & 1) * PFB_PAR + 2048); ++cnt;
        f32x4 (&A)[2][2][4][2] = const_cast<f32x4 (&)[2][2][4][2]>(acc);
        { float rd[2][4];
#pragma unroll
          for (int ai = 0; ai < 2; ++ai)
#pragma unroll
              for (int m = 0; m < 4; ++m) rd[ai][m] = ssq_flt(pq[wr * 64 + fr + ai * HALF + m * 16]);
#pragma unroll
          for (int ai = 0; ai < 2; ++ai)
#pragma unroll
              for (int m = 0; m < 4; ++m) rd[ai][m] = rsqrtf(rd[ai][m] * (1.f / 2048.f) + 1e-6f) * (1.0f / 64.0f);
#pragma unroll
          for (int bj = 0; bj < 2; ++bj) { const f32x4 s0 = *(const PG8_LAS f32x4*)(pv + wc * 32 + 8 * fq + bj * HALF), s1 = *(const PG8_LAS f32x4*)(pv + wc * 32 + 8 * fq + bj * HALF + 4);
#pragma unroll
              for (int ai = 0; ai < 2; ++ai)
#pragma unroll
                  for (int m = 0; m < 4; ++m) { A[ai][bj][m][0] = A[ai][bj][m][0] * rd[ai][m] + s0; A[ai][bj][m][1] = A[ai][bj][m][1] * rd[ai][m] + s1; } } }
        if (gain != nullptr) {
#pragma unroll
            for (int ai = 0; ai < 2; ++ai)
#pragma unroll
                for (int m = 0; m < 4; ++m)
#pragma unroll
                    for (int bj = 0; bj < 2; ++bj) { const f32x4 a = A[ai][bj][m][0], b = A[ai][bj][m][1];
                        float ss = (a[0] * a[0] + a[1] * a[1]) + (a[2] * a[2] + a[3] * a[3]) + (b[0] * b[0] + b[1] * b[1]) + (b[2] * b[2] + b[3] * b[3]);
                        ss += __shfl_xor(ss, 16); ss += __shfl_xor(ss, 32);
                        if (fq == 0) part[((ai * HALF + wr * 64 + m * 16 + fr) * 2 + bj) * 4 + wc] = ss; }
            asm volatile("s_waitcnt lgkmcnt(0)" ::: "memory"); __builtin_amdgcn_s_barrier(); asm volatile("" ::: "memory");
            const f32x4 g0 = *(const f32x4*)(gain + wc * 32 + 8 * fq), g1 = *(const f32x4*)(gain + wc * 32 + 8 * fq + 4);
#pragma unroll
            for (int ai = 0; ai < 2; ++ai)
#pragma unroll
                for (int m = 0; m < 4; ++m) { bf16_t* rowp = O + (size_t)(row0 + ai * HALF + m * 16) * ldc + col0;
#pragma unroll
                    for (int bj = 0; bj < 2; ++bj) { const f32x4 p = *(const PG8_LAS f32x4*)(part + ((ai * HALF + wr * 64 + m * 16 + fr) * 2 + bj) * 4);
                        const float rs = rsqrtf(((p[0] + p[1]) + (p[2] + p[3])) * (1.f / 128.f) + 1e-6f);
                        const f32x4 v0 = A[ai][bj][m][0] * g0 * rs, v1 = A[ai][bj][m][1] * g1 * rs;
                        u32x4 w; w.x = cvt_pk_bf16(v0[0], v0[1]); w.y = cvt_pk_bf16(v0[2], v0[3]); w.z = cvt_pk_bf16(v1[0], v1[1]); w.w = cvt_pk_bf16(v1[2], v1[3]);
                        *(u32x4*)(rowp + bj * HALF) = w; } }
        } else {
            if (u.pn >= 18) {
                constexpr int GA0 = 4608, GB0 = 6656; const int d0 = (u.pn - 18) * HALF + wc * 32 + 8 * fq;
#pragma unroll
                for (int ai = 0; ai < 2; ++ai)
#pragma unroll
                    for (int m = 0; m < 4; ++m) { bf16_t* rowp = O + (size_t)(row0 + ai * HALF + m * 16) * ldc + d0;
                        f32x4 r0, r1, s0, s1;
#pragma unroll
                        for (int e = 0; e < 4; ++e) {
                            const float ea0 = 1.0f + __builtin_amdgcn_exp2f(-1.4426950408889634f * A[ai][0][m][0][e]), eb0 = 1.0f + __builtin_amdgcn_exp2f(-1.4426950408889634f * A[ai][1][m][0][e]);
                            const float ea1 = 1.0f + __builtin_amdgcn_exp2f(-1.4426950408889634f * A[ai][0][m][1][e]), eb1 = 1.0f + __builtin_amdgcn_exp2f(-1.4426950408889634f * A[ai][1][m][1][e]);
                            r0[e] = eb0 * __builtin_amdgcn_rcpf(ea0); s0[e] = __builtin_amdgcn_rcpf(eb0); r1[e] = eb1 * __builtin_amdgcn_rcpf(ea1); s1[e] = __builtin_amdgcn_rcpf(eb1); }
                        u32x4 w; w.x = cvt_pk_bf16(r0[0], r0[1]); w.y = cvt_pk_bf16(r0[2], r0[3]); w.z = cvt_pk_bf16(r1[0], r1[1]); w.w = cvt_pk_bf16(r1[2], r1[3]);
                        *(u32x4*)(rowp + GA0) = w;
                        w.x = cvt_pk_bf16(s0[0], s0[1]); w.y = cvt_pk_bf16(s0[2], s0[3]); w.z = cvt_pk_bf16(s1[0], s1[1]); w.w = cvt_pk_bf16(s1[2], s1[3]);
                        *(u32x4*)(rowp + GB0) = w; }
            } else {
#pragma unroll
            for (int ai = 0; ai < 2; ++ai)
#pragma unroll
                for (int m = 0; m < 4; ++m) { bf16_t* rowp = O + (size_t)(row0 + ai * HALF + m * 16) * ldc + col0;
#pragma unroll
                    for (int bj = 0; bj < 2; ++bj) { const f32x4 v0 = A[ai][bj][m][0], v1 = A[ai][bj][m][1];
                        u32x4 w; w.x = cvt_pk_bf16(v0[0], v0[1]); w.y = cvt_pk_bf16(v0[2], v0[3]); w.z = cvt_pk_bf16(v1[0], v1[1]); w.w = cvt_pk_bf16(v1[2], v1[3]);
                        *(u32x4*)(rowp + bj * HALF) = w; } }
            }
        }
    }
};
template <int MODE> struct EpiGate {
    static constexpr bool PERM = true, AFTER_DRAIN = false, HAS_MID = false;
    const bf16_t* G; int ldg; const bf16_t* P; bf16_t* O; int ldo;
    __device__ __forceinline__ void operator()(const f32x4 (&acc)[2][2][4][2], const Unit& u, int wr, int wc, int fr, int fq) const {
        const int row0 = u.pm * BM + wr * 64 + fr, col0 = u.pn * BM + wc * 32 + 8 * fq;
#pragma unroll
        for (int ai = 0; ai < 2; ++ai) {
            u32x4 gw[4][2], pw[4][2];
#pragma unroll
            for (int m = 0; m < 4; ++m)
#pragma unroll
                for (int bj = 0; bj < 2; ++bj) { const size_t row = (size_t)(row0 + ai * HALF + m * 16); const int col = col0 + bj * HALF;
                    gw[m][bj] = *(const u32x4*)(G + row * ldg + col); if (MODE == 1) pw[m][bj] = *(const u32x4*)(P + row * ldo + col); }
            asm volatile("" ::: "memory");
#pragma unroll
            for (int m = 0; m < 4; ++m)
#pragma unroll
                for (int bj = 0; bj < 2; ++bj) { const size_t row = (size_t)(row0 + ai * HALF + m * 16); const int col = col0 + bj * HALF; const u32x4 g4 = gw[m][bj];
                    f32x4 v0 = acc[ai][bj][m][0], v1 = acc[ai][bj][m][1];
                    v0[0] *= sigmoidf_fast(bf_lo(g4.x)); v0[1] *= sigmoidf_fast(bf_hi(g4.x)); v0[2] *= sigmoidf_fast(bf_lo(g4.y)); v0[3] *= sigmoidf_fast(bf_hi(g4.y));
                    v1[0] *= sigmoidf_fast(bf_lo(g4.z)); v1[1] *= sigmoidf_fast(bf_hi(g4.z)); v1[2] *= sigmoidf_fast(bf_lo(g4.w)); v1[3] *= sigmoidf_fast(bf_hi(g4.w));
                    if (MODE == 1) { const u32x4 p4 = pw[m][bj];
                        v0[0] += bf_lo(p4.x); v0[1] += bf_hi(p4.x); v0[2] += bf_lo(p4.y); v0[3] += bf_hi(p4.y);
                        v1[0] += bf_lo(p4.z); v1[1] += bf_hi(p4.z); v1[2] += bf_lo(p4.w); v1[3] += bf_hi(p4.w); }
                    u32x4 w; w.x = cvt_pk_bf16(v0[0], v0[1]); w.y = cvt_pk_bf16(v0[2], v0[3]); w.z = cvt_pk_bf16(v1[0], v1[1]); w.w = cvt_pk_bf16(v1[2], v1[3]);
                    *(u32x4*)(O + row * ldo + col) = w; }
            asm volatile("" ::: "memory");
        }
    }
};
template <int LDG, int LDO, bool FP8OUT, bool ACC64 = false> struct EpiGateMid {
    static constexpr bool PERM = true, AFTER_DRAIN = false, HAS_MID = true;
    const bf16_t* GA; const bf16_t* GB; bf16_t* O;
    __device__ __forceinline__ void mid(f32x4 (&acc)[2][2][4][2], const Unit& u, int wr, int wc, int fr, int fq) const {
        asm volatile("" : "+v"(fr), "+v"(fq));
        const unsigned go = (unsigned)((u.pm * BM + wr * 64 + fr) * LDG + u.pn * BM + wc * 32 + 8 * fq);
#pragma unroll
        for (int hb = 0; hb < 4; ++hb) { const int bj = hb >> 1, ai = hb & 1;
            u32x4 ga[4];
#pragma unroll
            for (int m = 0; m < 4; ++m) { const unsigned o = go + (unsigned)((ai * HALF + m * 16) * LDG + bj * HALF); ga[m] = *(const u32x4*)(GA + o); }
            asm volatile("" ::: "memory");
#pragma unroll
            for (int m = 0; m < 4; ++m) {
                f32x4& v0 = acc[ai][bj][m][0]; f32x4& v1 = acc[ai][bj][m][1];
                v0[0] *= bf_lo(ga[m].x); v0[1] *= bf_hi(ga[m].x); v0[2] *= bf_lo(ga[m].y); v0[3] *= bf_hi(ga[m].y);
                v1[0] *= bf_lo(ga[m].z); v1[1] *= bf_hi(ga[m].z); v1[2] *= bf_lo(ga[m].w); v1[3] *= bf_hi(ga[m].w);
                asm volatile("" : "+v"(v0), "+v"(v1)); }
        }
    }
    __device__ __forceinline__ void operator()(const f32x4 (&acc)[2][2][4][2], const Unit& u, int wr, int wc, int fr, int fq) const {
        asm volatile("" : "+v"(fr), "+v"(fq));
        const unsigned go = (unsigned)((u.pm * BM + wr * 64 + fr) * LDG + u.pn * BM + wc * 32 + 8 * fq), oo = (unsigned)((u.pm * BM + wr * 64 + fr) * LDO + u.pn * BM + wc * 32 + 8 * fq);
#pragma unroll
        for (int ai = 0; ai < 2; ++ai) {
            u32x4 gw[4][2];
#pragma unroll
            for (int m = 0; m < 4; ++m)
#pragma unroll
                for (int bj = 0; bj < 2; ++bj) gw[m][bj] = *(const u32x4*)(GB + (go + (unsigned)((ai * HALF + m * 16) * LDG + bj * HALF)));
            asm volatile("" ::: "memory");
#pragma unroll
            for (int m = 0; m < 4; ++m)
#pragma unroll
                for (int bj = 0; bj < 2; ++bj) { const u32x4 g4 = gw[m][bj]; f32x4 v0 = acc[ai][bj][m][0], v1 = acc[ai][bj][m][1];
                    if (ACC64) { v0 = v0 * (1.0f / 64.0f); v1 = v1 * (1.0f / 64.0f); }
                    v0[0] *= bf_lo(g4.x); v0[1] *= bf_hi(g4.x); v0[2] *= bf_lo(g4.y); v0[3] *= bf_hi(g4.y);
                    v1[0] *= bf_lo(g4.z); v1[1] *= bf_hi(g4.z); v1[2] *= bf_lo(g4.w); v1[3] *= bf_hi(g4.w);
                    if constexpr (FP8OUT) { int w0 = 0, w1 = 0; w0 = __builtin_amdgcn_cvt_pk_fp8_f32(v0[0], v0[1], w0, false); w0 = __builtin_amdgcn_cvt_pk_fp8_f32(v0[2], v0[3], w0, true);
                        w1 = __builtin_amdgcn_cvt_pk_fp8_f32(v1[0], v1[1], w1, false); w1 = __builtin_amdgcn_cvt_pk_fp8_f32(v1[2], v1[3], w1, true);
                        typedef int i32x2 __attribute__((ext_vector_type(2))); *(i32x2*)((unsigned char*)O + (oo + (unsigned)((ai * HALF + m * 16) * LDO + bj * HALF))) = (i32x2){w0, w1}; }
                    else { u32x4 w; w.x = cvt_pk_bf16(v0[0], v0[1]); w.y = cvt_pk_bf16(v0[2], v0[3]); w.z = cvt_pk_bf16(v1[0], v1[1]); w.w = cvt_pk_bf16(v1[2], v1[3]);
                    *(u32x4*)(O + (oo + (unsigned)((ai * HALF + m * 16) * LDO + bj * HALF))) = w; } }
            asm volatile("" ::: "memory");
        }
    }
};
struct EpiRes {
    static constexpr bool PERM = false, AFTER_DRAIN = false, HAS_MID = false;
    const float* xp; const float* xs; const float* xb; float* out; const float* modg; int row_off;
    __device__ __forceinline__ void operator()(const f32x4 (&acc)[2][2][4][2], const Unit& u, int wr, int wc, int fr, int fq) const {
        const int rowg = row_off + u.pm * BM;
        const int b = rowg < 32768 ? (rowg >> 11) : 16 + ((rowg - 32768) >> 12);
        const float* gvec = modg + (size_t)b * (6 * 2048);
        const float* base = xp ? (rowg < 32768 ? xp + (size_t)rowg * 2048 : xs + (size_t)(rowg - 32768) * 2048) : xb + (size_t)rowg * 2048;
        float* op = out + (size_t)rowg * 2048;
        const int r0 = wr * 64 + fr, col0 = u.pn * BM + wc * 32 + 4 * fq;
        f32x4 gv[2][2];
#pragma unroll
        for (int bj = 0; bj < 2; ++bj)
#pragma unroll
            for (int n = 0; n < 2; ++n) gv[bj][n] = *(const f32x4*)(gvec + col0 + bj * HALF + n * 16);
#pragma unroll
        for (int ai = 0; ai < 2; ++ai) {
            f32x4 bs[4][2][2];
#pragma unroll
            for (int m = 0; m < 4; ++m)
#pragma unroll
                for (int bj = 0; bj < 2; ++bj)
#pragma unroll
                    for (int n = 0; n < 2; ++n) bs[m][bj][n] = *(const f32x4*)(base + (size_t)(r0 + ai * HALF + m * 16) * 2048 + col0 + bj * HALF + n * 16);
            asm volatile("" ::: "memory");
#pragma unroll
            for (int m = 0; m < 4; ++m)
#pragma unroll
                for (int bj = 0; bj < 2; ++bj)
#pragma unroll
                    for (int n = 0; n < 2; ++n) *(f32x4*)(op + (size_t)(r0 + ai * HALF + m * 16) * 2048 + col0 + bj * HALF + n * 16) = bs[m][bj][n] + gv[bj][n] * acc[ai][bj][m][n];
            asm volatile("" ::: "memory");
        }
    }
};
template <bool ACC64 = false> struct EpiMlp1 {
    static constexpr bool PERM = true, AFTER_DRAIN = false, HAS_MID = false;
    bf16_t* O; int ldc; PG8_LAS unsigned char* buf; mutable int cnt;
    __device__ __forceinline__ void operator()(const f32x4 (&acc)[2][2][4][2], const Unit& u, int wr, int wc, int fr, int fq) const {
        const int row0 = u.pm * BM + wr * 64 + fr, col0 = u.pn * BM + wc * 32 + 8 * fq;
        const PG8_LAS ssq_t* pq = (const PG8_LAS ssq_t*)(buf + (cnt & 1) * PFB_PAR); const PG8_LAS float* pv = (const PG8_LAS float*)(buf + (cnt & 1) * PFB_PAR + 2048); ++cnt;
        f32x4 s0[2], s1[2]; float rs[2][4];
#pragma unroll
        for (int bj = 0; bj < 2; ++bj) { s0[bj] = *(const PG8_LAS f32x4*)(pv + wc * 32 + 8 * fq + bj * HALF); s1[bj] = *(const PG8_LAS f32x4*)(pv + wc * 32 + 8 * fq + bj * HALF + 4); }
#pragma unroll
        for (int ai = 0; ai < 2; ++ai)
#pragma unroll
            for (int m = 0; m < 4; ++m) rs[ai][m] = ssq_flt(pq[wr * 64 + fr + ai * HALF + m * 16]);
#pragma unroll
        for (int ai = 0; ai < 2; ++ai)
#pragma unroll
            for (int m = 0; m < 4; ++m) { const float r = rsqrtf(rs[ai][m] * (1.f / 2048.f) + 1e-6f) * (ACC64 ? (1.0f / 64.0f) : 1.0f); bf16_t* rowp = O + (size_t)(row0 + ai * HALF + m * 16) * ldc + col0;
#pragma unroll
                for (int bj = 0; bj < 2; ++bj) { const f32x4 z = (f32x4){0.f, 0.f, 0.f, 0.f};
                    f32x4 v0 = __builtin_elementwise_max(acc[ai][bj][m][0] * r + s0[bj], z), v1 = __builtin_elementwise_max(acc[ai][bj][m][1] * r + s1[bj], z); v0 = v0 * v0; v1 = v1 * v1;
                    u32x4 w; w.x = cvt_pk_bf16(v0[0], v0[1]); w.y = cvt_pk_bf16(v0[2], v0[3]); w.z = cvt_pk_bf16(v1[0], v1[1]); w.w = cvt_pk_bf16(v1[2], v1[3]);
                    __builtin_nontemporal_store(w, (u32x4*)(rowp + bj * HALF)); } }
    }
};
template <bool FP8OUT> struct EpiRes2 {
    static constexpr bool PERM = false, AFTER_DRAIN = false, HAS_MID = false;
    const float* xp; const float* xs; const float* xb; float* out; const float* modg; int row_off;
    const float* lnw; const float* modsc; bf16_t* XA; float* ssq;
    __device__ __forceinline__ void operator()(const f32x4 (&acc)[2][2][4][2], const Unit& u, int wr, int wc, int fr, int fq) const {
        const int rowg = row_off + u.pm * BM;
        const int b = rowg < 32768 ? (rowg >> 11) : 16 + ((rowg - 32768) >> 12);
        const float* gvec = modg + (size_t)b * (6 * 2048); const float* scv = modsc + (size_t)b * (6 * 2048);
        const float* base = xp ? (rowg < 32768 ? xp + (size_t)rowg * 2048 : xs + (size_t)(rowg - 32768) * 2048) : xb + (size_t)rowg * 2048;
        float* op = out + (size_t)rowg * 2048; bf16_t* xa = FP8OUT ? (bf16_t*)((unsigned char*)XA + (size_t)(u.pm * BM) * 2048) : XA + (size_t)(u.pm * BM) * 2048;
        const int r0 = wr * 64 + fr, col0 = u.pn * BM + wc * 32 + 4 * fq;
        const unsigned rb = (unsigned)(r0 * 2048 + col0);
        float ss[2][4];
#pragma unroll
        for (int ai = 0; ai < 2; ++ai)
#pragma unroll
            for (int m = 0; m < 4; ++m) ss[ai][m] = 0.f;
#pragma unroll
        for (int bn = 0; bn < 4; ++bn) { const int bj = bn >> 1, n = bn & 1, c = col0 + bj * HALF + n * 16;
            const f32x4 gvv = *(const f32x4*)(gvec + c), avv = *(const f32x4*)(lnw + c) * (*(const f32x4*)(scv + c) + 1.0f);
            f32x4 bs[2][4];
#pragma unroll
            for (int ai = 0; ai < 2; ++ai)
#pragma unroll
                for (int m = 0; m < 4; ++m) bs[ai][m] = *(const f32x4*)(base + (rb + (unsigned)((ai * HALF + m * 16) * 2048 + bj * HALF + n * 16)));
            asm volatile("" ::: "memory");
#pragma unroll
            for (int ai = 0; ai < 2; ++ai)
#pragma unroll
                for (int m = 0; m < 4; ++m) { const unsigned ro = rb + (unsigned)((ai * HALF + m * 16) * 2048 + bj * HALF + n * 16); const f32x4 xn = bs[ai][m] + gvv * acc[ai][bj][m][n];
                    *(f32x4*)(op + ro) = xn; ss[ai][m] += (xn[0] * xn[0] + xn[1] * xn[1]) + (xn[2] * xn[2] + xn[3] * xn[3]);
                    const f32x4 y = xn * avv;
                    if constexpr (FP8OUT) { int w8 = 0; w8 = __builtin_amdgcn_cvt_pk_fp8_f32(y[0], y[1], w8, false); w8 = __builtin_amdgcn_cvt_pk_fp8_f32(y[2], y[3], w8, true); *(int*)((unsigned char*)xa + ro) = w8; }
                    else { typedef unsigned u32x2 __attribute__((ext_vector_type(2))); u32x2 w; w.x = cvt_pk_bf16(y[0], y[1]); w.y = cvt_pk_bf16(y[2], y[3]); *(u32x2*)(xa + ro) = w; } }
            asm volatile("" ::: "memory");
        }
#pragma unroll
        for (int ai = 0; ai < 2; ++ai)
#pragma unroll
            for (int m = 0; m < 4; ++m) { float t = ss[ai][m]; t += __shfl_xor(t, 16); t += __shfl_xor(t, 32);
                if (fq == 0) __hip_atomic_fetch_add(ssq + u.pm * BM + r0 + ai * HALF + m * 16, t, __ATOMIC_RELAXED, __HIP_MEMORY_SCOPE_AGENT); }
    }
};
template <int BASEK, int OUTK, int XAK, bool ACC64 = false> struct EpiResid {
    static constexpr bool PERM = true, AFTER_DRAIN = false, HAS_MID = false;
    const float* xp; const float* xs; bf16_t* xb; float* out; const float* modg; int row_off;
    const float* lnw; const float* modsc; void* XA; ssq_t* ssq; PG8_LAS float* part;
    __device__ __forceinline__ void operator()(const f32x4 (&acc)[2][2][4][2], const Unit& u, int wr, int wc, int fr, int fq) const {
        const int rowg = row_off + u.pm * BM;
        const int b = rowg < 32768 ? (rowg >> 11) : 16 + ((rowg - 32768) >> 12);
        const float* gvec = modg + (size_t)b * (6 * 2048); const float* scv = modsc + (size_t)b * (6 * 2048);
        const float* basef = rowg < 32768 ? xp + (size_t)rowg * 2048 : xs + (size_t)(rowg - 32768) * 2048;
        bf16_t* xbt = xb + (size_t)(u.pm * BM) * 2048; float* op = out + (size_t)rowg * 2048;
        const int r0 = wr * 64 + fr, col0 = u.pn * BM + wc * 32 + 8 * fq;
        const unsigned rb = (unsigned)(r0 * 2048 + col0);
        constexpr bool WIDE = (BASEK == 1 && XAK == 0);
        constexpr int NB = WIDE ? 2 : 4, RG = WIDE ? 8 : 4;
        float tsum[2][4];
#pragma unroll
        for (int hb = 0; hb < NB; ++hb) { const int bj = WIDE ? hb : (hb >> 1), ai0 = WIDE ? 0 : (hb & 1), c = col0 + bj * HALF;
            f32x4 g0 = *(const f32x4*)(gvec + c), g1 = *(const f32x4*)(gvec + c + 4);
            if (ACC64) { g0 = g0 * (1.0f / 64.0f); g1 = g1 * (1.0f / 64.0f); }
            f32x4 a0 = g0, a1 = g1;
            if (XAK) { a0 = *(const f32x4*)(lnw + c) * (*(const f32x4*)(scv + c) + 1.0f); a1 = *(const f32x4*)(lnw + c + 4) * (*(const f32x4*)(scv + c + 4) + 1.0f); }
            u32x4 bw[RG]; f32x4 bf0[RG], bf1[RG];
#pragma unroll
            for (int q = 0; q < RG; ++q) { const int ai = ai0 + (q >> 2), m = q & 3; const unsigned ro = rb + (unsigned)((ai * HALF + m * 16) * 2048 + bj * HALF);
                if (BASEK == 1) bw[q] = *(const u32x4*)(xbt + ro); else { bf0[q] = *(const f32x4*)(basef + ro); bf1[q] = *(const f32x4*)(basef + ro + 4); } }
            asm volatile("" ::: "memory");
#pragma unroll
            for (int q = 0; q < RG; ++q) { const int ai = ai0 + (q >> 2), m = q & 3; const unsigned ro = rb + (unsigned)((ai * HALF + m * 16) * 2048 + bj * HALF);
                f32x4 x0, x1;
                if (BASEK == 1) { const u32x4 w = bw[q]; x0 = (f32x4){bf_lo(w.x), bf_hi(w.x), bf_lo(w.y), bf_hi(w.y)}; x1 = (f32x4){bf_lo(w.z), bf_hi(w.z), bf_lo(w.w), bf_hi(w.w)}; }
                else { x0 = bf0[q]; x1 = bf1[q]; }
                x0 += g0 * acc[ai][bj][m][0]; x1 += g1 * acc[ai][bj][m][1];
                if (OUTK == 1) { u32x4 w; w.x = cvt_pk_bf16(x0[0], x0[1]); w.y = cvt_pk_bf16(x0[2], x0[3]); w.z = cvt_pk_bf16(x1[0], x1[1]); w.w = cvt_pk_bf16(x1[2], x1[3]); *(u32x4*)(xbt + ro) = w; }
                else { *(f32x4*)(op + ro) = x0; *(f32x4*)(op + ro + 4) = x1; }
                if (XAK) { float t = ((x0[0] * x0[0] + x0[1] * x0[1]) + (x0[2] * x0[2] + x0[3] * x0[3])) + ((x1[0] * x1[0] + x1[1] * x1[1]) + (x1[2] * x1[2] + x1[3] * x1[3]));
                    const f32x4 y0 = x0 * a0, y1 = x1 * a1;
                    if (XAK == 1) { u32x4 w; w.x = cvt_pk_bf16(y0[0], y0[1]); w.y = cvt_pk_bf16(y0[2], y0[3]); w.z = cvt_pk_bf16(y1[0], y1[1]); w.w = cvt_pk_bf16(y1[2], y1[3]);
                        *(u32x4*)((bf16_t*)XA + (size_t)(u.pm * BM) * 2048 + ro) = w; }
                    else { int w0 = 0, w1 = 0; w0 = __builtin_amdgcn_cvt_pk_fp8_f32(y0[0], y0[1], w0, false); w0 = __builtin_amdgcn_cvt_pk_fp8_f32(y0[2], y0[3], w0, true);
                        w1 = __builtin_amdgcn_cvt_pk_fp8_f32(y1[0], y1[1], w1, false); w1 = __builtin_amdgcn_cvt_pk_fp8_f32(y1[2], y1[3], w1, true);
                        typedef int i32x2 __attribute__((ext_vector_type(2))); *(i32x2*)((unsigned char*)XA + (size_t)(u.pm * BM) * 4096 + ro + (ro & ~2047u)) = (i32x2){w0, w1}; }
                    if (bj == 0) tsum[ai][m] = t;
                    else { t += tsum[ai][m]; t += __shfl_xor(t, 16); t += __shfl_xor(t, 32);
                        if (fq == 0) part[(r0 + ai * HALF + m * 16) * 4 + wc] = t; } } }
            asm volatile("" ::: "memory");
        }
        if (XAK) {
            asm volatile("s_waitcnt lgkmcnt(0)" ::: "memory"); __builtin_amdgcn_s_barrier();
            const int t_ = (wr * 4 + wc) * 64 + fq * 16 + fr;
            if (t_ < 256) { const f32x4 v = *(const PG8_LAS f32x4*)(part + t_ * 4);
                __hip_atomic_fetch_add(ssq + u.pm * BM + t_, ssq_fix((v[0] + v[1]) + (v[2] + v[3])), __ATOMIC_RELAXED, __HIP_MEMORY_SCOPE_AGENT); }
        }
    }
};
}

#ifndef G23_FP8
#define G23_FP8 1
#endif
#ifndef G5_FP8
#define G5_FP8 0
#endif
#ifndef G4_FP8
#define G4_FP8 1
#endif
#ifndef MK_MULTI
#define MK_MULTI 0
#endif
#ifndef PG8_SP2
#define PG8_SP2 true
#endif
#ifndef PG8_ALIGN
#define PG8_ALIGN true
#endif

constexpr int NWAVES = 8;
constexpr int D = 2048, TTOK = 49152, TP = 32768, NSEQ = 20, INC = 8704, DFF = 8192, HD = 128;
constexpr int TC = 24576, NCH = 2, NLAYER = 2;
constexpr float RMS_EPS = 1e-6f, ATT_SCALE = 0.08838834764831845f, LOG2E = 1.4426950408889634f;
constexpr int ZC_QA = 0, ZC_KA = 1024, ZC_VA = 1280, ZC_QB = 1536, ZC_KB = 2560, ZC_VB = 3584, ZC_GA = 4608, ZC_GB = 6656;
static_assert(TTOK == NCH * TC && TC % 256 == 0 && TP % 256 == 0, "chunks");
enum { I_XP = 0, I_XS, I_CP, I_CS, I_WADA, I_BADA, I_LN1, I_LN2, I_WIN, I_QNA, I_KNA, I_QNB, I_KNB, I_SINK, I_RPB, I_WBRA, I_WBRB, I_WOUT, I_W1, I_W2, N_IN };

constexpr size_t MiB = 1u << 20;
constexpr size_t WS_CTL = 0, CTL_ZERO_BYTES = 1 * MiB;
constexpr size_t WS_MOD = 1 * MiB;
constexpr size_t WS_TBLA = 3 * MiB, WS_TBLB = 4 * MiB;
constexpr size_t WS_W = 8 * MiB, W_LAYER = 114 * MiB;
constexpr size_t WO_IN = 0, WO_BR = 34 * MiB, WO_OUT = 42 * MiB, WO_1 = 50 * MiB, WO_2 = 82 * MiB;
constexpr size_t WS_H = WS_W + 2 * W_LAYER;
constexpr size_t WS_Z = WS_H + 96 * MiB;
constexpr size_t WS_O = WS_Z + 408 * MiB;
constexpr size_t WS_MB = WS_O + 48 * MiB;
constexpr size_t WS_SHW = WS_MB + 48 * MiB;
constexpr size_t WS_SSQ = WS_SHW + 3 * MiB;
constexpr size_t WS_XB = WS_SSQ + 2 * MiB;
constexpr size_t WS_END = WS_XB + 96 * MiB;
static_assert(G23_FP8 && G4_FP8, "the 48 MiB O / m buffers assume fp8 attention outputs and fp8 m");
static_assert((size_t)INC * 2048 * 2 == 34 * MiB && (size_t)TC * INC * 2 == 408 * MiB && (size_t)TC * D * 2 == 96 * MiB, "sizes");
constexpr int CW_TMO = 0, CW_BAR = 4096;
constexpr float WIN_SCALE = 64.0f;

constexpr int RING_OFF = 0, RING_BYTES = 133120;
constexpr int LDSCTL_OFF = RING_BYTES, MISC_OFF = LDSCTL_OFF + 320;
constexpr int LDS_BYTES = 149504;
constexpr int PART_OFF = 135168;
constexpr int PFB_OFF = PART_OFF + 8192;
static_assert(MISC_OFF + 128 <= PART_OFF && PFB_OFF + 2 * pg8::PFB_PAR <= LDS_BYTES, "LDS map");

#define GAS __attribute__((address_space(1)))
#define LAS __attribute__((address_space(3)))
typedef unsigned short bf16;
typedef unsigned v4u __attribute__((ext_vector_type(4)));
typedef unsigned v2u __attribute__((ext_vector_type(2)));
typedef float f32x4 __attribute__((ext_vector_type(4)));
typedef GAS unsigned gu32;
#define RLX_AGENT __ATOMIC_RELAXED, __HIP_MEMORY_SCOPE_AGENT
#define LDS_WAIT() asm volatile("s_waitcnt lgkmcnt(0)" ::: "memory")
#define VM_WAIT() asm volatile("s_waitcnt vmcnt(0)" ::: "memory")
__device__ __forceinline__ unsigned f2bf(float f) { unsigned u = __builtin_bit_cast(unsigned, f); return (u + 0x7fffu + ((u >> 16) & 1u)) >> 16; }
__device__ __forceinline__ unsigned pk2(float lo, float hi) { return f2bf(lo) | (f2bf(hi) << 16); }
__device__ __forceinline__ float bflo(unsigned w) { return __uint_as_float(w << 16); }
__device__ __forceinline__ float bfhi(unsigned w) { return __uint_as_float(w & 0xffff0000u); }
__device__ __forceinline__ float wave_sum(float v) {
#pragma unroll
    for (int o = 1; o < 64; o <<= 1) v += __shfl_xor(v, o);
    return v;
}
__device__ __forceinline__ int seq_of(int row) { return row < TP ? (row >> 11) : 16 + ((row - TP) >> 12); }

#define XB_TMO      128
#define XB_XCNT(j)  (256  + 64 * (j))
#define XB_XSUB(j)  (1280 + 64 * (j))
#define XB_XGEN(j)  (2304 + 64 * (j))
#define XB_TOP      3328
#define XB_TOPGEN   3392
#define XCD_BAR_WORDS 3456
#define GB_CNT(g)   (4096 + 64 * (g))
#define GB_GEN(g)   (5120 + 64 * (g))
#define GP_CNT(g, x) (8192  + 64 * ((g) * 16 + (x)))
#define GP_SUB(g, x) (16384 + 64 * ((g) * 16 + (x)))
#define XB_SPIN_CAP (1u << 18)

__device__ __forceinline__ unsigned xb_ld(unsigned* p)              { return __hip_atomic_load(p, __ATOMIC_RELAXED, __HIP_MEMORY_SCOPE_AGENT); }
__device__ __forceinline__ unsigned xb_add(unsigned* p, unsigned v) { return __hip_atomic_fetch_add(p, v, __ATOMIC_RELAXED, __HIP_MEMORY_SCOPE_AGENT); }
__device__ __forceinline__ unsigned xb_xcc_id() { return (unsigned)__builtin_amdgcn_s_getreg((3 << 11) | 20) & 0xFu; }
#define XB_SPIN(cond, bar) do { unsigned _sp = 0; while (cond) { __builtin_amdgcn_s_sleep(1); \
    if ((++_sp & 255u) == 0u) { if (xb_ld(&(bar)[XB_TMO])) break; if (_sp > XB_SPIN_CAP) { atomicAdd(&(bar)[XB_TMO], 1u); break; } } } } while (0)

struct XcdBarrier {
    unsigned* bar; unsigned x;
    volatile LAS unsigned* st;
};

__device__ __forceinline__ XcdBarrier xcd_barrier_post(unsigned* bar, volatile LAS unsigned* st) {
    XcdBarrier b; b.bar = bar; b.x = xb_xcc_id(); b.st = st;
    if (threadIdx.x == 0) { (void)xb_add(&bar[XB_XCNT(b.x)], 1u); (void)xb_add(&bar[GP_CNT(blockIdx.x & 7u, b.x)], 1u); }
    return b;
}
__device__ __forceinline__ void xcd_barrier_complete(unsigned* bar, unsigned x, unsigned& nloc, unsigned& nx) {
    const unsigned G = gridDim.x * gridDim.y * gridDim.z;
    unsigned sum, cnt, mine, sp = 0u;
    for (;;) {
        sum = 0u; cnt = 0u; mine = 0u;
#pragma unroll
        for (unsigned j = 0; j < 16; ++j) { const unsigned c = xb_ld(&bar[XB_XCNT(j)]); sum += c; cnt += (c > 0u) ? 1u : 0u; mine = (j == x) ? c : mine; }
        if (sum == G) break;
        __builtin_amdgcn_s_sleep(1);
        if ((++sp & 255u) == 0u) { if (xb_ld(&bar[XB_TMO])) break; if (sp > XB_SPIN_CAP) { atomicAdd(&bar[XB_TMO], 1u); break; } }
    }
    nloc = mine > 0u ? mine : 1u; nx = cnt > 0u ? cnt : 1u;
}

__device__ __forceinline__ void xcd_barrier(const XcdBarrier& b) {
    asm volatile("s_waitcnt vmcnt(0)" ::: "memory");
    __syncthreads();
    if (threadIdx.x == 0) {
        unsigned* bar = b.bar;
        __builtin_amdgcn_s_waitcnt(0);
        unsigned nloc = b.st[0], nx = b.st[1];
        if (nloc == 0u) { xcd_barrier_complete(bar, b.x, nloc, nx); b.st[0] = nloc; b.st[1] = nx; }
        const unsigned old = xb_add(&bar[XB_XSUB(b.x)], 1u);
        const unsigned gen = old / nloc;
        if (old + 1u == (gen + 1u) * nloc) {
            __builtin_amdgcn_fence(__ATOMIC_RELEASE, "agent");
            asm volatile("s_waitcnt vmcnt(0)" ::: "memory");
            const unsigned og = xb_add(&bar[XB_TOP], 1u);
            const unsigned tg = og / nx;
            if (og + 1u == (tg + 1u) * nx) xb_add(&bar[XB_TOPGEN], 1u);
            else XB_SPIN(xb_ld(&bar[XB_TOPGEN]) == tg, bar);
            __builtin_amdgcn_fence(__ATOMIC_ACQUIRE, "agent");
            xb_add(&bar[XB_XGEN(b.x)], 1u);
            asm volatile("s_waitcnt vmcnt(0)" ::: "memory");
        } else {
            XB_SPIN(xb_ld(&bar[XB_XGEN(b.x)]) == gen, bar);
            __builtin_amdgcn_fence(__ATOMIC_ACQUIRE, "agent");
            asm volatile("s_waitcnt vmcnt(0)" ::: "memory");
        }
    }
    __syncthreads();
}

__device__ __forceinline__ void grp_barrier(const XcdBarrier& b, const unsigned g, const bool nb = false, const unsigned lag = 0u) {
    asm volatile("s_waitcnt vmcnt(0)" ::: "memory");
    __syncthreads();
    if (threadIdx.x == 0) {
        unsigned* bar = b.bar;
        __builtin_amdgcn_s_waitcnt(0);
        unsigned nloc = b.st[2], npair = b.st[3];
        if (nloc == 0u) { npair = 0u;
#pragma unroll
            for (unsigned j = 0; j < 16; ++j) { const unsigned c = xb_ld(&bar[GP_CNT(g, j)]); npair += (c > 0u) ? 1u : 0u; nloc = (j == b.x) ? c : nloc; }
            nloc = nloc > 0u ? nloc : 1u; npair = npair > 0u ? npair : 1u; b.st[2] = nloc; b.st[3] = npair; }
        const unsigned old = xb_add(&bar[GP_SUB(g, b.x)], 1u);
        const unsigned gen = old / nloc;
        if (old + 1u == (gen + 1u) * nloc) {
            __builtin_amdgcn_fence(__ATOMIC_RELEASE, "agent");
            asm volatile("s_waitcnt vmcnt(0)" ::: "memory");
            if (npair == 1u) xb_add(&bar[GB_GEN(g)], 1u);
            else { const unsigned og = xb_add(&bar[GB_CNT(g)], 1u);
                if (og + 1u == (gen + 1u) * npair) xb_add(&bar[GB_GEN(g)], 1u); }
        }
        XB_SPIN(xb_ld(&bar[GB_GEN(g)]) == gen, bar);
        if (nb) { if (g > 0u) XB_SPIN((int)(xb_ld(&bar[GB_GEN(g - 1u)]) - (gen + 1u - lag)) < 0, bar);
                  if (g < 7u) XB_SPIN((int)(xb_ld(&bar[GB_GEN(g + 1u)]) - (gen + 1u - lag)) < 0, bar); }
        __builtin_amdgcn_fence(__ATOMIC_ACQUIRE, "agent");
        asm volatile("s_waitcnt vmcnt(0)" ::: "memory");
    }
    __syncthreads();
}


struct Args { const float* in[N_IN]; float* out; unsigned char* ws; };
struct Frame {
    LAS unsigned char* lds;
    int tid, lane, wave, G, gw, ngw;
    const __attribute__((address_space(4))) Args* ap;
    __device__ __forceinline__ const __attribute__((address_space(4))) Args* args() const { const __attribute__((address_space(4))) Args* p = ap; asm volatile("" : "+s"(p)); return p; }
    __device__ __forceinline__ const float* in(int i) const { return args()->in[i]; }
    __device__ __forceinline__ float* out() const { return args()->out; }
    __device__ __forceinline__ unsigned char* ws() const { return args()->ws; }
    __device__ __forceinline__ float* mod() const { return (float*)(ws() + WS_MOD); }
    __device__ __forceinline__ float* shwin() const { return (float*)(ws() + WS_SHW); }
    __device__ __forceinline__ float* shw1() const { return (float*)(ws() + WS_SHW) + (size_t)NLAYER * NSEQ * INC; }
    __device__ __forceinline__ pg8::ssq_t* ssq() const { return (pg8::ssq_t*)(ws() + WS_SSQ); }
};

static_assert(ZC_GA == 4608 && ZC_GB == 6656 && INC == 8704, "EpiZ's gate branch and win_src_col assume this column layout of z");
__device__ __forceinline__ int win_src_col(const int np) { if (np < ZC_GA) return np; const int t = (np - ZC_GA) >> 7, o = (np - ZC_GA) & 127; return ZC_GA + (t & 1) * 2048 + (t >> 1) * 128 + o; }
__device__ __forceinline__ void transpose_item(const float* W, int N, bf16* WT, int ldT, int koff, LAS float* scr, int item, int lane) {
    const int nblk = N / 32, kb = item / nblk, nb = item - kb * nblk, k0 = 64 * kb, n0 = 32 * nb;
    float tv[32];
#pragma unroll
    for (int i = 0; i < 32; ++i) tv[i] = W[(size_t)(k0 + 2 * i + (lane >> 5)) * N + n0 + (lane & 31)];
#pragma unroll
    for (int i = 0; i < 32; ++i) scr[(2 * i + (lane >> 5)) * 33 + (lane & 31)] = tv[i];
    LDS_WAIT(); asm volatile("" ::: "memory");
    const int c = lane & 7;
#pragma unroll
    for (int j = 0; j < 4; ++j) { const int n = (lane >> 3) + 8 * j; const LAS float* s = scr + (8 * c) * 33 + n;
        v4u o; o.x = pk2(s[0 * 33], s[1 * 33]); o.y = pk2(s[2 * 33], s[3 * 33]); o.z = pk2(s[4 * 33], s[5 * 33]); o.w = pk2(s[6 * 33], s[7 * 33]);
        *(GAS v4u*)(WT + (size_t)(n0 + n) * ldT + koff + k0 + 8 * c) = o; }
    LDS_WAIT(); asm volatile("" ::: "memory");
}

__device__ __forceinline__ unsigned pk4_fp8(float a, float b, float c, float d) { int w = 0; w = __builtin_amdgcn_cvt_pk_fp8_f32(a, b, w, false); w = __builtin_amdgcn_cvt_pk_fp8_f32(c, d, w, true); return (unsigned)w; }
template <bool WINPERM = false> __device__ __forceinline__ void transpose_item_fp8(const float* W, int N, unsigned char* WT, int ldT, float scale, LAS float* scr, int item, int lane) {
    const int nblk = N / 32, kb = item / nblk, nb = item - kb * nblk, k0 = 64 * kb, n0 = 32 * nb, ns = WINPERM ? win_src_col(n0) : n0;
    float tv[32];
#pragma unroll
    for (int i = 0; i < 32; ++i) tv[i] = W[(size_t)(k0 + 2 * i + (lane >> 5)) * N + ns + (lane & 31)];
#pragma unroll
    for (int i = 0; i < 32; ++i) scr[(2 * i + (lane >> 5)) * 33 + (lane & 31)] = tv[i];
    LDS_WAIT(); asm volatile("" ::: "memory");
    const int c = lane & 7;
#pragma unroll
    for (int j = 0; j < 4; ++j) { const int n = (lane >> 3) + 8 * j; const LAS float* s = scr + (8 * c) * 33 + n;
        v2u o; o.x = pk4_fp8(s[0 * 33] * scale, s[1 * 33] * scale, s[2 * 33] * scale, s[3 * 33] * scale); o.y = pk4_fp8(s[4 * 33] * scale, s[5 * 33] * scale, s[6 * 33] * scale, s[7 * 33] * scale);
        *(GAS v2u*)(WT + (size_t)(n0 + n) * ldT + k0 + 8 * c) = o; }
    LDS_WAIT(); asm volatile("" ::: "memory");
}
__device__ __forceinline__ void p0_weights(Frame& F) {
    LAS float* scr = (LAS float*)(F.lds + RING_OFF + F.wave * 16384);
    constexpr int I_IN = (D / 64) * (INC / 32), I_BR = (1024 / 64) * (D / 32), I_OUT = (D / 64) * (D / 32), I_1 = (D / 64) * (DFF / 32), I_2 = (DFF / 64) * (D / 32);
    constexpr int PER_LAYER = I_IN + 2 * I_BR + I_OUT + I_1 + I_2;
    for (int it = F.gw; it < NLAYER * PER_LAYER; it += F.ngw) {
        const int l = it / PER_LAYER; int r = it - l * PER_LAYER;
        unsigned char* wl = F.ws() + WS_W + (size_t)l * W_LAYER;
        if (r < I_IN) { transpose_item_fp8<true>(F.in(I_WIN) + (size_t)l * D * INC, INC, wl + WO_IN, D, WIN_SCALE, scr, r, F.lane); continue; } r -= I_IN;
#if G23_FP8
        if (r < I_BR) { transpose_item_fp8(F.in(I_WBRA) + (size_t)l * 1024 * D, D, wl + WO_BR, 2048, WIN_SCALE, scr, r, F.lane); continue; } r -= I_BR;
        if (r < I_BR) { transpose_item_fp8(F.in(I_WBRB) + (size_t)l * 1024 * D, D, wl + WO_BR + 1024, 2048, WIN_SCALE, scr, r, F.lane); continue; } r -= I_BR;
#else
        if (r < I_BR) { transpose_item(F.in(I_WBRA) + (size_t)l * 1024 * D, D, (bf16*)(wl + WO_BR), 2048, 0, scr, r, F.lane); continue; } r -= I_BR;
        if (r < I_BR) { transpose_item(F.in(I_WBRB) + (size_t)l * 1024 * D, D, (bf16*)(wl + WO_BR), 2048, 1024, scr, r, F.lane); continue; } r -= I_BR;
#endif
#if G4_FP8
        if (r < I_OUT) { transpose_item_fp8(F.in(I_WOUT) + (size_t)l * D * D, D, wl + WO_OUT, D, WIN_SCALE, scr, r, F.lane); continue; } r -= I_OUT;
#else
        if (r < I_OUT) { transpose_item(F.in(I_WOUT) + (size_t)l * D * D, D, (bf16*)(wl + WO_OUT), D, 0, scr, r, F.lane); continue; } r -= I_OUT;
#endif
#if G5_FP8
        if (r < I_1) { transpose_item_fp8(F.in(I_W1) + (size_t)l * D * DFF, DFF, wl + WO_1, D, WIN_SCALE, scr, r, F.lane); continue; } r -= I_1;
#else
        if (r < I_1) { transpose_item(F.in(I_W1) + (size_t)l * D * DFF, DFF, (bf16*)(wl + WO_1), D, 0, scr, r, F.lane); continue; } r -= I_1;
#endif
        transpose_item(F.in(I_W2) + (size_t)l * DFF * D, D, (bf16*)(wl + WO_2), DFF, 0, scr, r, F.lane);
    }
}

template <bool SILU, bool WINPERM = false> __device__ __forceinline__ void gemv20_task(Frame& F, const float* W, const int ldw, const int n0, const float* vA, const int vsA, const float* vB, const int vsB,
                                                                 float* out, const int ldo, const float* bias) {
    LAS float* scr = (LAS float*)(F.lds + RING_OFF + F.wave * 2048);
    LAS f32x4* red = (LAS f32x4*)(F.lds + RING_OFF + 16384);
    const float* Wc = W + (WINPERM ? win_src_col(n0 + 4 * F.lane) : n0 + 4 * F.lane);
    f32x4 acc[NSEQ];
#pragma unroll
    for (int b = 0; b < NSEQ; ++b) acc[b] = (f32x4){0.f, 0.f, 0.f, 0.f};
    for (int kc = 0; kc < 16; ++kc) {
        const int k0 = F.wave * 256 + kc * 16;
        if (F.lane < 16) {
#pragma unroll
            for (int b = 0; b < NSEQ; ++b) { const float cv = (b < 16) ? vA[(size_t)b * vsA + k0 + F.lane] : vB[(size_t)(b - 16) * vsB + k0 + F.lane];
                scr[F.lane * NSEQ + b] = SILU ? cv / (1.0f + __expf(-cv)) : cv; }
        }
        f32x4 w[16];
#pragma unroll
        for (int kk = 0; kk < 16; ++kk) w[kk] = *(const f32x4*)(Wc + (size_t)(k0 + kk) * ldw);
        LDS_WAIT(); asm volatile("" ::: "memory");
#pragma unroll
        for (int kk = 0; kk < 16; ++kk) {
#pragma unroll
            for (int b = 0; b < NSEQ; ++b) acc[b] += w[kk] * scr[kk * NSEQ + b]; }
        LDS_WAIT(); asm volatile("" ::: "memory");
    }
#pragma unroll
    for (int hb = 0; hb < 2; ++hb) {
#pragma unroll
        for (int b = 0; b < 10; ++b) red[(F.wave * 10 + b) * 64 + F.lane] = acc[hb * 10 + b];
        __syncthreads();
        for (int idx = F.tid; idx < 10 * 64; idx += NWAVES * 64) { const int b = idx >> 6, ln = idx & 63; f32x4 sum = (f32x4){0.f, 0.f, 0.f, 0.f};
#pragma unroll
            for (int w8 = 0; w8 < NWAVES; ++w8) sum += red[(w8 * 10 + b) * 64 + ln];
            if (bias) sum += *(const f32x4*)(bias + n0 + 4 * ln);
            *(f32x4*)(out + (size_t)(hb * 10 + b) * ldo + n0 + 4 * ln) = sum; }
        __syncthreads();
    }
}
__device__ __forceinline__ void p0_mod(Frame& F) {
    for (int task = blockIdx.x; task < NLAYER * 48; task += F.G) { const int l = task / 48, n0 = (task - l * 48) * 256;
        gemv20_task<true>(F, F.in(I_WADA) + (size_t)l * D * 12288, 12288, n0, F.in(I_CP), D, F.in(I_CS), D, F.mod() + (size_t)l * NSEQ * 12288, 12288, F.in(I_BADA) + l * 12288); }
}
__device__ __forceinline__ void p0_shw(Frame& F) {
    constexpr int T_IN = INC / 256, T_1 = DFF / 256;
    for (int task = blockIdx.x; task < NLAYER * (T_IN + T_1); task += F.G) { const int l = task / (T_IN + T_1), r = task - l * (T_IN + T_1);
        const float* m0 = F.mod() + (size_t)l * NSEQ * 12288;
        if (r < T_IN) gemv20_task<false, true>(F, F.in(I_WIN) + (size_t)l * D * INC, INC, r * 256, m0, 12288, m0 + 16 * 12288, 12288, F.shwin() + (size_t)l * NSEQ * INC, INC, nullptr);
        else gemv20_task<false>(F, F.in(I_W1) + (size_t)l * D * DFF, DFF, (r - T_IN) * 256, m0 + 3 * D, 12288, m0 + 16 * 12288 + 3 * D, 12288, F.shw1() + (size_t)l * NSEQ * DFF, DFF, nullptr); }
}
__device__ __forceinline__ void norm0_phase(Frame& F, const int c0, pg8::ssq_t* ssq) {
    int lane = F.lane; asm volatile("" : "+v"(lane));
    bf16* H = (bf16*)(F.ws() + WS_H);
    const float* lnw = F.in(I_LN1);
    const bool grp = (F.G & 7) == 0; const int ng = F.G >> 3;
    const int t_beg = grp ? ((int)blockIdx.x & 7) * (TC / 8) + ((int)blockIdx.x >> 3) * NWAVES + F.wave : F.gw, t_end = grp ? (((int)blockIdx.x & 7) + 1) * (TC / 8) : TC, t_inc = grp ? ng * NWAVES : F.ngw;
    auto xrow_of = [&](const int tl) -> const GAS f32x4* { const int row = c0 + tl; const float* xrow = row < TP ? F.in(I_XP) + (size_t)row * D : F.in(I_XS) + (size_t)(row - TP) * D; return (const GAS f32x4*)xrow + lane; };
    f32x4 v[8], nv[8];
    if (t_beg < t_end) { const GAS f32x4* xr = xrow_of(t_beg);
#pragma unroll
        for (int j = 0; j < 8; ++j) v[j] = xr[64 * j]; }
    for (int tl = t_beg; tl < t_end; tl += t_inc) {
        const int row = c0 + tl, b = seq_of(row);
        const float* sc = F.mod() + ((size_t)b * 6 + 1) * D;
        if (tl + t_inc < t_end) { const GAS f32x4* xn = xrow_of(tl + t_inc);
#pragma unroll
            for (int j = 0; j < 8; ++j) nv[j] = xn[64 * j]; }
        asm volatile("" ::: "memory");
        float ss = 0.f;
#pragma unroll
        for (int j = 0; j < 8; ++j) ss += (v[j].x * v[j].x + v[j].y * v[j].y) + (v[j].z * v[j].z + v[j].w * v[j].w);
        ss = wave_sum(ss);
        if (lane == 0) ssq[tl] = pg8::ssq_fix(ss);
        GAS unsigned* o4 = (GAS unsigned*)((unsigned char*)H + (size_t)tl * (2 * D)) + lane;
#pragma unroll
        for (int j = 0; j < 8; ++j) { const int col = 4 * lane + 256 * j;
            const f32x4 y = v[j] * (*(const f32x4*)(lnw + col)) * (*(const f32x4*)(sc + col) + 1.0f);
            o4[64 * j] = pk4_fp8(y.x, y.y, y.z, y.w); }
        asm volatile("" ::: "memory");
#pragma unroll
        for (int j = 0; j < 8; ++j) v[j] = nv[j];
    }
}

namespace att {
typedef short bf16x8 __attribute__((ext_vector_type(8)));
typedef short s16x4 __attribute__((ext_vector_type(4)));
typedef float f32x16 __attribute__((ext_vector_type(16)));
typedef float f32x4 __attribute__((ext_vector_type(4)));
typedef unsigned u32x4 __attribute__((ext_vector_type(4)));
constexpr int SHM_V = 64 * 128 * 2, SHM_K = 64 * 128 * 2;
constexpr int OFF_V = 0, OFF_K = 2 * SHM_V, OFF_WS = 2 * SHM_V + 2 * SHM_K, ATT_LDS = OFF_WS + 8 * 64 * 4;
constexpr float THR_L2 = 11.5f;
#define ATT_KSWZ(row, colB) ((row) * 256 + ((colB) ^ (((row) & 7) << 4)))
#define ATT_SBAR() __builtin_amdgcn_sched_barrier(0)
__device__ __forceinline__ int crow(int r, int hi) { return (r & 3) + 8 * (r >> 2) + 4 * hi; }
__device__ __forceinline__ unsigned cvtpk(float lo, float hi) { unsigned r; asm volatile("v_cvt_pk_bf16_f32 %0, %1, %2" : "=v"(r) : "v"(lo), "v"(hi)); return r; }
__device__ __forceinline__ void qkt(f32x16& p0, f32x16& p1, const LAS unsigned char* Ks, const bf16x8 (&qr)[8], int r32, int hi) {
#pragma unroll
    for (int d0 = 0; d0 < 8; ++d0) { const int cb = (d0 * 16 + hi * 8) * 2;
        const bf16x8 b0 = *(const LAS bf16x8*)(Ks + ATT_KSWZ(r32, cb));
        const bf16x8 b1 = *(const LAS bf16x8*)(Ks + ATT_KSWZ(32 + r32, cb));
        p0 = __builtin_amdgcn_mfma_f32_32x32x16_bf16(b0, qr[d0], p0, 0, 0, 0);
        p1 = __builtin_amdgcn_mfma_f32_32x32x16_bf16(b1, qr[d0], p1, 0, 0, 0); }
}
__device__ __forceinline__ int v_st(int k, int c) { const int kk = (k & ~0xC) | ((k & 4) << 1) | ((k & 8) >> 1); return ((kk >> 3) * 4 + (c >> 5)) * 512 + ((kk & 7) * 32 + (c & 31)) * 2; }
__device__ __forceinline__ int v_rd_base(int lane) { return ((lane & 3) << 3) | (((lane >> 2) & 3) << 6) | (((lane >> 4) & 1) << 5) | (((lane >> 5) & 1) << 8); }
constexpr int v_rd_off(int d0, int ks, int half) { return d0 * 512 + ks * 4096 + half * 2048; }
template <int OFF> __device__ __forceinline__ s16x4 tr_read(int vb) { s16x4 r; asm volatile("ds_read_b64_tr_b16 %0, %1 offset:%2" : "=&v"(r) : "v"(vb), "i"(OFF) : "memory"); return r; }
template <int D0> __device__ __forceinline__ void pv_one(f32x16& od, int vb, bf16x8 pa0, bf16x8 pa1, bf16x8 pa2, bf16x8 pa3) {
    const s16x4 l0 = tr_read<v_rd_off(D0, 0, 0)>(vb), h0 = tr_read<v_rd_off(D0, 0, 1)>(vb), l1 = tr_read<v_rd_off(D0, 1, 0)>(vb), h1 = tr_read<v_rd_off(D0, 1, 1)>(vb);
    const s16x4 l2 = tr_read<v_rd_off(D0, 2, 0)>(vb), h2 = tr_read<v_rd_off(D0, 2, 1)>(vb), l3 = tr_read<v_rd_off(D0, 3, 0)>(vb), h3 = tr_read<v_rd_off(D0, 3, 1)>(vb);
    asm volatile("s_waitcnt lgkmcnt(0)" ::: "memory"); ATT_SBAR();
#define ATT_PK(L, H) (bf16x8){L[0], L[1], L[2], L[3], H[0], H[1], H[2], H[3]}
    od = __builtin_amdgcn_mfma_f32_32x32x16_bf16(pa0, ATT_PK(l0, h0), od, 0, 0, 0);
    od = __builtin_amdgcn_mfma_f32_32x32x16_bf16(pa1, ATT_PK(l1, h1), od, 0, 0, 0);
    od = __builtin_amdgcn_mfma_f32_32x32x16_bf16(pa2, ATT_PK(l2, h2), od, 0, 0, 0);
    od = __builtin_amdgcn_mfma_f32_32x32x16_bf16(pa3, ATT_PK(l3, h3), od, 0, 0, 0);
#undef ATT_PK
}
__device__ __forceinline__ void pv_d0(f32x16 (&o)[4], int vb, bf16x8 pa0, bf16x8 pa1, bf16x8 pa2, bf16x8 pa3) {
    pv_one<0>(o[0], vb, pa0, pa1, pa2, pa3); pv_one<1>(o[1], vb, pa0, pa1, pa2, pa3); pv_one<2>(o[2], vb, pa0, pa1, pa2, pa3); pv_one<3>(o[3], vb, pa0, pa1, pa2, pa3);
}
__device__ __forceinline__ float swap_max(float v) { auto rr = __builtin_amdgcn_permlane32_swap(__float_as_uint(v), __float_as_uint(v), false, false); return fmaxf(__uint_as_float(rr[0]), __uint_as_float(rr[1])); }
__device__ __forceinline__ float swap_add(float v) { auto rr = __builtin_amdgcn_permlane32_swap(__float_as_uint(v), __float_as_uint(v), false, false); return __uint_as_float(rr[0]) + __uint_as_float(rr[1]); }
__device__ __forceinline__ bf16x8 knorm8(bf16x8 raw, const float (&g)[8]) {
    const u32x4 w = __builtin_bit_cast(u32x4, raw);
    float f[8] = {__uint_as_float(w.x << 16), __uint_as_float(w.x & 0xffff0000u), __uint_as_float(w.y << 16), __uint_as_float(w.y & 0xffff0000u),
                  __uint_as_float(w.z << 16), __uint_as_float(w.z & 0xffff0000u), __uint_as_float(w.w << 16), __uint_as_float(w.w & 0xffff0000u)};
    float ss = 0.f;
#pragma unroll
    for (int i = 0; i < 8; ++i) ss = fmaf(f[i], f[i], ss);
    ss += __shfl_xor(ss, 1); ss += __shfl_xor(ss, 2); ss += __shfl_xor(ss, 4); ss += __shfl_xor(ss, 8);
    const float rs = rsqrtf(ss * (1.f / 128.f) + 1e-6f);
    u32x4 o; o.x = cvtpk(f[0] * rs * g[0], f[1] * rs * g[1]); o.y = cvtpk(f[2] * rs * g[2], f[3] * rs * g[3]); o.z = cvtpk(f[4] * rs * g[4], f[5] * rs * g[5]); o.w = cvtpk(f[6] * rs * g[6], f[7] * rs * g[7]);
    return __builtin_bit_cast(bf16x8, o);
}

constexpr int OFF_T = 2 * SHM_V + 2 * SHM_K, OFF_WS2 = OFF_T + 8 * 8192, ATT_LDS2 = OFF_WS2 + 8 * 256;
__device__ __forceinline__ void glds16(const void* g, LAS unsigned char* l) { __builtin_amdgcn_global_load_lds((const unsigned*)g, (LAS unsigned*)l, 16, 0, 0); }
template <int LDZ, int LDO, class TblFn>
__device__ __forceinline__ void attn_unit(const bf16* __restrict__ Zq, const bf16* __restrict__ Zk, const bf16* __restrict__ Zv, bf16* __restrict__ Ob, const int NT,
                                          const TblFn& tbl, const float sink_l2, LAS unsigned char* lds, const int tid_in) {
    int tid = tid_in; asm volatile("" : "+v"(tid));
    const int wid = __builtin_amdgcn_readfirstlane(tid >> 6), lane = tid & 63, r32 = lane & 31, hi = lane >> 5;
    LAS unsigned char* V_lds = lds + OFF_V; LAS unsigned char* K_lds = lds + OFF_K; LAS unsigned char* T_lds = lds + OFF_T + wid * 8192;
    LAS float* wsf = (LAS float*)(lds + OFF_WS2) + wid * 64; LAS float* li_l = wsf; LAS float* al_l = wsf + 32;
    const LAS float* li_h = li_l + 4 * hi; const LAS float* al_h = al_l + 4 * hi;
    constexpr float C = 0.08838834764831845f * 1.4426950408889634f;
    float m_reg = -1e30f, l_reg = 0.f; f32x16 o[4] = {}; bf16x8 qr[8];
    { const bf16* Qw = Zq + (size_t)r32 * LDZ + hi * 8;
#pragma unroll
      for (int d0 = 0; d0 < 8; ++d0) qr[d0] = *(const bf16x8*)(Qw + d0 * 16); }
    unsigned kof[2], vof[2];
#pragma unroll
    for (int i = 0; i < 2; ++i) { const int p = (wid * 2 + i) * 64 + lane;
        { const int row = p >> 4, ch = (p & 15) ^ (row & 7); kof[i] = (unsigned)(row * LDZ + ch * 8); }
        { const int sub = p >> 5, g = p & 31, kk = (sub >> 2) * 8 + (g >> 2), c = (sub & 3) * 32 + (g & 3) * 8, k = (kk & ~0xC) | ((kk & 4) << 1) | ((kk & 8) >> 1);
          vof[i] = (unsigned)(k * LDZ + c); } }
    const int vb0 = (int)(unsigned)(uintptr_t)V_lds + v_rd_base(lane);
#define ATT_STAGE(t, b) do { const bf16* _k = Zk + (size_t)(t) * 64 * LDZ; const bf16* _v = Zv + (size_t)(t) * 64 * LDZ; \
        glds16(_k + kof[0], K_lds + (b) * SHM_K + (wid * 2) * 1024); glds16(_k + kof[1], K_lds + (b) * SHM_K + (wid * 2 + 1) * 1024); \
        glds16(_v + vof[0], V_lds + (b) * SHM_V + (wid * 2) * 1024); glds16(_v + vof[1], V_lds + (b) * SHM_V + (wid * 2 + 1) * 1024); } while (0)
#define ATT_TSTAGE(tp_) do { _Pragma("unroll") for (int i = 0; i < 8; ++i) glds16((tp_) + (i * 64 + lane) * 4, T_lds + i * 1024); } while (0)
    const float* tp = tbl(0);
    ATT_STAGE(0, 0); if (tp != nullptr) ATT_TSTAGE(tp);
    asm volatile("s_waitcnt vmcnt(0)" ::: "memory"); __syncthreads();
    for (int j = 0; j < NT; ++j) {
        const int b = j & 1;
        if (j + 1 < NT) ATT_STAGE(j + 1, b ^ 1);
        const float* tpn = (j + 1 < NT) ? tbl(j + 1) : nullptr;
        if (tp != nullptr) {
            f32x16 p0, p1;
#pragma unroll
            for (int i = 0; i < 4; ++i) { const f32x4 a = *(const LAS f32x4*)(T_lds + (i * 64 + lane) * 16), c4 = *(const LAS f32x4*)(T_lds + ((4 + i) * 64 + lane) * 16);
                p0[4 * i + 0] = a.x; p0[4 * i + 1] = a.y; p0[4 * i + 2] = a.z; p0[4 * i + 3] = a.w; p1[4 * i + 0] = c4.x; p1[4 * i + 1] = c4.y; p1[4 * i + 2] = c4.z; p1[4 * i + 3] = c4.w; }
            asm volatile("s_waitcnt lgkmcnt(0)" ::: "memory");
            if (tpn != nullptr) ATT_TSTAGE(tpn);
            qkt(p0, p1, K_lds + b * SHM_K, qr, r32, hi);
            float pmax = p0[0];
#pragma unroll
            for (int r = 1; r < 16; ++r) pmax = fmaxf(pmax, p0[r]);
#pragma unroll
            for (int r = 0; r < 16; ++r) pmax = fmaxf(pmax, p1[r]);
            pmax = swap_max(pmax) * C;
            if (!__all(pmax - m_reg <= THR_L2)) {
                const float mn = fmaxf(m_reg, pmax), alpha = __builtin_amdgcn_exp2f(m_reg - mn); m_reg = mn; l_reg *= alpha;
                if (hi == 0) al_l[r32] = alpha;
                asm volatile("s_waitcnt lgkmcnt(0)" ::: "memory");
#pragma unroll
                for (int d = 0; d < 4; ++d)
#pragma unroll
                    for (int r = 0; r < 16; ++r) o[d][r] *= al_h[(r & 3) + 8 * (r >> 2)];
            }
            float ps = 0.f; const float nm = -m_reg;
#pragma unroll
            for (int r = 0; r < 16; ++r) { p0[r] = __builtin_amdgcn_exp2f(fmaf(p0[r], C, nm)); p1[r] = __builtin_amdgcn_exp2f(fmaf(p1[r], C, nm)); ps += p0[r] + p1[r]; }
            l_reg += swap_add(ps);
            bf16x8 pa0, pa1, pa2, pa3;
#define ATT_PK4(P, BASE, OUT) do { const unsigned a0 = cvtpk(P[BASE + 0], P[BASE + 1]), a1 = cvtpk(P[BASE + 2], P[BASE + 3]); \
            const unsigned b0 = cvtpk(P[BASE + 4], P[BASE + 5]), b1 = cvtpk(P[BASE + 6], P[BASE + 7]); \
            auto r0 = __builtin_amdgcn_permlane32_swap(a0, b0, false, false); auto r1 = __builtin_amdgcn_permlane32_swap(a1, b1, false, false); \
            u32x4 w = {r0[0], r1[0], r0[1], r1[1]}; OUT = __builtin_bit_cast(bf16x8, w); } while (0)
            ATT_PK4(p0, 0, pa0); ATT_PK4(p0, 8, pa1); ATT_PK4(p1, 0, pa2); ATT_PK4(p1, 8, pa3);
#undef ATT_PK4
            pv_d0(o, vb0 + b * SHM_V, pa0, pa1, pa2, pa3);
        } else if (tpn != nullptr) ATT_TSTAGE(tpn);
        tp = tpn;
        asm volatile("s_waitcnt vmcnt(0)" ::: "memory"); __syncthreads();
    }
#undef ATT_STAGE
#undef ATT_TSTAGE
    l_reg += __builtin_amdgcn_exp2f(sink_l2 - m_reg);
    if (hi == 0) li_l[r32] = l_reg;
    asm volatile("s_waitcnt lgkmcnt(0)" ::: "memory");
#if G23_FP8
    { LAS unsigned char* St = (LAS unsigned char*)T_lds + hi * (4 * 128) + r32;
#pragma unroll
      for (int r = 0; r < 16; ++r) { const float rl = __builtin_amdgcn_rcpf(li_h[(r & 3) + 8 * (r >> 2)]);
#pragma unroll
          for (int d0 = 0; d0 < 4; ++d0) { const float v = o[d0][r] * rl; St[((r & 3) + 8 * (r >> 2)) * 128 + d0 * 32] = (unsigned char)(__builtin_amdgcn_cvt_pk_fp8_f32(v, v, 0, false) & 0xff); } }
      asm volatile("s_waitcnt lgkmcnt(0)" ::: "memory");
      unsigned char* Ow = (unsigned char*)Ob + (size_t)(lane >> 3) * LDO + (lane & 7) * 16;
#pragma unroll
      for (int i = 0; i < 4; ++i) { const u32x4 w = *(const LAS u32x4*)(T_lds + i * 1024 + lane * 16); *(u32x4*)(Ow + (size_t)(i * 8) * LDO) = w; }
      asm volatile("s_waitcnt lgkmcnt(0)" ::: "memory"); }
#else
    { LAS unsigned short* St = (LAS unsigned short*)T_lds + hi * (4 * 128) + r32;
#pragma unroll
      for (int r = 0; r < 16; ++r) { const float rl = __builtin_amdgcn_rcpf(li_h[(r & 3) + 8 * (r >> 2)]);
#pragma unroll
          for (int d0 = 0; d0 < 4; ++d0) { const float v = o[d0][r] * rl; St[((r & 3) + 8 * (r >> 2)) * 128 + d0 * 32] = (unsigned short)(cvtpk(v, v) & 0xffffu); } }
      asm volatile("s_waitcnt lgkmcnt(0)" ::: "memory");
      bf16* Ow = Ob + (size_t)(lane >> 4) * LDO + (lane & 15) * 8;
#pragma unroll
      for (int i = 0; i < 8; ++i) { const u32x4 w = *(const LAS u32x4*)(T_lds + i * 1024 + lane * 16); *(u32x4*)(Ow + (size_t)(i * 4) * LDO) = w; }
      asm volatile("s_waitcnt lgkmcnt(0)" ::: "memory"); }
#endif
}

struct B2Tile { const float* tp; bool va, vb; };
template <int LDZ, int LDO, class InfoFn>
__device__ __forceinline__ void attn_unit_b2(const bf16* __restrict__ Zq, const bf16* __restrict__ Zk, const bf16* __restrict__ Zv, bf16* __restrict__ Ob, const int NT,
                                             const InfoFn& tinfo, LAS unsigned char* lds, const int tid_in) {
    int tid = tid_in; asm volatile("" : "+v"(tid));
    const int wid = __builtin_amdgcn_readfirstlane(tid >> 6), lane = tid & 63, r32 = lane & 31, hi = lane >> 5;
    const int rp = wid >> 2, cb = wid & 3, w0 = cb == 0 ? 0 : (cb == 1 ? 8 : (cb == 2 ? 24 : 32));
    const int qtok = (2 * rp + (r32 >> 4)) * 64 + 16 * cb + (r32 & 15);
    static_assert(3 * SHM_V + 3 * SHM_K + 8 * 4096 == OFF_WS2 && G23_FP8, "mixer B's three-slot LDS map (fp8 output staging fits the 4 KiB slot)");
    LAS unsigned char* V_lds = lds; LAS unsigned char* K_lds = lds + 3 * SHM_V; LAS unsigned char* T_lds = lds + 3 * SHM_V + 3 * SHM_K + wid * 4096;
    LAS float* wsf = (LAS float*)(lds + OFF_WS2) + wid * 64; LAS float* li_l = wsf; LAS float* al_l = wsf + 32;
    const LAS float* li_h = li_l + 4 * hi; const LAS float* al_h = al_l + 4 * hi;
    constexpr float C = 0.08838834764831845f * 1.4426950408889634f;
    float m_reg = -1e30f, l_reg = 0.f; f32x16 o[4] = {}; bf16x8 qr[8];
    { const bf16* Qw = Zq + (size_t)qtok * LDZ + hi * 8;
#pragma unroll
      for (int d0 = 0; d0 < 8; ++d0) qr[d0] = *(const bf16x8*)(Qw + d0 * 16); }
    unsigned kof[2], vof[2];
#pragma unroll
    for (int i = 0; i < 2; ++i) { const int p = (wid * 2 + i) * 64 + lane;
        { const int row = p >> 4, ch = (p & 15) ^ (row & 7); kof[i] = (unsigned)(row * LDZ + ch * 8); }
        { const int sub = p >> 5, g = p & 31, kk = (sub >> 2) * 8 + (g >> 2), c = (sub & 3) * 32 + (g & 3) * 8, k = (kk & ~0xC) | ((kk & 4) << 1) | ((kk & 8) >> 1);
          vof[i] = (unsigned)(k * LDZ + c); } }
    const bool shifted = (cb == 1) || (cb == 2);
    const int vbw = (int)(unsigned)(uintptr_t)V_lds + (shifted ? (v_rd_base(lane & 31) + (hi ? 4096 : 256) + ((w0 - 8) >> 4) * 4096) : (v_rd_base(lane) + (w0 >> 4) * 4096));
    const int krow = w0 + r32;
#define ATT_STAGE(t, b) do { const bf16* _k = Zk + (size_t)(t) * 64 * LDZ; const bf16* _v = Zv + (size_t)(t) * 64 * LDZ; \
        glds16(_k + kof[0], K_lds + (b) * SHM_K + (wid * 2) * 1024); glds16(_k + kof[1], K_lds + (b) * SHM_K + (wid * 2 + 1) * 1024); \
        glds16(_v + vof[0], V_lds + (b) * SHM_V + (wid * 2) * 1024); glds16(_v + vof[1], V_lds + (b) * SHM_V + (wid * 2 + 1) * 1024); } while (0)
#define ATT_TSTAGE(tp_) do { _Pragma("unroll") for (int i = 0; i < 4; ++i) glds16((tp_) + (i * 64 + lane) * 4, T_lds + i * 1024); } while (0)
    B2Tile ti = tinfo(0), tn1; tn1.tp = nullptr; tn1.va = false; tn1.vb = false; if (NT > 1) tn1 = tinfo(1);
    f32x4 S0[4] = {}, S1[4] = {}, S2[4] = {};
    __syncthreads();
    if (ti.tp != nullptr) {
#pragma unroll
        for (int i = 0; i < 4; ++i) S0[i] = *(const f32x4*)(ti.tp + (i * 64 + lane) * 4); }
    if (tn1.tp != nullptr) {
#pragma unroll
        for (int i = 0; i < 4; ++i) S1[i] = *(const f32x4*)(tn1.tp + (i * 64 + lane) * 4); }
    ATT_STAGE(0, 0);
    if (NT > 1) { ATT_STAGE(1, 1); asm volatile("s_waitcnt vmcnt(4)" ::: "memory"); } else asm volatile("s_waitcnt vmcnt(0)" ::: "memory");
    __syncthreads();
    auto step = [&](const int j, const int b, const int b2, const f32x4 (&tcur)[4], f32x4 (&tld)[4]) __attribute__((always_inline)) {
        B2Tile tn2; tn2.tp = nullptr; tn2.va = false; tn2.vb = false; if (j + 2 < NT) tn2 = tinfo(j + 2);
        if (tn2.tp != nullptr) {
#pragma unroll
            for (int i = 0; i < 4; ++i) tld[i] = *(const f32x4*)(tn2.tp + (i * 64 + lane) * 4); }
        if (j + 2 < NT) ATT_STAGE(j + 2, b2);
        if (ti.tp != nullptr) {
            f32x16 p0;
#pragma unroll
            for (int i = 0; i < 4; ++i) { p0[4 * i + 0] = tcur[i].x; p0[4 * i + 1] = tcur[i].y; p0[4 * i + 2] = tcur[i].z; p0[4 * i + 3] = tcur[i].w; }
            { const LAS unsigned char* Ks = K_lds + b * SHM_K;
#pragma unroll
              for (int d0 = 0; d0 < 8; ++d0) { const int cbb = (d0 * 16 + hi * 8) * 2;
                  const bf16x8 kf = *(const LAS bf16x8*)(Ks + ATT_KSWZ(krow, cbb));
                  p0 = __builtin_amdgcn_mfma_f32_32x32x16_bf16(kf, qr[d0], p0, 0, 0, 0); } }
            if (!(ti.va && ti.vb)) {
                const bool ok = (r32 >> 4) ? ti.vb : ti.va;
#pragma unroll
                for (int r = 0; r < 16; ++r) p0[r] = ok ? p0[r] : -__builtin_inff(); }
            float pmax = p0[0];
#pragma unroll
            for (int r = 1; r < 16; ++r) pmax = fmaxf(pmax, p0[r]);
            pmax = swap_max(pmax) * C;
            if (!__all(pmax - m_reg <= THR_L2)) {
                const float mn = fmaxf(m_reg, pmax), alpha = __builtin_amdgcn_exp2f(m_reg - mn); m_reg = mn; l_reg *= alpha;
                if (hi == 0) al_l[r32] = alpha;
                asm volatile("s_waitcnt lgkmcnt(0)" ::: "memory");
#pragma unroll
                for (int d = 0; d < 4; ++d)
#pragma unroll
                    for (int r = 0; r < 16; ++r) o[d][r] *= al_h[(r & 3) + 8 * (r >> 2)];
            }
            float ps = 0.f; const float nm = -m_reg;
#pragma unroll
            for (int r = 0; r < 16; ++r) { p0[r] = __builtin_amdgcn_exp2f(fmaf(p0[r], C, nm)); ps += p0[r]; }
            l_reg += swap_add(ps);
            bf16x8 pa0, pa1;
#define ATT_PK4(P, BASE, OUT) do { const unsigned a0 = cvtpk(P[BASE + 0], P[BASE + 1]), a1 = cvtpk(P[BASE + 2], P[BASE + 3]); \
            const unsigned b0 = cvtpk(P[BASE + 4], P[BASE + 5]), b1 = cvtpk(P[BASE + 6], P[BASE + 7]); \
            auto r0 = __builtin_amdgcn_permlane32_swap(a0, b0, false, false); auto r1 = __builtin_amdgcn_permlane32_swap(a1, b1, false, false); \
            u32x4 w = {r0[0], r1[0], r0[1], r1[1]}; OUT = __builtin_bit_cast(bf16x8, w); } while (0)
            ATT_PK4(p0, 0, pa0); ATT_PK4(p0, 8, pa1);
#undef ATT_PK4
            { const int vb = vbw + b * SHM_V;
#define ATT_PK(L, H) (bf16x8){L[0], L[1], L[2], L[3], H[0], H[1], H[2], H[3]}
#define ATT_PV2(D0) do { const s16x4 l0 = tr_read<v_rd_off(D0, 0, 0)>(vb), h0 = tr_read<v_rd_off(D0, 0, 1)>(vb), l1 = tr_read<v_rd_off(D0, 1, 0)>(vb), h1 = tr_read<v_rd_off(D0, 1, 1)>(vb); \
              asm volatile("s_waitcnt lgkmcnt(0)" ::: "memory"); ATT_SBAR(); \
              o[D0] = __builtin_amdgcn_mfma_f32_32x32x16_bf16(pa0, ATT_PK(l0, h0), o[D0], 0, 0, 0); o[D0] = __builtin_amdgcn_mfma_f32_32x32x16_bf16(pa1, ATT_PK(l1, h1), o[D0], 0, 0, 0); } while (0)
              ATT_PV2(0); ATT_PV2(1); ATT_PV2(2); ATT_PV2(3);
#undef ATT_PV2
#undef ATT_PK
            }
        }
        const bool st2 = j + 2 < NT, tb2 = tn2.tp != nullptr;
        ti = tn1; tn1 = tn2;
        if (st2 && tb2) asm volatile("s_waitcnt vmcnt(8)" ::: "memory"); else if (st2) asm volatile("s_waitcnt vmcnt(4)" ::: "memory"); else asm volatile("s_waitcnt vmcnt(0)" ::: "memory");
        __syncthreads();
    };
    for (int j = 0; j < NT; j += 3) { step(j, 0, 2, S0, S2); if (j + 1 < NT) step(j + 1, 1, 0, S1, S0); if (j + 2 < NT) step(j + 2, 2, 1, S2, S1); }
#undef ATT_STAGE
#undef ATT_TSTAGE
    if (hi == 0) li_l[r32] = l_reg;
    asm volatile("s_waitcnt lgkmcnt(0)" ::: "memory");
#if G23_FP8
    { LAS unsigned char* St = (LAS unsigned char*)T_lds + hi * (4 * 128) + r32;
#pragma unroll
      for (int r = 0; r < 16; ++r) { const float rl = __builtin_amdgcn_rcpf(li_h[(r & 3) + 8 * (r >> 2)]);
#pragma unroll
          for (int d0 = 0; d0 < 4; ++d0) { const float v = o[d0][r] * rl; St[((r & 3) + 8 * (r >> 2)) * 128 + d0 * 32] = (unsigned char)(__builtin_amdgcn_cvt_pk_fp8_f32(v, v, 0, false) & 0xff); } }
      asm volatile("s_waitcnt lgkmcnt(0)" ::: "memory");
#pragma unroll
      for (int i = 0; i < 4; ++i) { const int ri = i * 8 + (lane >> 3), tok = (2 * rp + (ri >> 4)) * 64 + 16 * cb + (ri & 15);
          const u32x4 w = *(const LAS u32x4*)(T_lds + i * 1024 + lane * 16); *(u32x4*)((unsigned char*)Ob + (size_t)tok * LDO + (lane & 7) * 16) = w; }
      asm volatile("s_waitcnt lgkmcnt(0)" ::: "memory"); }
#else
    { LAS unsigned short* St = (LAS unsigned short*)T_lds + hi * (4 * 128) + r32;
#pragma unroll
      for (int r = 0; r < 16; ++r) { const float rl = __builtin_amdgcn_rcpf(li_h[(r & 3) + 8 * (r >> 2)]);
#pragma unroll
          for (int d0 = 0; d0 < 4; ++d0) { const float v = o[d0][r] * rl; St[((r & 3) + 8 * (r >> 2)) * 128 + d0 * 32] = (unsigned short)(cvtpk(v, v) & 0xffffu); } }
      asm volatile("s_waitcnt lgkmcnt(0)" ::: "memory");
#pragma unroll
      for (int i = 0; i < 8; ++i) { const int ri = i * 4 + (lane >> 4), tok = (2 * rp + (ri >> 4)) * 64 + 16 * cb + (ri & 15);
          const u32x4 w = *(const LAS u32x4*)(T_lds + i * 1024 + lane * 16); *(u32x4*)(Ob + (size_t)tok * LDO + (lane & 15) * 8) = w; }
      asm volatile("s_waitcnt lgkmcnt(0)" ::: "memory"); }
#endif
}
}

__device__ __forceinline__ void p0_tables(Frame& F) {
    float* tA = (float*)(F.ws() + WS_TBLA); float* tB = (float*)(F.ws() + WS_TBLB);
    const float ninf = -__builtin_inff();
    const int gt = blockIdx.x * (NWAVES * 64) + F.tid, ngt = F.G * NWAVES * 64;
    for (int e = gt; e < 8 * 10 * 2048; e += ngt) {
        const int h = e / 20480, rem = e - h * 20480, idx = rem >> 11, w_ = rem & 2047, i = w_ >> 8, lane = (w_ >> 2) & 63, ee = w_ & 3;
        const int r = 4 * (i & 3) + ee, hi = lane >> 5, q = lane & 31, key = ((i >> 2) << 5) + att::crow(r, hi);
        const int d = 32 * idx - 128 + q - key, ad = d < 0 ? -d : d;
        tA[e] = ad <= 128 ? -exp2f(-(float)(h + 1)) * (float)ad * (1.0f / ATT_SCALE) : ninf;
    }
    for (int e = gt; e < NLAYER * 8 * 16 * 4 * 1024; e += ngt) {
        const int w_ = e & 1023, t = e >> 10, cb = t & 3, t2 = t >> 2, d = t2 & 15, t3 = t2 >> 4, h = t3 & 7, l = t3 >> 3;
        const int i = w_ >> 8, lane = (w_ >> 2) & 63, ee = w_ & 3, r = 4 * i + ee, hi = lane >> 5, q = lane & 31, kw = att::crow(r, hi);
        const int w0 = cb == 0 ? 0 : (cb == 1 ? 8 : (cb == 2 ? 24 : 32)), kc = w0 + kw, c = 16 * cb + (q & 15), dr = d - (q >> 4);
        const int cc0 = c - 8 < 0 ? 0 : (c - 8 > 48 ? 48 : c - 8);
        int dcv = kc - c; dcv = dcv < -15 ? -15 : (dcv > 15 ? 15 : dcv);
        const bool ok = dr >= 0 && dr <= 14 && kc >= cc0 && kc < cc0 + 16;
        tB[e] = ok ? F.in(I_RPB)[((l * 8 + h) * 15 + dr) * 31 + dcv + 15] * (1.0f / ATT_SCALE) : ninf;
    }
}


__device__ __forceinline__ void qk_norm_phase(Frame& F, const int l) {
    bf16* Z = (bf16*)(F.ws() + WS_Z);
    const int sub = F.lane >> 4, li = F.lane & 15;
    for (int tl = F.gw; tl < TC; tl += F.ngw) {
        bf16* zr = Z + (size_t)tl * INC;
#pragma unroll
        for (int it = 0; it < 7; ++it) { const int hh = it * 4 + sub;
            if (hh < 26) {
                const int col = (hh < 10 ? hh * HD : 1536 + (hh - 10) * HD) + li * 8;
                const float* g = F.in(hh < 8 ? I_QNA : (hh < 10 ? I_KNA : (hh < 18 ? I_QNB : I_KNB))) + l * HD + li * 8;
                const v4u w = *(const v4u*)(zr + col);
                float f[8] = {bflo(w.x), bfhi(w.x), bflo(w.y), bfhi(w.y), bflo(w.z), bfhi(w.z), bflo(w.w), bfhi(w.w)};
                float ss = 0.f;
#pragma unroll
                for (int i = 0; i < 8; ++i) ss = fmaf(f[i], f[i], ss);
                ss += __shfl_xor(ss, 1); ss += __shfl_xor(ss, 2); ss += __shfl_xor(ss, 4); ss += __shfl_xor(ss, 8);
                const float rs = rsqrtf(ss * (1.f / HD) + RMS_EPS);
                const f32x4 g0 = *(const f32x4*)g, g1 = *(const f32x4*)(g + 4);
                v4u o; o.x = pk2(f[0] * rs * g0.x, f[1] * rs * g0.y); o.y = pk2(f[2] * rs * g0.z, f[3] * rs * g0.w); o.z = pk2(f[4] * rs * g1.x, f[5] * rs * g1.y); o.w = pk2(f[6] * rs * g1.z, f[7] * rs * g1.w);
                *(v4u*)(zr + col) = o;
            } }
    }
}

template <int MIXER> __device__ __forceinline__ void attn_fast(Frame& F, const int l, const int c0) {
    const bf16* Z = (const bf16*)(F.ws() + WS_Z); bf16* O = (bf16*)(F.ws() + WS_O);
    const float* tblA = (const float*)(F.ws() + WS_TBLA); const float* tblB = (const float*)(F.ws() + WS_TBLB) + (size_t)l * (8 * 16 * 4 * 1024);
    constexpr int OB = G23_FP8 ? 1 : 2;
    if (MIXER == 0) {
        const bool grp = (F.G & 7) == 0; constexpr int UPG = (TC / 64) * 2 / 8;
        for (int ui = grp ? ((int)blockIdx.x & 7) * UPG + ((int)blockIdx.x >> 3) : (int)blockIdx.x; ui < (grp ? (((int)blockIdx.x & 7) + 1) * UPG : (TC / 64) * 2); ui += grp ? (F.G >> 3) : F.G) {
            const int qb = ui >> 1, kvh = ui & 1, row0 = c0 + qb * 64, lq = qb * 64;
            const int S = row0 < TP ? 2048 : 4096, pos0 = row0 < TP ? (row0 & 2047) : ((row0 - TP) & 4095);
            const int jlo = pos0 >= 128 ? 0 : (128 - pos0) >> 6, jr = (S + 64 - pos0) >> 6, jhi = jr > 4 ? 4 : jr, NT = jhi - jlo + 1;
            const int lk = lq - 128 + 64 * jlo, g = F.wave >> 1, half = F.wave & 1, h = kvh * 4 + g, lqw = lq + 32 * half;
            const float* tb = tblA + (size_t)h * (10 * 2048);
            auto tfn = [=](int j) -> const float* { return tb + (half + 8 - 2 * (jlo + j)) * 2048; };
            att::attn_unit<INC, D>(Z + (size_t)lqw * INC + ZC_QA + h * HD, Z + (size_t)lk * INC + ZC_KA + kvh * HD, Z + (size_t)lk * INC + ZC_VA + kvh * HD,
                                   (bf16*)((unsigned char*)O + ((size_t)lqw * D + h * HD) * OB), NT, tfn, F.in(I_SINK)[l * 8 + h] * LOG2E, F.lds + RING_OFF, F.tid);
        }
    } else {
        const bool grp = (F.G & 7) == 0; constexpr int UPG = (TC / 256) * 8 / 8;
        for (int ui = grp ? ((int)blockIdx.x & 7) * UPG + ((int)blockIdx.x >> 3) : (int)blockIdx.x; ui < (grp ? (((int)blockIdx.x & 7) + 1) * UPG : (TC / 256) * 8); ui += grp ? (F.G >> 3) : F.G) {
            const int qb = ui >> 3, h = ui & 7, row0 = c0 + qb * 256;
            const int S = row0 < TP ? 2048 : 4096, pos0 = row0 < TP ? (row0 & 2047) : ((row0 - TP) & 4095);
            const int lq = qb * 256;
            const int rows = S >> 6, u4 = pos0 >> 6;
            const int lo_ = u4 - 4 < 0 ? 0 : (u4 - 4 > rows - 8 ? rows - 8 : u4 - 4), hiq = u4 + 3 - 4 < 0 ? 0 : (u4 - 1 > rows - 8 ? rows - 8 : u4 - 1);
            const int NT = hiq + 7 - lo_ + 1, lk = lq - pos0 + 64 * lo_;
            const int ra = u4 + 2 * (F.wave >> 2), rb_ = ra + 1;
            const int r0a = ra - 4 < 0 ? 0 : (ra - 4 > rows - 8 ? rows - 8 : ra - 4), r0b = rb_ - 4 < 0 ? 0 : (rb_ - 4 > rows - 8 ? rows - 8 : rb_ - 4);
            const float* tb = tblB + (size_t)(h * 16 * 4 + (F.wave & 3)) * 1024;
            auto tfn = [=](int j) -> att::B2Tile { const int kr = lo_ + j; att::B2Tile t; t.va = kr >= r0a && kr <= r0a + 7; t.vb = kr >= r0b && kr <= r0b + 7;
                t.tp = (t.va || t.vb) ? tb + (size_t)(kr - ra + 7) * (4 * 1024) : nullptr; return t; };
            att::attn_unit_b2<INC, D>(Z + (size_t)lq * INC + ZC_QB + h * HD, Z + (size_t)lk * INC + ZC_KB + h * HD, Z + (size_t)lk * INC + ZC_VB + h * HD,
                                      (bf16*)((unsigned char*)O + ((size_t)lq * D + 1024 + h * HD) * OB), NT, tfn, F.lds + RING_OFF, F.tid);
        }
    }
}

#ifndef SITE_MASK
#define SITE_MASK 0xffff
#endif
#define SITE(k) ((SITE_MASK >> (k)) & 1)
#ifndef STAGGER_TICKS
#define STAGGER_TICKS 0u
#endif
#ifndef PROBE_REP
#define PROBE_REP 0
#endif
constexpr int N_BAR_TOTAL = 2 + 2 * (8 + 7);
static_assert((TC / 256) % (8 * pg8::WGM) == 0, "group seams: every eighth of the tile list must hold whole tile groups");
__device__ __forceinline__ void seam_barrier(Frame& F, const XcdBarrier& bar) {
    if ((F.G & 7) == 0) grp_barrier(bar, (unsigned)blockIdx.x & 7u); else xcd_barrier(bar);
}
__device__ __forceinline__ void halo_barrier(Frame& F, const XcdBarrier& bar) {
    if ((F.G & 7) == 0) grp_barrier(bar, (unsigned)blockIdx.x & 7u, true); else xcd_barrier(bar);
}
__device__ __forceinline__ void hid_barrier(Frame& F, const XcdBarrier& bar) {
    if ((F.G & 7) == 0) grp_barrier(bar, (unsigned)blockIdx.x & 7u, true, 2u); else xcd_barrier(bar);
}
template <int l, int c, bool LAST> __device__ __forceinline__ void layer_chunk(Frame& F, const XcdBarrier& bar) {
    unsigned char* wl = F.ws() + WS_W + (size_t)l * W_LAYER;
    const pg8::bf16_t* WinT = (const pg8::bf16_t*)(wl + WO_IN); const pg8::bf16_t* WbrT = (const pg8::bf16_t*)(wl + WO_BR); const pg8::bf16_t* WoutT = (const pg8::bf16_t*)(wl + WO_OUT);
    const pg8::bf16_t* W1T = (const pg8::bf16_t*)(wl + WO_1); const pg8::bf16_t* W2T = (const pg8::bf16_t*)(wl + WO_2);
    pg8::bf16_t* Hb = (pg8::bf16_t*)(F.ws() + WS_H); pg8::bf16_t* Zb = (pg8::bf16_t*)(F.ws() + WS_Z); pg8::bf16_t* Ob = (pg8::bf16_t*)(F.ws() + WS_O); pg8::bf16_t* Mb = (pg8::bf16_t*)(F.ws() + WS_MB); pg8::bf16_t* Xb = (pg8::bf16_t*)(F.ws() + WS_XB);
    constexpr int c0 = c * TC;
    pg8::ssq_t* ssq1 = F.ssq() + (size_t)((0 * NCH + c) * NLAYER + l) * TC;
    pg8::ssq_t* ssq2 = F.ssq() + (size_t)((1 * NCH + c) * NLAYER + l) * TC;
    const float* modl = F.mod() + (size_t)l * NSEQ * 6 * D;
    if (l == 0) { norm0_phase(F, c0, ssq1); seam_barrier(F, bar); }
    if (SITE(1)) { pg8::Gemm g{Hb, WinT, TC, INC, D / 2, D, D / 2}; pg8::PrefetchOrder S; S.init(TC, INC, F.G, (int)blockIdx.x); S.rev = true;
      S.ssq = ssq1; S.shw = F.shwin() + (size_t)l * NSEQ * INC; S.ldw = INC; S.row_off = c0; S.buf = F.lds + PFB_OFF; S.cnt = 0;
      pg8::EpiZ E{Zb, INC, F.in(I_QNA) + l * HD, F.in(I_KNA) + l * HD, F.in(I_QNB) + l * HD, F.in(I_KNB) + l * HD, (PG8_LAS float*)(F.lds + PART_OFF), F.lds + PFB_OFF, 0};
      pg8::gemm_phase<pg8::EpiZ, pg8::PrefetchOrder, true, PG8_SP2, true>(F.lds + RING_OFF, g, S, E); halo_barrier(F, bar); }
#if PROBE_REP & 2
    if (SITE(1)) { pg8::Gemm g{Hb, WinT, TC, INC, D / 2, D, D / 2}; pg8::PrefetchOrder S; S.init(TC, INC, F.G, (int)blockIdx.x);
      S.ssq = ssq1; S.shw = F.shwin() + (size_t)l * NSEQ * INC; S.ldw = INC; S.row_off = c0; S.buf = F.lds + PFB_OFF; S.cnt = 0;
      pg8::EpiZ E{Zb, INC, F.in(I_QNA) + l * HD, F.in(I_KNA) + l * HD, F.in(I_QNB) + l * HD, F.in(I_KNB) + l * HD, (PG8_LAS float*)(F.lds + PART_OFF), F.lds + PFB_OFF, 0};
      pg8::gemm_phase<pg8::EpiZ, pg8::PrefetchOrder, true, PG8_SP2, true>(F.lds + RING_OFF, g, S, E); xcd_barrier(bar); }
#endif
    if (SITE(2)) { attn_fast<0>(F, l, c0); attn_fast<1>(F, l, c0); seam_barrier(F, bar); }
#if PROBE_REP & 4
    if (SITE(2)) { attn_fast<0>(F, l, c0); attn_fast<1>(F, l, c0); xcd_barrier(bar); }
#endif
    if (SITE(3)) { pg8::Gemm g{Ob, WbrT, TC, D, G23_FP8 ? D / 2 : D, G23_FP8 ? D / 2 : D, G23_FP8 ? D / 2 : D}; pg8::StaticOrder S; S.init(TC, D, F.G, (int)blockIdx.x);
      pg8::EpiGateMid<INC, D, G4_FP8 != 0, G23_FP8 != 0> E{Zb + ZC_GA, Zb + ZC_GB, Mb};
      pg8::gemm_phase<pg8::EpiGateMid<INC, D, G4_FP8 != 0, G23_FP8 != 0>, pg8::StaticOrder, PG8_ALIGN, PG8_SP2, G23_FP8 != 0>(F.lds + RING_OFF, g, S, E); seam_barrier(F, bar); }
#if PROBE_REP & 64
    if (SITE(3)) { pg8::Gemm g{Ob, WbrT, TC, D, G23_FP8 ? D / 2 : D, G23_FP8 ? D / 2 : D, G23_FP8 ? D / 2 : D}; pg8::StaticOrder S; S.init(TC, D, F.G, (int)blockIdx.x);
      pg8::EpiGateMid<INC, D, G4_FP8 != 0, G23_FP8 != 0> E{Zb + ZC_GA, Zb + ZC_GB, Mb};
      pg8::gemm_phase<pg8::EpiGateMid<INC, D, G4_FP8 != 0, G23_FP8 != 0>, pg8::StaticOrder, PG8_ALIGN, PG8_SP2, G23_FP8 != 0>(F.lds + RING_OFF, g, S, E); xcd_barrier(bar); }
#endif
#if G4_FP8
    if (SITE(5)) { pg8::Gemm g{Mb, WoutT, TC, D, D / 2, D / 2, D / 2}; pg8::StaticOrder S; S.init(TC, D, F.G, (int)blockIdx.x);
      pg8::EpiResid<(l == 0 ? 0 : 1), 1, (G5_FP8 ? 2 : 1), true> E{F.in(I_XP), F.in(I_XS), Xb, F.out(), modl + 2 * D, c0, F.in(I_LN2) + l * D, modl + 4 * D, (void*)Hb, ssq2, (PG8_LAS float*)(F.lds + PART_OFF)};
      pg8::gemm_phase<pg8::EpiResid<(l == 0 ? 0 : 1), 1, (G5_FP8 ? 2 : 1), true>, pg8::StaticOrder, PG8_ALIGN, PG8_SP2, true>(F.lds + RING_OFF, g, S, E); hid_barrier(F, bar); }
#else
    if (SITE(5)) { pg8::Gemm g{Mb, WoutT, TC, D, D, D, D}; pg8::StaticOrder S; S.init(TC, D, F.G, (int)blockIdx.x);
      pg8::EpiResid<(l == 0 ? 0 : 1), 1, 1> E{F.in(I_XP), F.in(I_XS), Xb, F.out(), modl + 2 * D, c0, F.in(I_LN2) + l * D, modl + 4 * D, (void*)Hb, ssq2, (PG8_LAS float*)(F.lds + PART_OFF)};
      pg8::gemm_phase<pg8::EpiResid<(l == 0 ? 0 : 1), 1, 1>, pg8::StaticOrder, PG8_ALIGN, PG8_SP2>(F.lds + RING_OFF, g, S, E); hid_barrier(F, bar); }
#endif
#ifdef PROBE_CLOCK
    if (LAST && blockIdx.x == 0 && F.tid == 0) { volatile LAS unsigned long long* st = (volatile LAS unsigned long long*)(F.lds + MISC_OFF + 64); st[0] = clock64(); st[1] = wall_clock64(); }
#endif
    if (SITE(6)) { pg8::Gemm g{Hb, W1T, TC, DFF, G5_FP8 ? D / 2 : D, D, G5_FP8 ? D / 2 : D}; pg8::PrefetchOrder S; S.init(TC, DFF, F.G, (int)blockIdx.x);
      S.ssq = ssq2; S.shw = F.shw1() + (size_t)l * NSEQ * DFF; S.ldw = DFF; S.row_off = c0; S.buf = F.lds + PFB_OFF; S.cnt = 0;
      pg8::EpiMlp1<G5_FP8 != 0> E{Zb, INC, F.lds + PFB_OFF, 0};
      pg8::gemm_phase<pg8::EpiMlp1<G5_FP8 != 0>, pg8::PrefetchOrder, PG8_ALIGN, PG8_SP2, G5_FP8 != 0>(F.lds + RING_OFF, g, S, E);
#ifdef PROBE_CLOCK
      if (LAST && blockIdx.x == 0 && F.tid == 0) { volatile LAS unsigned long long* st = (volatile LAS unsigned long long*)(F.lds + MISC_OFF + 64); st[2] = clock64(); st[3] = wall_clock64(); }
#endif
      seam_barrier(F, bar); }
#if PROBE_REP & 8
    if (SITE(6)) { pg8::Gemm g{Hb, W1T, TC, DFF, G5_FP8 ? D / 2 : D, D, G5_FP8 ? D / 2 : D}; pg8::PrefetchOrder S; S.init(TC, DFF, F.G, (int)blockIdx.x);
      S.ssq = ssq2; S.shw = F.shw1() + (size_t)l * NSEQ * DFF; S.ldw = DFF; S.row_off = c0; S.buf = F.lds + PFB_OFF; S.cnt = 0;
      pg8::EpiMlp1<G5_FP8 != 0> E{Zb, INC, F.lds + PFB_OFF, 0};
      pg8::gemm_phase<pg8::EpiMlp1<G5_FP8 != 0>, pg8::PrefetchOrder, PG8_ALIGN, PG8_SP2, G5_FP8 != 0>(F.lds + RING_OFF, g, S, E); xcd_barrier(bar); }
#endif
    if (SITE(7)) { pg8::Gemm g{Zb, W2T, TC, D, DFF, INC, DFF}; pg8::StaticOrder S; S.init(TC, D, F.G, (int)blockIdx.x);
      if (l + 1 < NLAYER) {
          pg8::EpiResid<1, 1, 2> E{F.in(I_XP), F.in(I_XS), Xb, F.out(), modl + 5 * D, c0, F.in(I_LN1) + (l + 1) * D, F.mod() + ((size_t)(l + 1) * NSEQ * 6 + 1) * D, (void*)Hb, F.ssq() + (size_t)((0 * NCH + c) * NLAYER + (l + 1)) * TC, (PG8_LAS float*)(F.lds + PART_OFF)};
          pg8::gemm_phase<pg8::EpiResid<1, 1, 2>, pg8::StaticOrder, PG8_ALIGN, PG8_SP2>(F.lds + RING_OFF, g, S, E);
      } else {
          pg8::EpiResid<1, 0, 0> E{F.in(I_XP), F.in(I_XS), Xb, F.out(), modl + 5 * D, c0, nullptr, nullptr, nullptr, nullptr, nullptr};
          pg8::gemm_phase<pg8::EpiResid<1, 0, 0>, pg8::StaticOrder, PG8_ALIGN, PG8_SP2>(F.lds + RING_OFF, g, S, E);
      }
      if (!LAST) { if (l + 1 < NLAYER) seam_barrier(F, bar); else if ((F.G & 7) != 0) xcd_barrier(bar); } }
}

__global__ void __launch_bounds__(NWAVES * 64, 2) enc_fwd(Args a) {
    extern __shared__ __attribute__((aligned(16))) unsigned char lds_raw[];
    Frame F;
    F.lds = (LAS unsigned char*)lds_raw;
    F.tid = threadIdx.x; F.lane = F.tid & 63; F.wave = __builtin_amdgcn_readfirstlane(F.tid >> 6);
    F.G = gridDim.x; F.gw = blockIdx.x * NWAVES + F.wave; F.ngw = F.G * NWAVES;
    F.ap = (const __attribute__((address_space(4))) Args*)__builtin_amdgcn_kernarg_segment_ptr();
    const unsigned char* a_ws = F.ws();
    gu32* ctl = (gu32*)(a_ws + WS_CTL);
    for (int u = F.tid; u < (LDS_BYTES - LDSCTL_OFF) / 4; u += NWAVES * 64) ((LAS unsigned*)(F.lds + LDSCTL_OFF))[u] = 0u;
    __syncthreads();
    volatile LAS unsigned* MISC = (volatile LAS unsigned*)(F.lds + MISC_OFF);
    XcdBarrier bar = xcd_barrier_post((unsigned*)(ctl + CW_BAR), MISC + 8);

    { p0_mod(F); p0_tables(F);
      for (int i = blockIdx.x * (NWAVES * 64) + F.tid; i < 2 * NCH * NLAYER * TC; i += F.G * NWAVES * 64) F.ssq()[i] = 0ull;
      xcd_barrier(bar); }
    { p0_shw(F); p0_weights(F); xcd_barrier(bar); }
#if PROBE_REP & 1
    { p0_mod(F); p0_tables(F); xcd_barrier(bar); p0_shw(F); p0_weights(F); xcd_barrier(bar); }
#endif

    layer_chunk<0, 0, false>(F, bar); layer_chunk<1, 0, false>(F, bar); layer_chunk<0, 1, false>(F, bar); layer_chunk<1, 1, true>(F, bar);

#ifdef PROBE_CLOCK
    if (blockIdx.x == 0 && F.tid == 0) { volatile LAS unsigned long long* st = (volatile LAS unsigned long long*)(F.lds + MISC_OFF + 64);
        const unsigned long long dc = st[2] - st[0], dt = st[3] - st[1]; const unsigned long long spin = dc * 5000ull / (dt ? dt : 1ull);
        const unsigned long long t0 = wall_clock64(); while (wall_clock64() - t0 < spin) __builtin_amdgcn_s_sleep(16); }
#endif
    if (blockIdx.x == 0 && F.tid == 0) { if (__hip_atomic_load(ctl + CW_BAR + XB_TMO, RLX_AGENT) != 0u) F.out()[0] = __builtin_nanf(""); }
}

extern "C" void kernel_launch(void* const* d_in, const int* in_sizes, int n_in, void* d_out, int out_size, void* d_ws, size_t ws_size, hipStream_t stream) {
    static int grid = 0;
    if (grid == 0) {
        if (n_in != N_IN || out_size != TTOK * D || ws_size < WS_END) { fprintf(stderr, "kernel_launch: shape/workspace mismatch (n_in %d, out %d, ws %zu, need %zu); nothing launched\n", n_in, out_size, ws_size, (size_t)WS_END); grid = -1; return; }
        int dev = 0, cus = 0;
        if (hipGetDevice(&dev) != hipSuccess || hipDeviceGetAttribute(&cus, hipDeviceAttributeMultiprocessorCount, dev) != hipSuccess) { grid = -1; return; }
        if (hipFuncSetAttribute((const void*)enc_fwd, hipFuncAttributeMaxDynamicSharedMemorySize, LDS_BYTES) != hipSuccess) { fprintf(stderr, "kernel_launch: hipFuncSetAttribute failed\n"); grid = -1; return; }
        int per_cu = 0;
        if (hipOccupancyMaxActiveBlocksPerMultiprocessor(&per_cu, (const void*)enc_fwd, NWAVES * 64, LDS_BYTES) != hipSuccess || per_cu < 1) { fprintf(stderr, "kernel_launch: occupancy query says %d blocks per CU\n", per_cu); }
        (void)hipGetLastError();
        grid = cus;
    }
    if (grid < 0) return;
    if (hipMemsetAsync((char*)d_ws + WS_CTL, 0, CTL_ZERO_BYTES, stream) != hipSuccess) return;
    Args a{};
    for (int i = 0; i < N_IN; ++i) a.in[i] = (const float*)d_in[i];
    a.out = (float*)d_out; a.ws = (unsigned char*)d_ws;
    hipLaunchKernelGGL(enc_fwd, dim3(grid), dim3(NWAVES * 64), LDS_BYTES, stream, a);
    const hipError_t le = hipPeekAtLastError();
    if (le != hipSuccess) fprintf(stderr, "kernel_launch: launch failed: %s\n", hipGetErrorName(le));
}
```
